# Optimizing an MI355X kernel written in HIP

```python
import math
import jax, jax.numpy as jnp
from jax import lax
import numpy as np

D_MODEL = 4096
BATCH = 2
SEQ = 4096
DEPTH = 4

HEAD_DIM = 128
N_HEADS_SB = D_MODEL // (2 * HEAD_DIM)
N_HEADS_DIL = D_MODEL // (2 * HEAD_DIM)
DIL_PATTERNS = ((128, 1), (512, 4), (2048, 16))
N_HEADS_MLA = D_MODEL // HEAD_DIM
Q_LORA = D_MODEL // 4
KV_LORA = 512
QK_NOPE = 128
QK_ROPE = 64
V_HEAD = 128
ROPE_THETA = 10000.0
EPS = 1e-6
Q_BLOCK = 128
ADA_SCALE = 0.5
N_EVEN = (DEPTH + 1) // 2
N_ODD = DEPTH // 2
W_SB = N_HEADS_SB * HEAD_DIM
W_DIL = N_HEADS_DIL * HEAD_DIM
EVEN_IN = 4 * W_SB + 4 * W_DIL
QK_HEAD = QK_NOPE + QK_ROPE
MLA_WIDTH = N_HEADS_MLA * V_HEAD
ODD_IN = Q_LORA + KV_LORA + QK_ROPE + MLA_WIDTH

kernel_name = "hybrid_stickbreak_dilated_mla_trunk"


def rms_norm(x, w):
    xf = x.astype(jnp.float32)
    y = xf * lax.rsqrt(jnp.mean(xf * xf, axis=-1, keepdims=True) + EPS)
    return (y * w.astype(jnp.float32)).astype(x.dtype)


def rope_tables(positions, dim):
    inv = ROPE_THETA ** (-jnp.arange(0, dim, 2, dtype=jnp.float32) / dim)
    ang = positions.astype(jnp.float32)[..., None] * inv
    return jnp.cos(ang)[:, :, None, :], jnp.sin(ang)[:, :, None, :]


def apply_rope(x, cos, sin):
    x1, x2 = jnp.split(x.astype(jnp.float32), 2, axis=-1)
    out = jnp.concatenate([x1 * cos - x2 * sin, x2 * cos + x1 * sin], axis=-1)
    return out.astype(x.dtype)


def modulation(c, w, b):
    mod = jax.nn.silu(c) @ w + b
    shift, scale, gate = jnp.split(mod, 3, axis=-1)
    return shift[:, None], scale[:, None], gate[:, None]


def _to_blocks(x):
    b, s, h, d = x.shape
    return x.reshape(b, s // Q_BLOCK, Q_BLOCK, h, d).transpose(1, 0, 2, 3, 4)


def _from_blocks(y):
    nb, b, q, h, d = y.shape
    return y.transpose(1, 0, 2, 3, 4).reshape(b, nb * q, h, d)


def stick_breaking_attention(q, k, v):
    b, s, h, d = q.shape
    scale = 1.0 / math.sqrt(d)
    key_pos = jnp.arange(s)

    def one_block(args):
        qb, q0 = args
        z = jnp.einsum('bqhd,bkhd->bhqk', qb, k,
                       preferred_element_type=jnp.float32) * scale
        qpos = q0 + jnp.arange(Q_BLOCK)
        before = key_pos[None, :] < qpos[:, None]
        log_keep = jnp.where(before, jax.nn.log_sigmoid(-z), 0.0)
        excl = lax.cumsum(log_keep, axis=3, reverse=True) - log_keep
        w = jnp.where(before, jnp.exp(jax.nn.log_sigmoid(z) + excl), 0.0)
        return jnp.einsum('bhqk,bkhd->bqhd', w.astype(v.dtype), v)

    starts = jnp.arange(s // Q_BLOCK) * Q_BLOCK
    return _from_blocks(lax.map(one_block, (_to_blocks(q), starts)))


def _strided_band_attention(q, k, v, dil, span, scale):
    b, s, h, d = q.shape
    unit = dil * Q_BLOCK
    s_pad = -(-s // unit) * unit
    nb = s_pad // unit

    def to_res(x):
        x = jnp.pad(x, ((0, 0), (0, s_pad - s), (0, 0), (0, 0)))
        x = x.reshape(b, s_pad // dil, dil, h, d).transpose(0, 2, 1, 3, 4)
        return x.reshape(b * dil, nb, Q_BLOCK, h, d)

    def with_prev(x):
        prev = jnp.pad(x[:, :-1], ((0, 0), (1, 0), (0, 0), (0, 0), (0, 0)))
        return jnp.concatenate([prev, x], axis=2)

    def from_res(x):
        tail = x.shape[3:]
        x = x.reshape((b, dil, s_pad // dil) + tail)
        x = jnp.moveaxis(x, 1, 2)
        return x.reshape((b, s_pad) + tail)[:, :s]

    qr = to_res(q)
    kb = with_prev(to_res(k))
    vb = with_prev(to_res(v))
    scores = jnp.einsum('nbqhd,nbkhd->nbqhk', qr, kb,
                        preferred_element_type=jnp.float32) * scale
    qi = jnp.arange(Q_BLOCK)[:, None] + Q_BLOCK
    ki = jnp.arange(2 * Q_BLOCK)[None, :]
    dist = qi - ki
    band = (dist >= 0) & (dist <= span)
    has_prev = (jnp.arange(nb)[:, None, None] > 0) | (ki >= Q_BLOCK)[None]
    valid = band[None] & has_prev
    scores = jnp.where(valid[None, :, :, None, :], scores, -jnp.inf)
    lse = jax.nn.logsumexp(scores, axis=-1)
    p = jnp.exp(scores - lse[..., None])
    o = jnp.einsum('nbqhk,nbkhd->nbqhd', p, vb.astype(jnp.float32))
    return from_res(o), from_res(lse)


def dilated_window_attention(q, k, v):
    scale = 1.0 / math.sqrt(q.shape[-1])
    outs, lses = [], []
    for window, dil in DIL_PATTERNS:
        o, lse = _strided_band_attention(q, k, v, dil, window // dil, scale)
        outs.append(o)
        lses.append(lse)
    wts = jax.nn.softmax(jnp.stack(lses, axis=0), axis=0)
    out = jnp.einsum('pbsh,pbshd->bshd', wts, jnp.stack(outs, axis=0))
    return out.astype(q.dtype)


def causal_softmax_attention(q, k, v):
    s = q.shape[1]
    scale = 1.0 / math.sqrt(q.shape[-1])
    key_pos = jnp.arange(s)

    def one_block(args):
        qb, q0 = args
        z = jnp.einsum('bqhd,bkhd->bhqk', qb, k,
                       preferred_element_type=jnp.float32) * scale
        causal = key_pos[None, :] <= (q0 + jnp.arange(Q_BLOCK))[:, None]
        p = jax.nn.softmax(jnp.where(causal, z, -jnp.inf), axis=-1)
        return jnp.einsum('bhqk,bkhd->bqhd', p.astype(v.dtype), v)

    starts = jnp.arange(s // Q_BLOCK) * Q_BLOCK
    return _from_blocks(lax.map(one_block, (_to_blocks(q), starts)))


def even_mixer(h, w_in, q_norm, k_norm, w_out, cos, sin):
    b, s, _ = h.shape
    proj = h @ w_in
    cuts = np.cumsum([W_SB] * 4 + [W_DIL] * 3).tolist()
    q_sb, k_sb, v_sb, g_sb, q_dl, k_dl, v_dl, g_dl = jnp.split(proj, cuts, axis=-1)
    o_sb = stick_breaking_attention(q_sb.reshape(b, s, N_HEADS_SB, HEAD_DIM),
                                    k_sb.reshape(b, s, N_HEADS_SB, HEAD_DIM),
                                    v_sb.reshape(b, s, N_HEADS_SB, HEAD_DIM))
    q_dl = apply_rope(rms_norm(q_dl.reshape(b, s, N_HEADS_DIL, HEAD_DIM), q_norm), cos, sin)
    k_dl = apply_rope(rms_norm(k_dl.reshape(b, s, N_HEADS_DIL, HEAD_DIM), k_norm), cos, sin)
    o_dl = dilated_window_attention(q_dl, k_dl, v_dl.reshape(b, s, N_HEADS_DIL, HEAD_DIM))
    mixed = jnp.concatenate([o_sb.reshape(b, s, W_SB) * jax.nn.silu(g_sb),
                             o_dl.reshape(b, s, W_DIL) * jax.nn.silu(g_dl)], axis=-1)
    return mixed @ w_out


def odd_mixer(h, w_in, q_lat_norm, kv_lat_norm, w_uq, w_ukv, q_norm, k_norm, w_out, cos, sin):
    b, s, _ = h.shape
    proj = h @ w_in
    cuts = np.cumsum([Q_LORA, KV_LORA, QK_ROPE]).tolist()
    c_q, c_kv, k_pe, g = jnp.split(proj, cuts, axis=-1)
    q = (rms_norm(c_q, q_lat_norm) @ w_uq).reshape(b, s, N_HEADS_MLA, QK_HEAD)
    kv = (rms_norm(c_kv, kv_lat_norm) @ w_ukv).reshape(b, s, N_HEADS_MLA, QK_NOPE + V_HEAD)
    k_nope, v = jnp.split(kv, [QK_NOPE], axis=-1)
    k_pe = jnp.broadcast_to(k_pe[:, :, None, :], (b, s, N_HEADS_MLA, QK_ROPE))
    k = jnp.concatenate([k_nope, k_pe], axis=-1)
    q = rms_norm(q, q_norm)
    k = rms_norm(k, k_norm)
    q = jnp.concatenate([q[..., :QK_NOPE], apply_rope(q[..., QK_NOPE:], cos, sin)], axis=-1)
    k = jnp.concatenate([k[..., :QK_NOPE], apply_rope(k[..., QK_NOPE:], cos, sin)], axis=-1)
    o = causal_softmax_attention(q, k, v)
    return (o.reshape(b, s, MLA_WIDTH) * jax.nn.silu(g)) @ w_out


def setup_inputs(seed: int = 0) -> dict:
    key = jax.random.key(seed)
    ks = jax.random.split(key, 20)
    f32 = jnp.float32

    def nrm(k, shape, scale):
        return jax.random.normal(k, shape, f32) * scale

    def gain(k, shape):
        return 1.0 + 0.02 * jax.random.normal(k, shape, f32)

    x = nrm(ks[0], (BATCH, SEQ, D_MODEL), 1.0)
    c = nrm(ks[1], (BATCH, D_MODEL), 1.0)
    positions = (jnp.arange(SEQ, dtype=jnp.int32)[None, :]
                 + jax.random.randint(ks[2], (BATCH, 1), 0, 1024, dtype=jnp.int32))
    return {
        "x": x,
        "c": c,
        "positions": positions,
        "ada_w": nrm(ks[3], (DEPTH, D_MODEL, 3 * D_MODEL), ADA_SCALE * D_MODEL ** -0.5),
        "ada_b": nrm(ks[4], (DEPTH, 3 * D_MODEL), 0.01),
        "norm_w": gain(ks[5], (DEPTH, D_MODEL)),
        "ev_w_in": nrm(ks[6], (N_EVEN, D_MODEL, EVEN_IN), D_MODEL ** -0.5),
        "ev_q_norm": gain(ks[7], (N_EVEN, HEAD_DIM)),
        "ev_k_norm": gain(ks[8], (N_EVEN, HEAD_DIM)),
        "ev_w_out": nrm(ks[9], (N_EVEN, W_SB + W_DIL, D_MODEL), (W_SB + W_DIL) ** -0.5),
        "od_w_in": nrm(ks[10], (N_ODD, D_MODEL, ODD_IN), D_MODEL ** -0.5),
        "od_q_lat_norm": gain(ks[11], (N_ODD, Q_LORA)),
        "od_kv_lat_norm": gain(ks[12], (N_ODD, KV_LORA)),
        "od_w_uq": nrm(ks[13], (N_ODD, Q_LORA, N_HEADS_MLA * QK_HEAD), Q_LORA ** -0.5),
        "od_w_ukv": nrm(ks[14], (N_ODD, KV_LORA, N_HEADS_MLA * (QK_NOPE + V_HEAD)), KV_LORA ** -0.5),
        "od_q_norm": gain(ks[15], (N_ODD, QK_HEAD)),
        "od_k_norm": gain(ks[16], (N_ODD, QK_HEAD)),
        "od_w_out": nrm(ks[17], (N_ODD, MLA_WIDTH, D_MODEL), MLA_WIDTH ** -0.5),
    }


def reference(x, c, positions, ada_w, ada_b, norm_w, ev_w_in, ev_q_norm, ev_k_norm, ev_w_out,
              od_w_in, od_q_lat_norm, od_kv_lat_norm, od_w_uq, od_w_ukv, od_q_norm, od_k_norm,
              od_w_out):
    cos_full, sin_full = rope_tables(positions, HEAD_DIM)
    cos_mla, sin_mla = rope_tables(positions, QK_ROPE)
    for layer in range(DEPTH):
        shift, scale, gate = modulation(c, ada_w[layer], ada_b[layer])
        h = rms_norm(x, norm_w[layer]) * (1.0 + scale) + shift
        if layer % 2 == 0:
            i = layer // 2
            y = even_mixer(h, ev_w_in[i], ev_q_norm[i], ev_k_norm[i], ev_w_out[i],
                           cos_full, sin_full)
        else:
            i = layer // 2
            y = odd_mixer(h, od_w_in[i], od_q_lat_norm[i], od_kv_lat_norm[i], od_w_uq[i],
                          od_w_ukv[i], od_q_norm[i], od_k_norm[i], od_w_out[i],
                          cos_mla, sin_mla)
        x = x + gate * y
    return x
```

```cpp
#include <hip/hip_runtime.h>
#include <cstdio>
#include <cstdint>

#ifndef MK_N_LAUNCHES
#define MK_N_LAUNCHES 1
#endif

#define LAS __attribute__((address_space(3)))
#define GAS __attribute__((address_space(1)))
typedef unsigned short bf16_t;
typedef short bf16x8 __attribute__((ext_vector_type(8)));
typedef short s16x4 __attribute__((ext_vector_type(4)));
typedef float f32x2 __attribute__((ext_vector_type(2)));
typedef float f32x4 __attribute__((ext_vector_type(4)));
typedef float f32x16 __attribute__((ext_vector_type(16)));
typedef unsigned u32x2 __attribute__((ext_vector_type(2)));
typedef unsigned u32x4 __attribute__((ext_vector_type(4)));
typedef __bf16 hbf16x2 __attribute__((ext_vector_type(2)));

constexpr int NB = 2, SEQ = 4096, DM = 4096, MTOK = NB * SEQ, DEPTH = 4;
constexpr int EVEN_IN = 16384, ODD_IN = 5696, ODD_INP = 5888;
constexpr int EVEN_LD = EVEN_IN + 2176;
constexpr int QLORA = 1024, KVLORA = 512, NH_MLA = 32, NH_SB = 16, NH_DL = 16;
constexpr int UQ_N = 6144, UKV_N = 8192;
constexpr float EPS = 1e-6f;
constexpr float LOG2E = 1.4426950408889634f;
constexpr float QS128 = 1.4426950408889634f * 0.08838834764831845f;
constexpr float QS192 = 1.4426950408889634f * 0.07216878364870322f;
constexpr int EC_QSB = 0, EC_KSB = 2048, EC_VSB = 4096, EC_GSB = 6144, EC_QDL = 8192, EC_KDL = 10240, EC_VDL = 12288, EC_GDL = 14336;
constexpr int OC_CQ = 0, OC_CKV = 1024, OC_G = 1536, OC_KPE = 5632;

constexpr int RING_BYTES_C = 131072;
constexpr size_t MiB = 1u << 20;
constexpr size_t WS_CTL = 0, CTL_ZERO_BYTES = 1 * MiB;
constexpr size_t WS_MOD = 1 * MiB;
constexpr size_t WS_COSF = 2 * MiB, WS_SINF = 4 * MiB;
constexpr size_t WS_COSM = 6 * MiB, WS_SINM = 7 * MiB;
constexpr size_t WS_DIAG = 8 * MiB;
constexpr size_t WS_WEVIN = 16 * MiB;
constexpr size_t WS_WEVOUT = 272 * MiB;
constexpr size_t WS_WODIN = 336 * MiB;
constexpr size_t WS_WUQ = 428 * MiB;
constexpr size_t WS_WUKV = 452 * MiB;
constexpr size_t WS_WODOUT = 468 * MiB;
constexpr size_t WS_H = 544 * MiB;
constexpr size_t WS_PROJ = 1506 * MiB;
constexpr size_t WS_MIXED = 864 * MiB;
constexpr size_t WS_ODL = 928 * MiB;
constexpr size_t WS_LSE = 1024 * MiB;
constexpr size_t WS_QRAW = 1026 * MiB;
constexpr size_t WS_KVRAW = 1122 * MiB;
constexpr size_t WS_XH = 1122 * MiB;
constexpr size_t WS_QF = 1250 * MiB;
constexpr size_t WS_KF = 1346 * MiB;
constexpr size_t WS_VF = 1442 * MiB;
constexpr size_t WS_END = 1800 * MiB;
constexpr int CW_BAR = 4096;
constexpr size_t CTL_SSQCQ = 524288, CTL_SSQKV = CTL_SSQCQ + 2 * MTOK * 4;
static_assert(CTL_SSQKV + 4 * MTOK * 4 <= CTL_ZERO_BYTES, "CTL map");
constexpr int XCH_OFF = RING_BYTES_C + 1024;

constexpr int RING_BYTES = 131072;
constexpr int LDSCTL_OFF = RING_BYTES, MISC_OFF = LDSCTL_OFF + 320;
constexpr int LDS_BYTES = 147456;
constexpr int NWAVES = 8, NTHR = 512;

__device__ __forceinline__ unsigned cvtpk(float lo, float hi) { f32x2 v = {lo, hi}; hbf16x2 b = __builtin_convertvector(v, hbf16x2); return __builtin_bit_cast(unsigned, b); }
typedef _Float16 hf16x2 __attribute__((ext_vector_type(2)));
__device__ __forceinline__ unsigned pkh(float lo, float hi) { hf16x2 h; h.x = (_Float16)lo; h.y = (_Float16)hi; return __builtin_bit_cast(unsigned, h); }
__device__ __forceinline__ float h_lo(unsigned w) { return (float)__builtin_bit_cast(hf16x2, w).x; }
__device__ __forceinline__ float h_hi(unsigned w) { return (float)__builtin_bit_cast(hf16x2, w).y; }
__device__ __forceinline__ float bf_lo(unsigned w) { return __uint_as_float(w << 16); }
__device__ __forceinline__ float bf_hi(unsigned w) { return __uint_as_float(w & 0xffff0000u); }
__device__ __forceinline__ float bf2f(bf16_t b) { return __uint_as_float(((unsigned)b) << 16); }
__device__ __forceinline__ void unpack8(u32x4 w, float (&x)[8]) { x[0] = bf_lo(w.x); x[1] = bf_hi(w.x); x[2] = bf_lo(w.y); x[3] = bf_hi(w.y); x[4] = bf_lo(w.z); x[5] = bf_hi(w.z); x[6] = bf_lo(w.w); x[7] = bf_hi(w.w); }
__device__ __forceinline__ u32x4 pack8u(const float (&x)[8]) { u32x4 w; w.x = cvtpk(x[0], x[1]); w.y = cvtpk(x[2], x[3]); w.z = cvtpk(x[4], x[5]); w.w = cvtpk(x[6], x[7]); return w; }
__device__ __forceinline__ int lane_fresh() { int l; asm volatile("v_mbcnt_lo_u32_b32 %0, -1, 0\n\tv_mbcnt_hi_u32_b32 %0, -1, %0" : "=v"(l)); return l; }
__device__ __forceinline__ float sum16(float v) { auto r = __builtin_amdgcn_permlane16_swap(__float_as_uint(v), __float_as_uint(v), false, false); return __uint_as_float(r[0]) + __uint_as_float(r[1]); }
__device__ __forceinline__ float sum32(float v) { auto r = __builtin_amdgcn_permlane32_swap(__float_as_uint(v), __float_as_uint(v), false, false); return __uint_as_float(r[0]) + __uint_as_float(r[1]); }
__device__ __forceinline__ float dpp_xor1(float v) { return __int_as_float(__builtin_amdgcn_update_dpp(0, __float_as_int(v), 0xB1  , 0xF, 0xF, true)); }
__device__ __forceinline__ float wave_sum(float v) {
    v += __int_as_float(__builtin_amdgcn_update_dpp(0, __float_as_int(v), 0xB1, 0xF, 0xF, true));
    v += __int_as_float(__builtin_amdgcn_update_dpp(0, __float_as_int(v), 0x4E, 0xF, 0xF, true));
    v += __int_as_float(__builtin_amdgcn_update_dpp(0, __float_as_int(v), 0x124, 0xF, 0xF, true));
    v += __int_as_float(__builtin_amdgcn_update_dpp(0, __float_as_int(v), 0x128, 0xF, 0xF, true));
    v = sum16(v); v = sum32(v);
    return v;
}
__device__ __forceinline__ float silu_f(float v) { return v * __builtin_amdgcn_rcpf(1.0f + __builtin_amdgcn_exp2f(-v * LOG2E)); }
__device__ __forceinline__ int opaque_tid(int wv) { int t = wv * 64 + lane_fresh(); asm volatile("" : "+v"(t)); return t; }
#define LDS_WAIT() asm volatile("s_waitcnt lgkmcnt(0)" ::: "memory")
#define VM_WAIT() asm volatile("s_waitcnt vmcnt(0)" ::: "memory")
#define SBAR() __builtin_amdgcn_sched_barrier(0)

namespace pg8 {
constexpr int BM = 256, BK = 64, HALF = 128, HTB = HALF * BK * 2, STAGE_BYTES = 8 * HTB, NXCD = 8, WGM = 8;
__host__ __device__ __forceinline__ int lds_byte(int r, int c) { const int st = (r >> 4) * 2 + (c >> 5), rr = r & 15, cc = c & 31, ob = rr * 64 + cc * 2; return st * 1024 + (ob ^ (((ob >> 9) & 1) << 5)); }
__host__ __device__ __forceinline__ void stage_rc(int b, int& R, int& C) { const int st = b / 1024, sb = b % 1024, swz = sb ^ (((sb >> 9) & 1) << 5); R = (st >> 1) * 16 + swz / 64; C = (st & 1) * 32 + (swz % 64) / 2; }
__host__ __device__ __forceinline__ int perm32(int rho) { const int n = rho >> 4, i = rho & 15; return 8 * (i >> 2) + 4 * n + (i & 3); }
struct Unit { int pm, pn; };
struct Gemm { const bf16_t* A; const bf16_t* Bt; int M, N, K, lda, ldb; };
struct StaticOrder {
    int nM, nN, nwg, G, c;
    __host__ __device__ void init(int M, int N, int G_, int c_) { nM = M / BM; nN = N / BM; nwg = nM * nN; G = G_; c = c_; }
    __host__ __device__ bool next(int i, Unit& u) const {
        const int L = i * G + c; if (L >= nwg) return false;
        int wgid = L; { const int q = nwg / NXCD, r = nwg % NXCD, xcd = wgid % NXCD, off = wgid / NXCD; wgid = (xcd < r ? xcd * (q + 1) : r * (q + 1) + (xcd - r) * q) + off; }
        const int nig = WGM * nN, gid = wgid / nig, fm = gid * WGM, gsz = (nM - fm) < WGM ? (nM - fm) : WGM;
        u.pm = fm + ((wgid % nig) % gsz); u.pn = (wgid % nig) / gsz; return true;
    }
    __device__ __forceinline__ void a_ready(const Unit&) const {}
    __device__ __forceinline__ void done(const Unit&) const {}
};
struct EpiBf16Op {
    static constexpr bool PERM = true;
    bf16_t* O; int ldc;
    int kind;
    const float* knw; const float* cosM; const float* sinM;
    float* ssq_q; float* ssq_kv; float* ssq_pe;
    __device__ __forceinline__ void operator()(const f32x4 (&acc)[2][2][4][2], const Unit& u, int wr, int wc, int fr, int fq) const {
        const int row0 = u.pm * BM + wr * 64 + fr, col0 = u.pn * BM + wc * 32 + 8 * fq;
        float sc = 1.f; bool act = false;
        if (kind == 1) { const int seg = u.pn >> 3; if (seg == 0) sc = QS128; act = (seg == 3) || (seg == 7); }
        else if (kind == 2) { act = (u.pn >= 6) && (u.pn < 22); }
#pragma unroll
        for (int ai = 0; ai < 2; ++ai)
#pragma unroll
            for (int m = 0; m < 4; ++m) { bf16_t* rowp = O + (size_t)(row0 + ai * HALF + m * 16) * ldc + col0;
#pragma unroll
                for (int bj = 0; bj < 2; ++bj) { f32x4 v0 = acc[ai][bj][m][0] * sc, v1 = acc[ai][bj][m][1] * sc;
                    if (kind == 2 && u.pn == 22 && bj == 0 && wc < 2) { const int i4 = 4 * (4 * wc + fq); const size_t row = (size_t)(row0 + ai * HALF + m * 16);
                        const f32x4 w1 = *(const f32x4*)(knw + 128 + i4), w2 = *(const f32x4*)(knw + 160 + i4);
                        const f32x4 c = *(const f32x4*)(cosM + row * 32 + i4), sn = *(const f32x4*)(sinM + row * 32 + i4);
                        const f32x4 x1 = v0 * w1, x2 = v1 * w2; v0 = x1 * c - x2 * sn; v1 = x2 * c + x1 * sn; }
                    if (act) {
#pragma unroll
                        for (int j = 0; j < 4; ++j) { v0[j] = silu_f(v0[j]); v1[j] = silu_f(v1[j]); } }
                    u32x4 w; w.x = cvtpk(v0[0], v0[1]); w.y = cvtpk(v0[2], v0[3]); w.z = cvtpk(v1[0], v1[1]); w.w = cvtpk(v1[2], v1[3]);
                    *(u32x4*)(rowp + bj * HALF) = w; }
                if (kind == 2 && u.pn < 6) { float sq = 0.f;
#pragma unroll
                    for (int bj = 0; bj < 2; ++bj)
#pragma unroll
                        for (int n = 0; n < 2; ++n) { const f32x4 x = acc[ai][bj][m][n]; sq += (x[0] * x[0] + x[1] * x[1]) + (x[2] * x[2] + x[3] * x[3]); }
                    sq = sum16(sq); sq = sum32(sq);
                    if (fq == 0) { if (u.pn < 4) atomicAdd(ssq_q + row0 + ai * HALF + m * 16, sq); else atomicAdd(ssq_kv + 2 * (row0 + ai * HALF + m * 16), sq); } }
                if (kind == 2 && u.pn == 22 && wc < 2) { float sq = 0.f;
#pragma unroll
                    for (int n = 0; n < 2; ++n) { const f32x4 x = acc[ai][0][m][n]; sq += (x[0] * x[0] + x[1] * x[1]) + (x[2] * x[2] + x[3] * x[3]); }
                    sq = sum16(sq); sq = sum32(sq);
                    if (fq == 0) atomicAdd(ssq_pe + 2 * (row0 + ai * HALF + m * 16), sq); } }
    }
};
struct EpiKV {
    static constexpr bool PERM = true;
    bf16_t* KF; bf16_t* VF;
    const bf16_t* P2;
    const float* ssqkv;
    const float* ssqpe;
    const float* knw;
    const float* cosM; const float* sinM;
    LAS unsigned char* xl;
    __device__ __forceinline__ void operator()(const f32x4 (&acc)[2][2][4][2], const Unit& u, int wr, int wc, int fr, int fq) const {
        asm volatile("" : "+v"(fr), "+v"(fq));
        const int rl0 = wr * 64 + fr, q4 = 4 * (4 * wc + fq); const bool ropel = wc < 2;
        LAS f32x2* X = (LAS f32x2*)xl;
        float sq8[8], pe8[8];
#pragma unroll
        for (int rr = 0; rr < 8; ++rr) { const size_t row = (size_t)u.pm * BM + rl0 + (rr >> 2) * HALF + (rr & 3) * 16; const f32x2 t2 = *(const f32x2*)(ssqkv + 2 * row); sq8[rr] = t2[0]; pe8[rr] = t2[1]; }
#pragma unroll
        for (int ai = 0; ai < 2; ++ai)
#pragma unroll
            for (int m = 0; m < 4; ++m) { const int rloc = rl0 + ai * HALF + m * 16;
                float pn = 0.f;
#pragma unroll
                for (int n = 0; n < 2; ++n) { const f32x4 x = acc[ai][0][m][n]; pn += (x[0] * x[0] + x[1] * x[1]) + (x[2] * x[2] + x[3] * x[3]); }
                pn = sum16(pn); pn = sum32(pn);
                if (fq == 0) X[rloc * 4 + wc] = (f32x2){pn, 0.f}; }
        asm volatile("s_waitcnt lgkmcnt(0)" ::: "memory"); __builtin_amdgcn_s_barrier(); asm volatile("" ::: "memory");
        const int bh = (u.pm >> 4) * NH_MLA + u.pn;
        const f32x4 wka = *(const f32x4*)(knw + wc * 32 + fq * 8), wkb = *(const f32x4*)(knw + wc * 32 + fq * 8 + 4);
        float rk8[8];
#pragma unroll
        for (int ai = 0; ai < 2; ++ai)
#pragma unroll
            for (int m = 0; m < 4; ++m) { const int rloc = rl0 + ai * HALF + m * 16; const size_t row = (size_t)u.pm * BM + rloc; const int srow = (int)(row & (SEQ - 1));
                const f32x4 xa = *(const LAS f32x4*)(X + rloc * 4), xb = *(const LAS f32x4*)(X + rloc * 4 + 2);
                const float ssn = (xa[0] + xa[2]) + (xb[0] + xb[2]), spe = pe8[ai * 4 + m];
                const float rkv = __builtin_amdgcn_rsqf(sq8[ai * 4 + m] * (1.0f / KVLORA) + EPS);
                const float rk = __builtin_amdgcn_rsqf((rkv * rkv * ssn + spe) * (1.0f / 192.0f) + EPS), sk = rkv * rk;
                rk8[ai * 4 + m] = rk;
                const size_t trow = (size_t)bh * SEQ + srow;
                { const f32x4 b0 = acc[ai][0][m][0] * wka * sk, b1 = acc[ai][0][m][1] * wkb * sk; u32x4 w;
                  w.x = cvtpk(b0[0], b0[1]); w.y = cvtpk(b0[2], b0[3]); w.z = cvtpk(b1[0], b1[1]); w.w = cvtpk(b1[2], b1[3]);
                  *(u32x4*)(KF + trow * 192 + wc * 32 + fq * 8) = w; }
                { const f32x4 a0 = acc[ai][1][m][0] * rkv, a1 = acc[ai][1][m][1] * rkv; u32x4 w;
                  w.x = cvtpk(a0[0], a0[1]); w.y = cvtpk(a0[2], a0[3]); w.z = cvtpk(a1[0], a1[1]); w.w = cvtpk(a1[2], a1[3]);
                  *(u32x4*)(VF + trow * 128 + wc * 32 + fq * 8) = w; } }
        asm volatile("" ::: "memory");
        if (ropel) {
            u32x4 R8[8];
#pragma unroll
            for (int rr = 0; rr < 8; ++rr) { const size_t row = (size_t)u.pm * BM + rl0 + (rr >> 2) * HALF + (rr & 3) * 16; R8[rr] = *(const u32x4*)(P2 + row * ODD_INP + OC_KPE + wc * 32 + fq * 8); }
#pragma unroll
            for (int rr = 0; rr < 8; ++rr) { const size_t row = (size_t)u.pm * BM + rl0 + (rr >> 2) * HALF + (rr & 3) * 16; const int srow = (int)(row & (SEQ - 1));
                const float rk = rk8[rr]; const size_t trow = (size_t)bh * SEQ + srow;
                float x[8]; unpack8(R8[rr], x);
                u32x2 o1, o2;
                o1.x = cvtpk(x[0] * rk, x[1] * rk); o1.y = cvtpk(x[2] * rk, x[3] * rk); o2.x = cvtpk(x[4] * rk, x[5] * rk); o2.y = cvtpk(x[6] * rk, x[7] * rk);
                *(u32x2*)(KF + trow * 192 + 128 + q4) = o1; *(u32x2*)(KF + trow * 192 + 160 + q4) = o2; }
        }
    }
};
struct EpiEvenIn {
    static constexpr bool PERM = true;
    bf16_t* O;
    const float* qn; const float* kn;
    const unsigned short* cosF; const unsigned short* sinF;
    LAS unsigned char* xl;
    __device__ __forceinline__ void operator()(const f32x4 (&acc)[2][2][4][2], const Unit& u, int wr, int wc, int fr, int fq) const {
        asm volatile("" : "+v"(fr), "+v"(fq));
        const int row0 = u.pm * BM + wr * 64 + fr, col0 = u.pn * BM + wc * 32 + 8 * fq;
        const int seg = u.pn >> 3;
        if (seg == 4 || seg == 5) {
            const int rl0 = wr * 64 + fr, i4 = 4 * (4 * wc + fq);
            LAS float* X = (LAS float*)xl;
            u32x2 ct[8], st[8];
#pragma unroll
            for (int rr = 0; rr < 8; ++rr) { const size_t row = (size_t)u.pm * BM + rl0 + (rr >> 2) * HALF + (rr & 3) * 16;
                ct[rr] = *(const u32x2*)(cosF + row * 64 + i4); st[rr] = *(const u32x2*)(sinF + row * 64 + i4); }
#pragma unroll
            for (int ai = 0; ai < 2; ++ai)
#pragma unroll
                for (int m = 0; m < 4; ++m) { const int rloc = rl0 + ai * HALF + m * 16;
#pragma unroll
                    for (int bj = 0; bj < 2; ++bj) { const f32x4 x = acc[ai][bj][m][0], y = acc[ai][bj][m][1];
                        float s = ((x[0] * x[0] + x[1] * x[1]) + (x[2] * x[2] + x[3] * x[3])) + ((y[0] * y[0] + y[1] * y[1]) + (y[2] * y[2] + y[3] * y[3]));
                        s = sum16(s); s = sum32(s);
                        if (fq == 0) X[(rloc * 2 + bj) * 4 + wc] = s; } }
            asm volatile("s_waitcnt lgkmcnt(0)" ::: "memory"); __builtin_amdgcn_s_barrier(); asm volatile("" ::: "memory");
            const float* wv = (seg == 4) ? qn : kn; const float osc = (seg == 4) ? QS128 : 1.0f;
            const f32x4 w1 = *(const f32x4*)(wv + i4), w2 = *(const f32x4*)(wv + 64 + i4);
#pragma unroll
            for (int ai = 0; ai < 2; ++ai)
#pragma unroll
                for (int m = 0; m < 4; ++m) { const int rloc = rl0 + ai * HALF + m * 16; const size_t row = (size_t)u.pm * BM + rloc;
                    const u32x2 cq = ct[ai * 4 + m], sq_ = st[ai * 4 + m];
                    const f32x4 c = {h_lo(cq.x), h_hi(cq.x), h_lo(cq.y), h_hi(cq.y)}, sn = {h_lo(sq_.x), h_hi(sq_.x), h_lo(sq_.y), h_hi(sq_.y)};
                    const f32x4 xs0 = *(const LAS f32x4*)(X + (rloc * 2 + 0) * 4), xs1 = *(const LAS f32x4*)(X + (rloc * 2 + 1) * 4);
#pragma unroll
                    for (int bj = 0; bj < 2; ++bj) { const f32x4 xs = bj ? xs1 : xs0;
                        const float rinv = __builtin_amdgcn_rsqf(((xs[0] + xs[1]) + (xs[2] + xs[3])) * (1.0f / 128.0f) + EPS);
                        const f32x4 y1 = acc[ai][bj][m][0] * w1 * rinv, y2 = acc[ai][bj][m][1] * w2 * rinv;
                        const f32x4 o1 = (y1 * c - y2 * sn) * osc, o2 = (y2 * c + y1 * sn) * osc;
                        u32x4 w; w.x = cvtpk(o1[0], o1[1]); w.y = cvtpk(o1[2], o1[3]); w.z = cvtpk(o2[0], o2[1]); w.w = cvtpk(o2[2], o2[3]);
                        *(u32x4*)(O + row * EVEN_LD + col0 + bj * HALF) = w; } }
            return;
        }
        const float sc = (seg == 0) ? QS128 : 1.f; const bool act = (seg == 3) || (seg == 7);
#pragma unroll
        for (int ai = 0; ai < 2; ++ai)
#pragma unroll
            for (int m = 0; m < 4; ++m) { bf16_t* rowp = O + (size_t)(row0 + ai * HALF + m * 16) * EVEN_LD + col0;
#pragma unroll
                for (int bj = 0; bj < 2; ++bj) { f32x4 v0 = acc[ai][bj][m][0] * sc, v1 = acc[ai][bj][m][1] * sc;
                    if (act) {
#pragma unroll
                        for (int j = 0; j < 4; ++j) { v0[j] = silu_f(v0[j]); v1[j] = silu_f(v1[j]); } }
                    u32x4 w; w.x = cvtpk(v0[0], v0[1]); w.y = cvtpk(v0[2], v0[3]); w.z = cvtpk(v1[0], v1[1]); w.w = cvtpk(v1[2], v1[3]);
                    *(u32x4*)(rowp + bj * HALF) = w; } }
    }
};
struct EpiResid {
    static constexpr bool PERM = true;
    const float* xin32; const unsigned short* xin16; float* xout32; unsigned short* xout16; const float* gate;
    __device__ __forceinline__ void operator()(const f32x4 (&acc)[2][2][4][2], const Unit& u, int wr, int wc, int fr, int fq) const {
        const int row0 = u.pm * BM + wr * 64 + fr, col0 = u.pn * BM + wc * 32 + 8 * fq;
        const float* gp = gate + (u.pm >= 16 ? 12288 : 0) + col0;
        f32x4 gv[2][2];
#pragma unroll
        for (int bj = 0; bj < 2; ++bj)
#pragma unroll
            for (int n = 0; n < 2; ++n) gv[bj][n] = *(const f32x4*)(gp + bj * HALF + n * 4);
        const bool in16 = xin16 != nullptr, out16 = xout16 != nullptr;
        if (in16) {
#pragma unroll
            for (int ai = 0; ai < 2; ++ai) {
                u32x4 raw[4][2];
#pragma unroll
                for (int m = 0; m < 4; ++m)
#pragma unroll
                    for (int bj = 0; bj < 2; ++bj) raw[m][bj] = *(const u32x4*)(xin16 + (size_t)(row0 + ai * HALF + m * 16) * DM + col0 + bj * HALF);
#pragma unroll
                for (int m = 0; m < 4; ++m) { const size_t off = (size_t)(row0 + ai * HALF + m * 16) * DM + col0;
#pragma unroll
                    for (int bj = 0; bj < 2; ++bj) { const u32x4 r = raw[m][bj];
                        const f32x4 x0 = {h_lo(r.x), h_hi(r.x), h_lo(r.y), h_hi(r.y)}, x1 = {h_lo(r.z), h_hi(r.z), h_lo(r.w), h_hi(r.w)};
                        const f32x4 y0 = x0 + gv[bj][0] * acc[ai][bj][m][0], y1 = x1 + gv[bj][1] * acc[ai][bj][m][1];
                        if (out16) { u32x4 w; w.x = pkh(y0[0], y0[1]); w.y = pkh(y0[2], y0[3]); w.z = pkh(y1[0], y1[1]); w.w = pkh(y1[2], y1[3]); *(u32x4*)(xout16 + off + bj * HALF) = w; }
                        else { *(f32x4*)(xout32 + off + bj * HALF) = y0; *(f32x4*)(xout32 + off + bj * HALF + 4) = y1; } } }
                asm volatile("" ::: "memory");
            }
            return;
        }
#pragma unroll
        for (int g2 = 0; g2 < 4; ++g2) { const int ai = g2 >> 1, mb = (g2 & 1) * 2;
            f32x4 xo[2][2][2];
#pragma unroll
            for (int m = 0; m < 2; ++m)
#pragma unroll
                for (int bj = 0; bj < 2; ++bj)
#pragma unroll
                    for (int n = 0; n < 2; ++n) xo[m][bj][n] = *(const f32x4*)(xin32 + (size_t)(row0 + ai * HALF + (mb + m) * 16) * DM + col0 + bj * HALF + n * 4);
#pragma unroll
            for (int m = 0; m < 2; ++m) { const size_t off = (size_t)(row0 + ai * HALF + (mb + m) * 16) * DM + col0;
#pragma unroll
                for (int bj = 0; bj < 2; ++bj) { const f32x4 y0 = xo[m][bj][0] + gv[bj][0] * acc[ai][bj][m == 0 ? mb : mb + 1][0], y1 = xo[m][bj][1] + gv[bj][1] * acc[ai][bj][m == 0 ? mb : mb + 1][1];
                    if (out16) { u32x4 w; w.x = pkh(y0[0], y0[1]); w.y = pkh(y0[2], y0[3]); w.z = pkh(y1[0], y1[1]); w.w = pkh(y1[2], y1[3]); *(u32x4*)(xout16 + off + bj * HALF) = w; }
                    else { *(f32x4*)(xout32 + off + bj * HALF) = y0; *(f32x4*)(xout32 + off + bj * HALF + 4) = y1; } } }
            asm volatile("" ::: "memory");
        }
    }
};

template <class Epi, class Sched, bool ALIGN_EPI = true, bool SP2 = true>
__device__ __forceinline__ void gemm_phase(LAS unsigned char* lds, const Gemm g, const Sched& S, const Epi& E, int wv) {
    const int tid = opaque_tid(wv), wid = __builtin_amdgcn_readfirstlane(tid >> 6), lane = tid & 63, wr = wid >> 2, wc = wid & 3, fr = lane & 15, fq = lane >> 4;
    const int K = g.K, nt = K / BK;
    unsigned voffA[2], voffB[2];
#pragma unroll
    for (int i = 0; i < 2; ++i) { int R, C; stage_rc(tid * 16 + i * 8192, R, C); const int Rb = Epi::PERM ? ((R & ~31) + perm32(R & 31)) : R;
        voffA[i] = (unsigned)(R * g.lda + C) * 2u; voffB[i] = (unsigned)(Rb * g.ldb + C) * 2u; }
    const size_t kstep = (size_t)(BK * 2);
    const size_t hstepA = (size_t)HALF * g.lda * 2, hstepB = (size_t)HALF * g.ldb * 2;
    const size_t tstepA = 2 * hstepA, tstepB = 2 * hstepB;
    const unsigned ldsw = (unsigned)wid * 1024u;
    const int aoff = lds_byte(wr * 64 + fr, fq * 8), boff = lds_byte(wc * 32 + fr, fq * 8);
#define PG8_SA(b, h) (((b) * 2 + (h)) * HTB)
#define PG8_SB(b, h) ((4 + (b) * 2 + (h)) * HTB)
#define PG8_STAGE(bufoff, gbase, voff) do { _Pragma("unroll") for (int _i = 0; _i < 2; ++_i) \
        __builtin_amdgcn_global_load_lds((const unsigned*)((const char*)(gbase) + (voff)[_i]), (LAS unsigned*)(lds + (bufoff) + ldsw + _i * 8192), 16, 0, 0); } while (0)
#define PG8_LDA(dst, b, h) do { _Pragma("unroll") for (int m = 0; m < 4; ++m) _Pragma("unroll") for (int k = 0; k < 2; ++k) dst[m][k] = *(const LAS bf16x8*)(lds + PG8_SA(b, h) + aoff + m * 2048 + k * 1024); } while (0)
#define PG8_LDB(dst, b, h) do { _Pragma("unroll") for (int n = 0; n < 2; ++n) _Pragma("unroll") for (int k = 0; k < 2; ++k) dst[n][k] = *(const LAS bf16x8*)(lds + PG8_SB(b, h) + boff + n * 2048 + k * 1024); } while (0)
#define PG8_MMA(ai, bj, At, Bt) do { __builtin_amdgcn_s_setprio(1); _Pragma("unroll") for (int m = 0; m < 4; ++m) _Pragma("unroll") for (int n = 0; n < 2; ++n) _Pragma("unroll") for (int k = 0; k < 2; ++k) \
        acc[ai][bj][m][n] = __builtin_amdgcn_mfma_f32_16x16x32_bf16(Bt[n][k], At[m][k], acc[ai][bj][m][n], 0, 0, 0); __builtin_amdgcn_s_setprio(0); } while (0)
#define PG8_WAIT_V(n) asm volatile("s_waitcnt vmcnt(" #n ")" ::: "memory")
#define PG8_WAIT_L(n) asm volatile("s_waitcnt lgkmcnt(" #n ")" ::: "memory")
#define PG8_BAR __builtin_amdgcn_s_barrier()
#define PG8_SCHED __builtin_amdgcn_sched_barrier(0)
    Unit cur, nxt; int ui = 0;
    if (!S.next(0, cur)) return;
    f32x4 acc[2][2][4][2];
#pragma unroll
    for (int a = 0; a < 2; ++a)
#pragma unroll
        for (int b = 0; b < 2; ++b)
#pragma unroll
            for (int m = 0; m < 4; ++m)
#pragma unroll
                for (int n = 0; n < 2; ++n) acc[a][b][m][n] = (f32x4){0.f, 0.f, 0.f, 0.f};
    bf16x8 At[4][2], B0[2][2], B1[2][2];
    const char* cA = (const char*)g.A + (size_t)cur.pm * tstepA; const char* cB = (const char*)g.Bt + (size_t)cur.pn * tstepB;
    S.a_ready(cur);
    if constexpr (SP2) {
        PG8_STAGE(PG8_SB(0, 0), cB, voffB); PG8_STAGE(PG8_SB(0, 1), cB + hstepB, voffB); PG8_STAGE(PG8_SA(0, 0), cA, voffA); PG8_STAGE(PG8_SA(0, 1), cA + hstepA, voffA);
        if (wr == 1) PG8_BAR;
        PG8_WAIT_V(2); PG8_BAR;
        PG8_STAGE(PG8_SB(1, 0), cB + kstep, voffB); PG8_STAGE(PG8_SA(1, 0), cA + kstep, voffA); PG8_STAGE(PG8_SB(1, 1), cB + hstepB + kstep, voffB);
        PG8_WAIT_V(6); PG8_BAR;
    } else {
        PG8_STAGE(PG8_SB(0, 0), cB, voffB); PG8_STAGE(PG8_SA(0, 0), cA, voffA); PG8_STAGE(PG8_SB(0, 1), cB + hstepB, voffB); PG8_STAGE(PG8_SA(0, 1), cA + hstepA, voffA);
        if (wr == 1) PG8_BAR;
        PG8_WAIT_V(4); PG8_BAR;
        PG8_STAGE(PG8_SB(1, 0), cB + kstep, voffB); PG8_STAGE(PG8_SA(1, 0), cA + kstep, voffA); PG8_STAGE(PG8_SB(1, 1), cB + hstepB + kstep, voffB);
        PG8_WAIT_V(6); PG8_BAR;
    }
    for (;;) {
        const bool has_next = S.next(ui + 1, nxt);
        const char* nA = has_next ? (const char*)g.A + (size_t)nxt.pm * tstepA : cA; const char* nB = has_next ? (const char*)g.Bt + (size_t)nxt.pn * tstepB : cB;
        for (int t = 0; t < nt; t += 2) {
            const bool last = (t == nt - 2);
            const char* a1 = cA + (size_t)(t + 1) * kstep;
            const char* a2 = last ? nA : cA + (size_t)(t + 2) * kstep; const char* b2 = last ? nB : cB + (size_t)(t + 2) * kstep;
            const char* a3 = a2 + kstep; const char* b3 = b2 + kstep;
            if (last && has_next) S.a_ready(nxt);
            if constexpr (SP2) {
            PG8_LDB(B0, 0, 0); PG8_LDB(B1, 0, 1); PG8_SCHED; PG8_LDA(At, 0, 0); PG8_STAGE(PG8_SA(1, 1), a1 + hstepA, voffA);
            PG8_WAIT_V(8); PG8_WAIT_L(0); PG8_BAR; PG8_MMA(0, 0, At, B0); PG8_MMA(0, 1, At, B1); PG8_BAR; PG8_SCHED;
            PG8_LDA(At, 0, 1); PG8_STAGE(PG8_SB(0, 0), b2, voffB); PG8_STAGE(PG8_SB(0, 1), b2 + hstepB, voffB); PG8_STAGE(PG8_SA(0, 0), a2, voffA);
            PG8_WAIT_V(8); PG8_WAIT_L(0); PG8_BAR; PG8_MMA(1, 0, At, B0); PG8_MMA(1, 1, At, B1); PG8_BAR; PG8_SCHED;
            PG8_LDB(B0, 1, 0); PG8_LDB(B1, 1, 1); PG8_SCHED; PG8_LDA(At, 1, 0); PG8_STAGE(PG8_SA(0, 1), a2 + hstepA, voffA);
            PG8_WAIT_V(8); PG8_WAIT_L(0); PG8_BAR; PG8_MMA(0, 0, At, B0); PG8_MMA(0, 1, At, B1); PG8_BAR; PG8_SCHED;
            PG8_LDA(At, 1, 1); PG8_STAGE(PG8_SB(1, 0), b3, voffB); PG8_STAGE(PG8_SB(1, 1), b3 + hstepB, voffB); PG8_STAGE(PG8_SA(1, 0), a3, voffA);
            PG8_WAIT_V(8); PG8_WAIT_L(0); PG8_BAR; PG8_MMA(1, 0, At, B0); PG8_MMA(1, 1, At, B1); PG8_BAR; PG8_SCHED;
            } else {
            PG8_LDB(B0, 0, 0); PG8_SCHED; PG8_LDA(At, 0, 0); PG8_STAGE(PG8_SA(1, 1), a1 + hstepA, voffA);
            PG8_WAIT_L(8); PG8_BAR; PG8_WAIT_L(0); PG8_MMA(0, 0, At, B0); PG8_BAR; PG8_SCHED;
            PG8_LDB(B1, 0, 1); PG8_STAGE(PG8_SB(0, 0), b2, voffB);
            PG8_BAR; PG8_WAIT_L(0); PG8_MMA(0, 1, At, B1); PG8_BAR;
            PG8_LDA(At, 0, 1); PG8_STAGE(PG8_SA(0, 0), a2, voffA);
            PG8_BAR; PG8_WAIT_L(0); PG8_MMA(1, 0, At, B0); PG8_BAR; PG8_SCHED;
            PG8_STAGE(PG8_SB(0, 1), b2 + hstepB, voffB);
            PG8_WAIT_V(6); PG8_BAR; PG8_MMA(1, 1, At, B1); PG8_BAR;
            PG8_LDB(B0, 1, 0); PG8_SCHED; PG8_LDA(At, 1, 0); PG8_STAGE(PG8_SA(0, 1), a2 + hstepA, voffA);
            PG8_WAIT_L(8); PG8_BAR; PG8_WAIT_L(0); PG8_MMA(0, 0, At, B0); PG8_BAR; PG8_SCHED;
            PG8_LDB(B1, 1, 1); PG8_STAGE(PG8_SB(1, 0), b3, voffB);
            PG8_BAR; PG8_WAIT_L(0); PG8_MMA(0, 1, At, B1); PG8_BAR;
            PG8_LDA(At, 1, 1); PG8_STAGE(PG8_SA(1, 0), a3, voffA);
            PG8_BAR; PG8_WAIT_L(0); PG8_MMA(1, 0, At, B0); PG8_BAR; PG8_SCHED;
            PG8_STAGE(PG8_SB(1, 1), b3 + hstepB, voffB);
            PG8_WAIT_V(6); PG8_BAR; PG8_MMA(1, 1, At, B1); PG8_BAR;
            }
        }
        if constexpr (ALIGN_EPI) { if (wr == 0) PG8_BAR; }
        E(acc, cur, wr, wc, fr, fq); S.done(cur);
        if (!has_next) break;
#pragma unroll
        for (int a = 0; a < 2; ++a)
#pragma unroll
            for (int b = 0; b < 2; ++b)
#pragma unroll
                for (int m = 0; m < 4; ++m)
#pragma unroll
                    for (int n = 0; n < 2; ++n) acc[a][b][m][n] = (f32x4){0.f, 0.f, 0.f, 0.f};
        cur = nxt; cA = nA; cB = nB; ++ui;
        if constexpr (ALIGN_EPI) { if (wr == 1) PG8_BAR; }
    }
    PG8_WAIT_V(0);
    if constexpr (!ALIGN_EPI) { if (wr == 0) PG8_BAR; }
    PG8_BAR;
#undef PG8_SA
#undef PG8_SB
#undef PG8_STAGE
#undef PG8_LDA
#undef PG8_LDB
#undef PG8_MMA
#undef PG8_WAIT_V
#undef PG8_WAIT_L
#undef PG8_BAR
#undef PG8_SCHED
}
}

#define XB_TMO      128
#define XB_XCNT(j)  (256  + 64 * (j))
#define XB_XSUB(j)  (1280 + 64 * (j))
#define XB_XGEN(j)  (2304 + 64 * (j))
#define XB_TOP      3328
#define XB_TOPGEN   3392
#define XCD_BAR_WORDS 3456
#define XB_SPIN_CAP (1u << 18)
__device__ __forceinline__ unsigned xb_ld(unsigned* p)              { return __hip_atomic_load(p, __ATOMIC_RELAXED, __HIP_MEMORY_SCOPE_AGENT); }
__device__ __forceinline__ unsigned xb_add(unsigned* p, unsigned v) { return __hip_atomic_fetch_add(p, v, __ATOMIC_RELAXED, __HIP_MEMORY_SCOPE_AGENT); }
__device__ __forceinline__ unsigned xb_xcc_id() { return (unsigned)__builtin_amdgcn_s_getreg((3 << 11) | 20) & 0xFu; }
#define XB_SPIN(cond, bar) do { unsigned _sp = 0; while (cond) { __builtin_amdgcn_s_sleep(1); \
    if ((++_sp & 255u) == 0u) { if (xb_ld(&(bar)[XB_TMO])) break; if (_sp > XB_SPIN_CAP) { atomicAdd(&(bar)[XB_TMO], 1u); break; } } } } while (0)
struct XcdBarrier { unsigned* bar; unsigned x; volatile LAS unsigned* st; int wv; };
__device__ __forceinline__ bool xb_thread0(int wv) { return wv == 0 && lane_fresh() == 0; }
__device__ __forceinline__ XcdBarrier xcd_barrier_post(unsigned* bar, volatile LAS unsigned* st, int wv) {
    XcdBarrier b; b.bar = bar; b.x = xb_xcc_id(); b.st = st; b.wv = wv;
    if (xb_thread0(wv)) (void)xb_add(&bar[XB_XCNT(b.x)], 1u);
    return b;
}
__device__ __forceinline__ void xcd_barrier_complete(unsigned* bar, unsigned x, unsigned& nloc, unsigned& nx) {
    const unsigned G = gridDim.x * gridDim.y * gridDim.z;
    unsigned sum, cnt, mine, sp = 0u;
    for (;;) {
        sum = 0u; cnt = 0u;
#pragma unroll
        for (unsigned j = 0; j < 16; ++j) { const unsigned c = xb_ld(&bar[XB_XCNT(j)]); sum += c; cnt += (c > 0u) ? 1u : 0u; }
        mine = xb_ld(&bar[XB_XCNT(x)]);
        if (sum == G) break;
        __builtin_amdgcn_s_sleep(1);
        if ((++sp & 255u) == 0u) { if (xb_ld(&bar[XB_TMO])) break; if (sp > XB_SPIN_CAP) { atomicAdd(&bar[XB_TMO], 1u); break; } }
    }
    nloc = mine > 0u ? mine : 1u; nx = cnt > 0u ? cnt : 1u;
}
__device__ __forceinline__ void xcd_barrier(const XcdBarrier& b) {
    asm volatile("s_waitcnt vmcnt(0)" ::: "memory");
    __syncthreads();
    if (xb_thread0(b.wv)) {
        unsigned* bar = b.bar; asm volatile("" : "+s"(bar));
        __builtin_amdgcn_s_waitcnt(0);
        unsigned nloc = b.st[0], nx = b.st[1];
        if (nloc == 0u) { xcd_barrier_complete(bar, b.x, nloc, nx); b.st[0] = nloc; b.st[1] = nx; }
        const unsigned old = xb_add(&bar[XB_XSUB(b.x)], 1u);
        const unsigned gen = old / nloc;
        if (old + 1u == (gen + 1u) * nloc) {
            __builtin_amdgcn_fence(__ATOMIC_RELEASE, "agent");
            asm volatile("s_waitcnt vmcnt(0)" ::: "memory");
            const unsigned og = xb_add(&bar[XB_TOP], 1u);
            const unsigned tg = og / nx;
            if (og + 1u == (tg + 1u) * nx) xb_add(&bar[XB_TOPGEN], 1u);
            else XB_SPIN(xb_ld(&bar[XB_TOPGEN]) == tg, bar);
            __builtin_amdgcn_fence(__ATOMIC_ACQUIRE, "agent");
            xb_add(&bar[XB_XGEN(b.x)], 1u);
            asm volatile("s_waitcnt vmcnt(0)" ::: "memory");
        } else {
            XB_SPIN(xb_ld(&bar[XB_XGEN(b.x)]) == gen, bar);
            __builtin_amdgcn_fence(__ATOMIC_ACQUIRE, "agent");
            asm volatile("s_waitcnt vmcnt(0)" ::: "memory");
        }
    }
    __syncthreads();
}

namespace att {
constexpr int KVBLK = 64, QBLK = 32, QB = 256;
constexpr int SHM_V = 16384, SHM_K = 16384, SHM_KR = 8192;
constexpr int V_OFF = 0, K_OFF = 2 * SHM_V, KR_OFF = K_OFF + 2 * SHM_K, WS_OFF = KR_OFF + 2 * SHM_KR, FLG_OFF = WS_OFF + 8 * 256, QR_OFF = FLG_OFF + 64 + 384, ATT_LDS = QR_OFF + 8 * 4096;
constexpr float SB_DONE = 0.f;
constexpr float THR2 = 11.5f;
#define KSWZ(row, colB) ((row) * 256 + ((colB) ^ ((((row) & 7) | ((((row) >> 4) & 1) << 3)) << 4)))
#define KRSWZ(row, colB) ((row) * 128 + ((colB) ^ ((((row) >> 1) & 7) << 4)))
__device__ __forceinline__ int v_st(int k, int c) { const int kk = (k & ~0xC) | ((k & 4) << 1) | ((k & 8) >> 1); return ((kk >> 3) * 4 + (c >> 5)) * 512 + ((kk & 7) * 32 + (c & 31)) * 2; }
__device__ __forceinline__ int v_rd_base(int lane) { return ((lane & 3) << 3) | (((lane >> 2) & 3) << 6) | (((lane >> 4) & 1) << 5) | (((lane >> 5) & 1) << 8); }
constexpr int v_rd_off(int d0, int ks, int half) { return d0 * 512 + ks * 4096 + half * 2048; }
__device__ __forceinline__ int crow(int r, int hi) { return (r & 3) + 8 * (r >> 2) + 4 * hi; }
__device__ __forceinline__ float xhalf(float v, int hi) {
    auto rr = __builtin_amdgcn_permlane32_swap(__float_as_uint(v), __float_as_uint(v), false, false);
    return __uint_as_float(hi ? rr[0] : rr[1]);
}
__device__ __forceinline__ void mask_tile(f32x16& p0, f32x16& p1, int dq, unsigned W) {
    const float NEG = -__builtin_inff();
#pragma unroll
    for (int r = 0; r < 16; ++r) {
        const int c = (r & 3) + 8 * (r >> 2);
        if ((unsigned)(dq - c) >= W) p0[r] = NEG;
        if ((unsigned)(dq - c - 32) >= W) p1[r] = NEG;
    }
}
#define PK4(P, B_, OUT) do { unsigned a0 = cvtpk(P[B_+0], P[B_+1]), a1 = cvtpk(P[B_+2], P[B_+3]);                          \
        unsigned b0 = cvtpk(P[B_+4], P[B_+5]), b1 = cvtpk(P[B_+6], P[B_+7]);                                             \
        auto r0 = __builtin_amdgcn_permlane32_swap(a0, b0, false, false); auto r1 = __builtin_amdgcn_permlane32_swap(a1, b1, false, false); \
        u32x4 w = {r0[0], r1[0], r0[1], r1[1]}; OUT = __builtin_bit_cast(bf16x8, w); } while (0)
__device__ __forceinline__ void softmax_tile(f32x16& p0, f32x16& p1, float& m_reg, float& l_reg, float& alpha) {
    float pmax = p0[0];
#pragma unroll
    for (int r = 1; r < 16; ++r) pmax = fmaxf(pmax, p0[r]);
#pragma unroll
    for (int r = 0; r < 16; ++r) pmax = fmaxf(pmax, p1[r]);
    { auto rr = __builtin_amdgcn_permlane32_swap(__float_as_uint(pmax), __float_as_uint(pmax), false, false);
      pmax = fmaxf(__uint_as_float(rr[0]), __uint_as_float(rr[1])); }
    float mn;
    if (__all((pmax - m_reg) <= THR2)) { mn = m_reg; alpha = 1.f; }
    else { mn = fmaxf(m_reg, pmax); alpha = __builtin_amdgcn_exp2f(m_reg - mn); m_reg = mn; }
#pragma unroll
    for (int r = 0; r < 16; ++r) p0[r] = __builtin_amdgcn_exp2f(p0[r] - mn);
#pragma unroll
    for (int r = 0; r < 16; ++r) p1[r] = __builtin_amdgcn_exp2f(p1[r] - mn);
    float ps = 0.f;
#pragma unroll
    for (int r = 0; r < 16; ++r) ps += p0[r];
#pragma unroll
    for (int r = 0; r < 16; ++r) ps += p1[r];
    { auto rr = __builtin_amdgcn_permlane32_swap(__float_as_uint(ps), __float_as_uint(ps), false, false);
      ps = __uint_as_float(rr[0]) + __uint_as_float(rr[1]); }
    l_reg = l_reg * alpha + ps;
}
__device__ __forceinline__ void sb_half(f32x16& p, float rin, float& rout, int hi) {
#pragma unroll
    for (int r = 0; r < 16; ++r) p[r] = __builtin_amdgcn_rcpf(1.f + __builtin_amdgcn_exp2f(p[r]));
    float s[4], q[4], R[4];
#pragma unroll
    for (int g = 0; g < 4; ++g) s[g] = (p[4 * g] * p[4 * g + 1]) * (p[4 * g + 2] * p[4 * g + 3]);
#pragma unroll
    for (int g = 0; g < 4; ++g) q[g] = xhalf(s[g], hi);
    R[3] = rin; R[2] = R[3] * (s[3] * q[3]); R[1] = R[2] * (s[2] * q[2]); R[0] = R[1] * (s[1] * q[1]);
    rout = R[0] * (s[0] * q[0]);
#pragma unroll
    for (int g = 0; g < 4; ++g) {
        float run = hi ? R[g] : R[g] * q[g];
#pragma unroll
        for (int i = 3; i >= 0; --i) { const float ui = p[4 * g + i]; p[4 * g + i] = (1.f - ui) * run; run *= ui; }
    }
}
__device__ __forceinline__ void sb_tile(f32x16& p0, f32x16& p1, float& carry, int hi) {
    float mid, nc;
    sb_half(p1, carry, mid, hi);
    sb_half(p0, mid, nc, hi);
    carry = nc;
}
template <bool MLA>
__device__ __forceinline__ void qkt(f32x16& p0, f32x16& p1, LAS unsigned char* lds, int KB, int r32, int hi, const bf16x8* qr, const bf16x8* qrr, bool a0, bool a1) {
    constexpr int NF = MLA ? 12 : 8, D = 8;
    const float NEG = -__builtin_inff();
    unsigned kb[4];
#pragma unroll
    for (int dd = 0; dd < 4; ++dd) kb[dd] = (unsigned)(K_OFF + KB * SHM_K + KSWZ(r32, (dd * 16 + hi * 8) * 2));
    const unsigned krb = (unsigned)(KR_OFF + KB * SHM_KR);
#define KADDR(i) ((i) < 8 ? (kb[(i) & 3] ^ ((unsigned)(((i) & 7) >> 2) << 7)) : krb + (unsigned)KRSWZ(r32, ((((i) < 8 ? 8 : (i)) - 8) * 16 + hi * 8) * 2))
#define KHOFF(i) ((i) < 8 ? 32u * 256u : 32u * 128u)
#define QFRAG(i) ((i) < 8 ? qr[(i) < 8 ? (i) : 0] : qrr[(i) < 8 ? 0 : (i) - 8])
    bf16x8 F[D];
    if (a0 && a1) {
#pragma unroll
        for (int s_ = 0; s_ < D; ++s_) F[s_] = *(const LAS bf16x8*)(lds + KADDR(s_ % NF) + (s_ / NF) * KHOFF(s_ % NF));
        SBAR();
#pragma unroll
        for (int r = 0; r < 16; ++r) { p0[r] = 0.f; p1[r] = 0.f; }
        __builtin_amdgcn_s_setprio(1);
#pragma unroll
        for (int s_ = 0; s_ < 2 * NF; ++s_) { const int i = s_ % NF;
            if (s_ < NF) p0 = __builtin_amdgcn_mfma_f32_32x32x16_bf16(F[s_ % D], QFRAG(i), p0, 0, 0, 0);
            else p1 = __builtin_amdgcn_mfma_f32_32x32x16_bf16(F[s_ % D], QFRAG(i), p1, 0, 0, 0);
            if (s_ + D < 2 * NF) F[s_ % D] = *(const LAS bf16x8*)(lds + KADDR((s_ + D) % NF) + ((s_ + D) / NF) * KHOFF((s_ + D) % NF));
            SBAR(); }
    } else if (a0) {
#pragma unroll
        for (int s_ = 0; s_ < D; ++s_) F[s_] = *(const LAS bf16x8*)(lds + KADDR(s_));
        SBAR();
#pragma unroll
        for (int r = 0; r < 16; ++r) { p0[r] = 0.f; p1[r] = NEG; }
        __builtin_amdgcn_s_setprio(1);
#pragma unroll
        for (int s_ = 0; s_ < NF; ++s_) { p0 = __builtin_amdgcn_mfma_f32_32x32x16_bf16(F[s_ % D], QFRAG(s_), p0, 0, 0, 0);
            if (s_ + D < NF) F[s_ % D] = *(const LAS bf16x8*)(lds + KADDR(s_ + D));
            SBAR(); }
    } else {
#pragma unroll
        for (int s_ = 0; s_ < D; ++s_) F[s_] = *(const LAS bf16x8*)(lds + KADDR(s_) + KHOFF(s_));
        SBAR();
#pragma unroll
        for (int r = 0; r < 16; ++r) { p1[r] = 0.f; p0[r] = NEG; }
        __builtin_amdgcn_s_setprio(1);
#pragma unroll
        for (int s_ = 0; s_ < NF; ++s_) { p1 = __builtin_amdgcn_mfma_f32_32x32x16_bf16(F[s_ % D], QFRAG(s_), p1, 0, 0, 0);
            if (s_ + D < NF) F[s_ % D] = *(const LAS bf16x8*)(lds + KADDR(s_ + D) + KHOFF(s_ + D));
            SBAR(); }
    }
    __builtin_amdgcn_s_setprio(0);
#undef KADDR
#undef KHOFF
#undef QFRAG
}
__device__ __forceinline__ void pv_tile(f32x16* o, unsigned vb0, const f32x16& p0, const f32x16& p1, bool a0, bool a1) {
#define TRRD(dst, off) asm volatile("ds_read_b64_tr_b16 %0, %1 offset:%2" : "=&v"(dst) : "v"(vb0), "i"(off) : "memory")
#define PV_RD(ks, S) do { constexpr int b_ = V_OFF + v_rd_off(0, ks, 0); \
        TRRD(S##l0, b_); TRRD(S##h0, b_ + 2048); TRRD(S##l1, b_ + 512); TRRD(S##h1, b_ + 512 + 2048); TRRD(S##l2, b_ + 1024); TRRD(S##h2, b_ + 1024 + 2048); TRRD(S##l3, b_ + 1536); TRRD(S##h3, b_ + 1536 + 2048); } while (0)
#define PV_MM(S, P, B_) do { bf16x8 pa; PK4(P, B_, pa); __builtin_amdgcn_s_setprio(1); \
        o[0] = __builtin_amdgcn_mfma_f32_32x32x16_bf16(pa, (bf16x8){S##l0[0], S##l0[1], S##l0[2], S##l0[3], S##h0[0], S##h0[1], S##h0[2], S##h0[3]}, o[0], 0, 0, 0);   \
        o[1] = __builtin_amdgcn_mfma_f32_32x32x16_bf16(pa, (bf16x8){S##l1[0], S##l1[1], S##l1[2], S##l1[3], S##h1[0], S##h1[1], S##h1[2], S##h1[3]}, o[1], 0, 0, 0);   \
        o[2] = __builtin_amdgcn_mfma_f32_32x32x16_bf16(pa, (bf16x8){S##l2[0], S##l2[1], S##l2[2], S##l2[3], S##h2[0], S##h2[1], S##h2[2], S##h2[3]}, o[2], 0, 0, 0);   \
        o[3] = __builtin_amdgcn_mfma_f32_32x32x16_bf16(pa, (bf16x8){S##l3[0], S##l3[1], S##l3[2], S##l3[3], S##h3[0], S##h3[1], S##h3[2], S##h3[3]}, o[3], 0, 0, 0); __builtin_amdgcn_s_setprio(0); } while (0)
    s16x4 Al0, Al1, Al2, Al3, Ah0, Ah1, Ah2, Ah3, Bl0, Bl1, Bl2, Bl3, Bh0, Bh1, Bh2, Bh3;
    if (a0) {
        PV_RD(0, A); PV_RD(1, B);
        asm volatile("s_waitcnt lgkmcnt(8)" ::: "memory"); SBAR(); PV_MM(A, p0, 0); SBAR();
        asm volatile("s_waitcnt lgkmcnt(0)" ::: "memory"); SBAR(); PV_MM(B, p0, 8); SBAR();
    }
    if (a1) {
        PV_RD(2, A); PV_RD(3, B);
        asm volatile("s_waitcnt lgkmcnt(8)" ::: "memory"); SBAR(); PV_MM(A, p1, 0); SBAR();
        asm volatile("s_waitcnt lgkmcnt(0)" ::: "memory"); SBAR(); PV_MM(B, p1, 8);
    }
#undef PV_MM
#undef PV_RD
#undef TRRD
}

struct Blk {
    const bf16_t* Q;
    const bf16_t* K;
    const bf16_t* V;
    bf16_t* O;
    const bf16_t* G;
    float* LSE;
    int P0;
    int dil;
    const float* ssq;
    const float* qw;
    const float* cs; const float* sn;
};
template <int MODE>
__device__ __forceinline__ void attn_block(const Blk& b, LAS unsigned char* lds, int wv) {
    constexpr bool MLA = MODE == 0, DIL = MODE == 1, SB = MODE == 2;
    constexpr int NQR = 8;
    const int qs = MLA ? UQ_N : (DIL ? b.dil * EVEN_LD : EVEN_LD), ks = MLA ? 192 : qs, vs = MLA ? 128 : qs;
    const int os = DIL ? b.dil * 2048 : DM, gs = MLA ? ODD_INP : EVEN_LD, ls = DIL ? b.dil * 16 : 0;
    const int tid = opaque_tid(wv), wid = __builtin_amdgcn_readfirstlane(tid >> 6), lane = tid & 63, r32 = lane & 31, hi = lane >> 5;
    int j_lo = 0; const int j_hi = b.P0 / KVBLK + 4;
    if (DIL) j_lo = b.P0 >= 256 ? b.P0 / KVBLK - 2 : 0;
    int NT = j_hi - j_lo;
    const int qlo = b.P0 + wid * QBLK, qm = qlo + r32 - 4 * hi;
    LAS float* wsf = (LAS float*)(lds + WS_OFF) + wid * 64; LAS float* li_l = wsf; LAS float* al_l = wsf + 32;
    const unsigned vb0 = (unsigned)(size_t)(lds + V_OFF) + (unsigned)v_rd_base(lane);
    unsigned kdo[2], vdo[2], krdo = 0u;
#pragma unroll
    for (int i = 0; i < 2; ++i) { const int row = 4 * (2 * wid + i) + (lane >> 4);
        kdo[i] = (unsigned)row * (unsigned)(ks * 2) + ((((unsigned)lane & 15u) << 4) ^ ((unsigned)((row & 7) | (((row >> 4) & 1) << 3)) << 4));
        const int key = (((lane >> 2) & 3) | (((lane >> 4) & 1) << 3)) + (((wid & 1) << 2) | ((wid >> 1) << 4));
        vdo[i] = (unsigned)key * (unsigned)(vs * 2) + (unsigned)(((2 * i + (lane >> 5)) * 32 + (lane & 3) * 8) * 2); }
    if constexpr (MLA) { const int row = 8 * wid + (lane >> 3); krdo = (unsigned)row * (unsigned)(ks * 2) + 256u + ((((unsigned)lane & 7u) << 4) ^ ((unsigned)((row >> 1) & 7) << 4)); }
#define TILE_J(t) (SB ? (j_hi - 1 - (t)) : (j_lo + (t)))
#define TDMA(j, bf) do { const char* kt_ = (const char*)b.K + (size_t)(j) * KVBLK * ks * 2; const char* vt_ = (const char*)b.V + (size_t)(j) * KVBLK * vs * 2; \
        _Pragma("unroll") for (int i_ = 0; i_ < 2; ++i_) __builtin_amdgcn_global_load_lds((const unsigned*)(kt_ + kdo[i_]), (LAS unsigned*)(lds + K_OFF + (bf) * SHM_K + (2 * wid + i_) * 1024), 16, 0, 0); \
        _Pragma("unroll") for (int i_ = 0; i_ < 2; ++i_) __builtin_amdgcn_global_load_lds((const unsigned*)(vt_ + vdo[i_]), (LAS unsigned*)(lds + V_OFF + (bf) * SHM_V + (2 * wid + i_) * 1024), 16, 0, 0); \
        if constexpr (MLA) __builtin_amdgcn_global_load_lds((const unsigned*)(kt_ + krdo), (LAS unsigned*)(lds + KR_OFF + (bf) * SHM_KR + wid * 1024), 16, 0, 0); } while (0)
    TDMA(TILE_J(0), 0);
    bf16x8 qr[NQR]; bf16x8 qrr[4];
    if constexpr (!MLA) { const bf16_t* qp = b.Q + (size_t)(wid * QBLK + r32) * qs + hi * 8;
#pragma unroll
      for (int d0 = 0; d0 < NQR; ++d0) qr[d0] = *(const bf16x8*)(qp + d0 * 16); }
    else {
      const int row = wid * QBLK + r32;
      const bf16_t* qp = b.Q + (size_t)row * qs + hi * 8;
      u32x4 raw[12];
#pragma unroll
      for (int d0 = 0; d0 < 12; ++d0) raw[d0] = *(const u32x4*)(qp + d0 * 16);
      const float rq = __builtin_amdgcn_rsqf(b.ssq[row] * (1.0f / QLORA) + EPS);
      float ss = 0.f;
#pragma unroll
      for (int d0 = 0; d0 < 12; ++d0) { float x[8]; unpack8(raw[d0], x);
#pragma unroll
          for (int e = 0; e < 8; ++e) ss += x[e] * x[e]; }
      ss += xhalf(ss, hi);
      const float sc = rq * __builtin_amdgcn_rsqf(rq * rq * ss * (1.0f / 192.0f) + EPS) * QS192;
#pragma unroll
      for (int d0 = 0; d0 < 8; ++d0) { float x[8]; unpack8(raw[d0], x); const f32x4 wa = *(const f32x4*)(b.qw + d0 * 16 + hi * 8), wb = *(const f32x4*)(b.qw + d0 * 16 + hi * 8 + 4);
#pragma unroll
          for (int e = 0; e < 4; ++e) { x[e] *= sc * wa[e]; x[4 + e] *= sc * wb[e]; }
          qr[d0] = __builtin_bit_cast(bf16x8, pack8u(x)); }
#pragma unroll
      for (int d1 = 0; d1 < 2; ++d1) { float x1[8], x2[8], o1[8], o2[8]; unpack8(raw[8 + d1], x1); unpack8(raw[10 + d1], x2);
          const int i0 = d1 * 16 + hi * 8;
#pragma unroll
          for (int e = 0; e < 8; ++e) { const float y1 = x1[e] * sc * b.qw[128 + i0 + e], y2 = x2[e] * sc * b.qw[160 + i0 + e]; const float c = b.cs[row * 32 + i0 + e], s = b.sn[row * 32 + i0 + e];
              o1[e] = y1 * c - y2 * s; o2[e] = y2 * c + y1 * s; }
          qrr[d1] = __builtin_bit_cast(bf16x8, pack8u(o1)); qrr[d1 + 2] = __builtin_bit_cast(bf16x8, pack8u(o2)); }
    }
    f32x16 o[4];
#pragma unroll
    for (int d = 0; d < 4; ++d)
#pragma unroll
        for (int r = 0; r < 16; ++r) o[d][r] = 0.f;
    float m_reg = -1e30f, l_reg = 0.f, carry = SB ? 1.f : 0.f;
#define TILE_FLAGS(t, act_, needm_, kb_) const int kb_ = TILE_J(t) * KVBLK; bool act_, needm_, a0_, a1_; \
        if (MLA) { a0_ = kb_ <= qlo + QBLK - 1; a1_ = kb_ + 32 <= qlo + QBLK - 1; needm_ = kb_ + KVBLK - 1 > qlo; } \
        else if (DIL) { a0_ = (kb_ <= qlo + QBLK - 1) && (kb_ + 31 >= qlo - 128); a1_ = (kb_ + 32 <= qlo + QBLK - 1) && (kb_ + KVBLK - 1 >= qlo - 128); \
                        needm_ = (kb_ + KVBLK - 1 > qlo) || (kb_ <= qlo + QBLK - 1 - 129); } \
        else { a0_ = kb_ <= qlo + QBLK - 2; a1_ = kb_ + 32 <= qlo + QBLK - 2; needm_ = kb_ + KVBLK - 1 > qlo - 1; } \
        act_ = a0_ || a1_;
    LAS unsigned* flg = (LAS unsigned*)(lds + FLG_OFF);
    constexpr bool NOPP = true;
    const bool h0 = NOPP ? true : (wid < 4);
#define SBDONE(td) ({ bool r_ = false; if constexpr (SB) { const u32x4 f0_ = *(const LAS u32x4*)(flg + ((td) & 1) * 8), f1_ = *(const LAS u32x4*)(flg + ((td) & 1) * 8 + 4); \
            r_ = (f0_.x & f0_.y & f0_.z & f0_.w & f1_.x & f1_.y & f1_.z & f1_.w) != 0u; } r_; })
    VM_WAIT();
    __syncthreads();
    bool stopped = false;
    for (int t = 0; t < NT; ++t) {
        if (SB && (NOPP || !h0) && t >= 1) { if (SBDONE(t - 1)) break; }
        if (t + 1 < NT) TDMA(TILE_J(t + 1), (t + 1) & 1);
        TILE_FLAGS(t, act_, needm_, kb_)
        f32x16 p0, p1;
        if (act_) qkt<MLA>(p0, p1, lds, t & 1, r32, hi, qr, qrr, a0_, a1_);
        if constexpr (!NOPP) __syncthreads();
        if (SB && !NOPP && h0 && t >= 1) { if (SBDONE(t - 1)) { stopped = true; break; } }
        if (act_) {
            if (needm_) { if (SB) mask_tile(p0, p1, qm - kb_ - 1, 0x7fffffffu); else mask_tile(p0, p1, qm - kb_, DIL ? 129u : 0x7fffffffu); }
            if constexpr (SB) { sb_tile(p0, p1, carry, hi); }
            else { float alpha_; softmax_tile(p0, p1, m_reg, l_reg, alpha_);
                if (__any(alpha_ < 1.f)) { if (hi == 0) al_l[r32] = alpha_; LDS_WAIT();
#pragma unroll
                    for (int d_ = 0; d_ < 4; ++d_)
#pragma unroll
                        for (int r = 0; r < 16; ++r) o[d_][r] *= al_l[crow(r, hi)]; } }
            pv_tile(o, vb0 + (unsigned)((t & 1) * SHM_V), p0, p1, a0_, a1_); }
        if constexpr (SB) { const bool dn_ = __all(carry <= SB_DONE); if (lane == 0) flg[(t & 1) * 8 + wid] = dn_ ? 1u : 0u; }
        VM_WAIT();
        __syncthreads();
    }
    if (!NOPP && h0 && !stopped) __syncthreads();
#undef SBDONE
#undef TILE_FLAGS
#undef TDMA
#undef TILE_J
    u32x4 gpre[8];
    if (b.G) {
#pragma unroll
        for (int i = 0; i < 8; ++i) { const int id = lane + 64 * i, row = id >> 4, c = id & 15; gpre[i] = *(const u32x4*)(b.G + (size_t)(wid * QBLK + row) * gs + c * 8); } }
    if constexpr (!SB) {
        if (hi == 0) li_l[r32] = l_reg;
        LDS_WAIT();
        if constexpr (DIL) { if (hi == 0) b.LSE[(size_t)(wid * QBLK + r32) * ls] = m_reg + __builtin_amdgcn_logf(l_reg); }
#pragma unroll
        for (int r = 0; r < 16; ++r) { const float rl = __builtin_amdgcn_rcpf(li_l[crow(r, hi)]);
#pragma unroll
            for (int d = 0; d < 4; ++d) o[d][r] *= rl; }
    }
    LAS unsigned char* ost = lds + wid * 8192;
#pragma unroll
    for (int r = 0; r < 16; ++r) { const int orow = crow(r, hi);
#pragma unroll
        for (int d = 0; d < 4; d += 2) {
            const float x = o[d][r], y = o[d + 1][r]; const bool odd = (r32 & 1) != 0;
            const float got = dpp_xor1(odd ? x : y);
            const unsigned w = odd ? cvtpk(got, y) : cvtpk(x, got);
            *(LAS unsigned*)(ost + orow * 256 + ((odd ? d + 1 : d) * 32 + (r32 & ~1)) * 2) = w; } }
    LDS_WAIT();
#pragma unroll
    for (int i = 0; i < 8; ++i) { const int id = lane + 64 * i, row = id >> 4, c = id & 15;
        u32x4 w = *(const LAS u32x4*)(ost + row * 256 + c * 16);
        if (b.G) { const u32x4 g = gpre[i]; float x[8], y[8]; unpack8(w, x); unpack8(g, y);
#pragma unroll
            for (int e = 0; e < 8; ++e) x[e] *= y[e];
            w = pack8u(x); }
        *(u32x4*)(b.O + (size_t)(wid * QBLK + row) * os + c * 8) = w; }
    __syncthreads();
}
__device__ __forceinline__ void attn_dil_wave(const Blk& b, LAS unsigned char* lds, LAS unsigned char* scratch, int wv) {
    const int qs = b.dil * EVEN_LD, os = b.dil * 2048, ls = b.dil * 16;
    const int tid = opaque_tid(wv), wid = __builtin_amdgcn_readfirstlane(tid >> 6), lane = tid & 63, r32 = lane & 31, hi = lane >> 5;
    const int qlo = b.P0, qm = qlo + r32 - 4 * hi;
    const int hlast = qlo >> 5, hfirst = qlo >= 128 ? hlast - 4 : 0, n = hlast - hfirst + 1;
    LAS unsigned char* kbuf = lds + wid * 16384; LAS unsigned char* vbuf = kbuf + 8192;
    LAS float* li_l = (LAS float*)(scratch + wid * 256); LAS float* al_l = li_l + 32;
    bf16x8 qr[8];
    { const bf16_t* qp = b.Q + (size_t)r32 * qs + hi * 8;
#pragma unroll
      for (int d0 = 0; d0 < 8; ++d0) qr[d0] = *(const bf16x8*)(qp + d0 * 16); }
    const unsigned rs2 = (unsigned)qs * 2u;
    const unsigned kl = (unsigned)(lane >> 4) * rs2 + ((((unsigned)lane & 15u) ^ ((unsigned)lane >> 4)) << 4);
    const unsigned vl = (unsigned)(((lane >> 2) & 3) | (((lane >> 4) & 1) << 3)) * rs2 + (unsigned)(((lane >> 5) * 32 + (lane & 3) * 8) * 2);
#define KDMA(hh) do { const char* kb_ = (const char*)b.K + (size_t)(hh) * 32 * rs2; _Pragma("unroll") for (int c_ = 0; c_ < 8; ++c_) \
        __builtin_amdgcn_global_load_lds((const unsigned*)(kb_ + (size_t)(4 * c_) * rs2 + (kl ^ (unsigned)(((c_ & 1) << 6) | ((c_ >> 2) << 7)))), (LAS unsigned*)(kbuf + c_ * 1024), 16, 0, 0); } while (0)
#define VDMA(hh) do { const char* vb_ = (const char*)b.V + (size_t)(hh) * 32 * rs2; _Pragma("unroll") for (int c_ = 0; c_ < 8; ++c_) \
        __builtin_amdgcn_global_load_lds((const unsigned*)(vb_ + (size_t)((((c_ >> 1) & 1) << 2) | ((c_ >> 2) << 4)) * rs2 + (c_ & 1) * 128 + vl), (LAS unsigned*)(vbuf + c_ * 1024), 16, 0, 0); } while (0)
    KDMA(hfirst); VDMA(hfirst);
    f32x16 o[4];
#pragma unroll
    for (int d = 0; d < 4; ++d)
#pragma unroll
        for (int r = 0; r < 16; ++r) o[d][r] = 0.f;
    float m_reg = -1e30f, l_reg = 0.f;
    const unsigned vb0 = (unsigned)(size_t)vbuf + (unsigned)v_rd_base(lane);
    unsigned kb[4];
#pragma unroll
    for (int dd = 0; dd < 4; ++dd) kb[dd] = (unsigned)(wid * 16384 + KSWZ(r32, (dd * 16 + hi * 8) * 2));
    const float NEG = -__builtin_inff();
    for (int i = 0; i < n; ++i) { const int hh = hfirst + i; const bool more = i + 1 < n;
        asm volatile("s_waitcnt vmcnt(8)" ::: "memory");
        f32x16 p;
#pragma unroll
        for (int r = 0; r < 16; ++r) p[r] = 0.f;
        { bf16x8 F[8];
#pragma unroll
          for (int d0 = 0; d0 < 8; ++d0) F[d0] = *(const LAS bf16x8*)(lds + (kb[d0 & 3] ^ ((unsigned)(d0 >> 2) << 7)));
          SBAR();
          __builtin_amdgcn_s_setprio(1);
#pragma unroll
          for (int d0 = 0; d0 < 8; ++d0) p = __builtin_amdgcn_mfma_f32_32x32x16_bf16(F[d0], qr[d0], p, 0, 0, 0);
          __builtin_amdgcn_s_setprio(0); }
        LDS_WAIT(); asm volatile("" ::: "memory");
        if (more) KDMA(hh + 1);
        if (hh == hlast || hh * 32 < qlo + 31 - 128) { const int dq = qm - hh * 32;
#pragma unroll
            for (int r = 0; r < 16; ++r) { const int c = (r & 3) + 8 * (r >> 2); if ((unsigned)(dq - c) >= 129u) p[r] = NEG; } }
        { float pmax = p[0];
#pragma unroll
          for (int r = 1; r < 16; ++r) pmax = fmaxf(pmax, p[r]);
          { auto rr = __builtin_amdgcn_permlane32_swap(__float_as_uint(pmax), __float_as_uint(pmax), false, false); pmax = fmaxf(__uint_as_float(rr[0]), __uint_as_float(rr[1])); }
          float mn, alpha;
          if (__all((pmax - m_reg) <= THR2)) { mn = m_reg; alpha = 1.f; }
          else { mn = fmaxf(m_reg, pmax); alpha = __builtin_amdgcn_exp2f(m_reg - mn); m_reg = mn; }
#pragma unroll
          for (int r = 0; r < 16; ++r) p[r] = __builtin_amdgcn_exp2f(p[r] - mn);
          float ps = 0.f;
#pragma unroll
          for (int r = 0; r < 16; ++r) ps += p[r];
          { auto rr = __builtin_amdgcn_permlane32_swap(__float_as_uint(ps), __float_as_uint(ps), false, false); ps = __uint_as_float(rr[0]) + __uint_as_float(rr[1]); }
          l_reg = l_reg * alpha + ps;
          if (__any(alpha < 1.f)) { if (hi == 0) al_l[r32] = alpha; LDS_WAIT();
#pragma unroll
              for (int d_ = 0; d_ < 4; ++d_)
#pragma unroll
                  for (int r = 0; r < 16; ++r) o[d_][r] *= al_l[crow(r, hi)];
              LDS_WAIT(); } }
        if (more) asm volatile("s_waitcnt vmcnt(8)" ::: "memory"); else asm volatile("s_waitcnt vmcnt(0)" ::: "memory");
        pv_tile(o, vb0, p, p, true, false);
        LDS_WAIT(); asm volatile("" ::: "memory");
        if (more) VDMA(hh + 1);
    }
#undef KDMA
#undef VDMA
    if (hi == 0) li_l[r32] = l_reg;
    LDS_WAIT();
    if (hi == 0) b.LSE[(size_t)r32 * ls] = m_reg + __builtin_amdgcn_logf(l_reg);
#pragma unroll
    for (int r = 0; r < 16; ++r) { const float rl = __builtin_amdgcn_rcpf(li_l[crow(r, hi)]);
#pragma unroll
        for (int d = 0; d < 4; ++d) o[d][r] *= rl; }
    LAS unsigned char* ost = kbuf;
#pragma unroll
    for (int r = 0; r < 16; ++r) { const int orow = crow(r, hi);
#pragma unroll
        for (int d = 0; d < 4; d += 2) {
            const float x = o[d][r], y = o[d + 1][r]; const bool odd = (r32 & 1) != 0;
            const float got = dpp_xor1(odd ? x : y);
            const unsigned w = odd ? cvtpk(got, y) : cvtpk(x, got);
            *(LAS unsigned*)(ost + orow * 256 + ((odd ? d + 1 : d) * 32 + (r32 & ~1)) * 2) = w; } }
    LDS_WAIT();
#pragma unroll 2
    for (int i = 0; i < 8; ++i) { const int id = lane + 64 * i, row = id >> 4, c = id & 15;
        const u32x4 w = *(const LAS u32x4*)(ost + row * 256 + c * 16);
        *(u32x4*)(b.O + (size_t)row * os + c * 8) = w; }
    LDS_WAIT(); asm volatile("" ::: "memory");
}
}

struct Args { const void* in[18]; float* out; unsigned char* ws; int ph_lo, ph_hi; };
typedef const __attribute__((address_space(4))) Args CArgs;
__device__ __forceinline__ CArgs* kargs() { CArgs* p = (CArgs*)__builtin_amdgcn_kernarg_segment_ptr(); asm volatile("" : "+s"(p)); return p; }
enum { IN_X = 0, IN_C, IN_POS, IN_ADAW, IN_ADAB, IN_NORMW, IN_EVWIN, IN_EVQN, IN_EVKN, IN_EVWOUT, IN_ODWIN, IN_ODQLN, IN_ODKVLN, IN_ODWUQ, IN_ODWUKV, IN_ODQN, IN_ODKN, IN_ODWOUT };

struct Frame {
    LAS unsigned char* lds;
    int tid, lane, wave, vcu, G, wv;
    unsigned char* ws;
    __device__ __forceinline__ void refresh() { tid = opaque_tid(wv); lane = tid & 63; wave = __builtin_amdgcn_readfirstlane(tid >> 6); }
};

__device__ __forceinline__ void transpose_item(const float* W, int N, const float* kscale, bf16_t* Bt, int ldb, int k0, int n0, int brow0, LAS unsigned char* scr, int lane, int dl_perm = -1) {
    const int kq = lane >> 4, nq = lane & 15;
    f32x4 v[16];
#pragma unroll
    for (int i = 0; i < 16; ++i) { const int k = 8 * (i >> 1) + 2 * kq + (i & 1); v[i] = __builtin_nontemporal_load((const f32x4*)(W + (size_t)(k0 + k) * N + n0 + 4 * nq)); }
#pragma unroll
    for (int i = 0; i < 8; ++i) { const int k = 8 * i + 2 * kq; f32x4 a = v[2 * i], c = v[2 * i + 1];
        if (kscale) { const float s0 = kscale[k0 + k], s1 = kscale[k0 + k + 1]; a = a * s0; c = c * s1; }
#pragma unroll
        for (int j = 0; j < 4; ++j) *(LAS unsigned*)(scr + (4 * nq + j) * 144 + k * 2) = cvtpk(a[j], c[j]); }
    LDS_WAIT(); asm volatile("" ::: "memory");
#pragma unroll
    for (int jj = 0; jj < 8; ++jj) { const int n = (lane >> 3) + 8 * jj, c = lane & 7;
        const u32x4 w = *(const LAS u32x4*)(scr + n * 144 + c * 16);
        const int drow = dl_perm < 0 ? brow0 + n : (dl_perm == 2 ? brow0 + 8 * ((n & 31) >> 2) + (n & 3) + 4 * (n >> 5) : brow0 + 8 * (n >> 2) + (n & 3) + 4 * dl_perm);
        *(u32x4*)(Bt + (size_t)drow * ldb + k0 + 8 * c) = w; }
    LDS_WAIT(); asm volatile("" ::: "memory");
}

__device__ __forceinline__ void phase_prologue(Frame& F, CArgs& a) {
    F.refresh();
    const float* cvec = (const float*)a.in[IN_C];
    const float* adaw = (const float*)a.in[IN_ADAW]; const float* adab = (const float*)a.in[IN_ADAB];
    LAS float* sl = (LAS float*)F.lds;
    LAS float* red = (LAS float*)(F.lds + 32768);
    for (int i = F.tid; i < 2 * DM; i += NTHR) sl[i] = silu_f(cvec[i]);
    __syncthreads();
    float* MOD = (float*)(F.ws + WS_MOD);
    for (int item = F.vcu; item < DEPTH * 192; item += F.G) {
        const int l = item / 192, ct = item % 192, cq = F.tid & 15, ir = F.tid >> 4;
        const float* wp = adaw + ((size_t)l * DM + ir) * 12288 + ct * 64 + cq * 4;
        f32x4 a0 = {0.f, 0.f, 0.f, 0.f}, a1 = {0.f, 0.f, 0.f, 0.f};
#pragma unroll 8
        for (int k = 0; k < 128; ++k) { const f32x4 w = __builtin_nontemporal_load((const f32x4*)(wp + (size_t)(32 * k) * 12288)); const float s0 = sl[ir + 32 * k], s1 = sl[DM + ir + 32 * k]; a0 += w * s0; a1 += w * s1; }
#pragma unroll
        for (int j = 0; j < 4; ++j) { red[(ir * 64 + cq * 4 + j) * 2 + 0] = a0[j]; red[(ir * 64 + cq * 4 + j) * 2 + 1] = a1[j]; }
        __syncthreads();
        if (F.tid < 128) { const int col = F.tid & 63, bb = F.tid >> 6; float s = 0.f;
#pragma unroll 8
            for (int r = 0; r < 32; ++r) s += red[(r * 64 + col) * 2 + bb];
            MOD[(size_t)(l * 2 + bb) * 12288 + ct * 64 + col] = s + adab[l * 12288 + ct * 64 + col]; }
        __syncthreads();
    }
    LAS unsigned char* scr = F.lds + F.wave * 9216;
    const int gw = F.vcu * NWAVES + F.wave, NGW = F.G * NWAVES;
    constexpr int I_EVIN = (DM / 64) * (EVEN_IN / 64), I_EVOUT = (DM / 64) * (DM / 64), I_ODIN = (DM / 64) * (ODD_IN / 64), I_UQ = (QLORA / 64) * (UQ_N / 64), I_UKV = (KVLORA / 64) * (UKV_N / 64), I_ODOUT = I_EVOUT;
    constexpr int I_PER = I_EVIN + I_EVOUT + I_ODIN + I_UQ + I_UKV + I_ODOUT;
    for (int it = gw; it < 2 * I_PER; it += NGW) {
        const int i = it / I_PER; int r = it % I_PER;
        if (r < I_EVIN) { const int nb = EVEN_IN / 64, kb = r / nb, nn = r % nb;
            const int n0 = nn * 64; const bool dl = n0 >= EC_QDL && n0 < EC_VDL;
            transpose_item((const float*)a.in[IN_EVWIN] + (size_t)i * DM * EVEN_IN, EVEN_IN, nullptr, (bf16_t*)(F.ws + WS_WEVIN) + (size_t)i * EVEN_IN * DM, DM, kb * 64, n0, dl ? (n0 & ~127) : n0, scr, F.lane, dl ? ((n0 >> 6) & 1) : -1); continue; } r -= I_EVIN;
        if (r < I_EVOUT) { const int nb = DM / 64, kb = r / nb, nn = r % nb;
            transpose_item((const float*)a.in[IN_EVWOUT] + (size_t)i * DM * DM, DM, nullptr, (bf16_t*)(F.ws + WS_WEVOUT) + (size_t)i * DM * DM, DM, kb * 64, nn * 64, nn * 64, scr, F.lane); continue; } r -= I_EVOUT;
        if (r < I_ODIN) { const int nb = ODD_IN / 64, kb = r / nb, nn = r % nb; const int n0 = nn * 64;
            const int brow = n0 < 1536 ? n0 : (n0 < 1600 ? OC_KPE + (n0 - 1536) : n0 - 64);
            transpose_item((const float*)a.in[IN_ODWIN] + (size_t)i * DM * ODD_IN, ODD_IN, nullptr, (bf16_t*)(F.ws + WS_WODIN) + (size_t)i * ODD_INP * DM, DM, kb * 64, n0, brow, scr, F.lane, n0 == 1536 ? 2 : -1); continue; } r -= I_ODIN;
        if (r < I_UQ) { const int nb = UQ_N / 64, kb = r / nb, nn = r % nb;
            transpose_item((const float*)a.in[IN_ODWUQ] + (size_t)i * QLORA * UQ_N, UQ_N, (const float*)a.in[IN_ODQLN] + i * QLORA, (bf16_t*)(F.ws + WS_WUQ) + (size_t)i * UQ_N * QLORA, QLORA, kb * 64, nn * 64, nn * 64, scr, F.lane); continue; } r -= I_UQ;
        if (r < I_UKV) { const int nb = UKV_N / 64, kb = r / nb, nn = r % nb;
            transpose_item((const float*)a.in[IN_ODWUKV] + (size_t)i * KVLORA * UKV_N, UKV_N, (const float*)a.in[IN_ODKVLN] + i * KVLORA, (bf16_t*)(F.ws + WS_WUKV) + (size_t)i * UKV_N * KVLORA, KVLORA, kb * 64, nn * 64, nn * 64, scr, F.lane); continue; } r -= I_UKV;
        { const int nb = DM / 64, kb = r / nb, nn = r % nb;
            transpose_item((const float*)a.in[IN_ODWOUT] + (size_t)i * DM * DM, DM, nullptr, (bf16_t*)(F.ws + WS_WODOUT) + (size_t)i * DM * DM, DM, kb * 64, nn * 64, nn * 64, scr, F.lane); }
    }
    const size_t gt = (size_t)F.vcu * NTHR + F.tid, NGT = (size_t)F.G * NTHR;
    for (size_t i = gt; i < (size_t)2 * 192 * DM / 8; i += NGT) { const size_t li = i / (192 * DM / 8), rem = i % (192 * DM / 8);
        *(u32x4*)((bf16_t*)(F.ws + WS_WODIN) + li * (size_t)ODD_INP * DM + (size_t)ODD_IN * DM + rem * 8) = (u32x4){0u, 0u, 0u, 0u}; }
    const int* pos = (const int*)a.in[IN_POS];
    for (size_t i = gt; i < (size_t)MTOK * 96; i += NGT) { const int tok = (int)(i / 96), j = (int)(i % 96);
        const float p = (float)pos[tok];
        if (j < 64) { const float inv = (float)pow(10000.0, -(double)j / 64.0); const float ang = p * inv;
            ((_Float16*)(F.ws + WS_COSF))[tok * 64 + j] = (_Float16)(float)cos((double)ang); ((_Float16*)(F.ws + WS_SINF))[tok * 64 + j] = (_Float16)(float)sin((double)ang); }
        else { const int jj = j - 64; const float inv = (float)pow(10000.0, -(double)jj / 32.0); const float ang = p * inv;
            ((float*)(F.ws + WS_COSM))[tok * 32 + jj] = (float)cos((double)ang); ((float*)(F.ws + WS_SINM))[tok * 32 + jj] = (float)sin((double)ang); } }
}

__device__ __forceinline__ void phase_h(Frame& F, CArgs& a, int layer, const float* xsrc) {
    F.refresh();
    const float* MOD = (const float*)(F.ws + WS_MOD); const float* nw = (const float*)a.in[IN_NORMW] + layer * DM;
    bf16_t* H = (bf16_t*)(F.ws + WS_H);
    LAS float* Acol = (LAS float*)F.lds; LAS float* Scol = Acol + DM;
    int cur_b = -1;
    for (int rb = F.vcu; rb < MTOK / 32; rb += F.G) {
        const int bb = rb / (SEQ / 32);
        if (bb != cur_b) { __syncthreads();
            const float* mp = MOD + (size_t)(layer * 2 + bb) * 12288;
            for (int i = F.tid; i < DM; i += NTHR) { Acol[i] = nw[i] * (1.0f + mp[DM + i]); Scol[i] = mp[i]; }
            __syncthreads(); cur_b = bb; }
#pragma unroll 1
        for (int rr = 0; rr < 4; ++rr) { const int row = rb * 32 + F.wave * 4 + rr;
            if (xsrc) {
            const f32x4* xr = (const f32x4*)(xsrc + (size_t)row * DM) + F.lane;
            f32x4 v[16]; float s = 0.f;
#pragma unroll
            for (int j = 0; j < 16; ++j) { v[j] = __builtin_nontemporal_load(xr + 64 * j); s += (v[j][0] * v[j][0] + v[j][1] * v[j][1]) + (v[j][2] * v[j][2] + v[j][3] * v[j][3]); }
            const float rinv = __builtin_amdgcn_rsqf(wave_sum(s) * (1.0f / DM) + EPS);
            u32x2* o8 = (u32x2*)(H + (size_t)row * DM) + F.lane;
#pragma unroll
            for (int j = 0; j < 16; ++j) { const int c = 4 * F.lane + 256 * j; const f32x4 A = *(const LAS f32x4*)(Acol + c), Sh = *(const LAS f32x4*)(Scol + c);
                const f32x4 h = v[j] * rinv * A + Sh; u32x2 w; w.x = cvtpk(h[0], h[1]); w.y = cvtpk(h[2], h[3]); o8[64 * j] = w; }
            } else {
            const u32x4* xr = (const u32x4*)((const unsigned short*)(F.ws + WS_XH) + (size_t)row * DM) + F.lane;
            u32x4 r[8]; float s = 0.f;
#pragma unroll
            for (int j = 0; j < 8; ++j) r[j] = __builtin_nontemporal_load(xr + 64 * j);
#pragma unroll
            for (int j = 0; j < 8; ++j) { const float a0 = h_lo(r[j].x), a1 = h_hi(r[j].x), a2 = h_lo(r[j].y), a3 = h_hi(r[j].y), a4 = h_lo(r[j].z), a5 = h_hi(r[j].z), a6 = h_lo(r[j].w), a7 = h_hi(r[j].w);
                s += ((a0 * a0 + a1 * a1) + (a2 * a2 + a3 * a3)) + ((a4 * a4 + a5 * a5) + (a6 * a6 + a7 * a7)); }
            const float rinv = __builtin_amdgcn_rsqf(wave_sum(s) * (1.0f / DM) + EPS);
            u32x4* o16 = (u32x4*)(H + (size_t)row * DM) + F.lane;
#pragma unroll
            for (int j = 0; j < 8; ++j) { const int c = 8 * F.lane + 512 * j;
                const f32x4 A0 = *(const LAS f32x4*)(Acol + c), A1 = *(const LAS f32x4*)(Acol + c + 4), S0 = *(const LAS f32x4*)(Scol + c), S1 = *(const LAS f32x4*)(Scol + c + 4);
                const f32x4 x0 = {h_lo(r[j].x), h_hi(r[j].x), h_lo(r[j].y), h_hi(r[j].y)}, x1 = {h_lo(r[j].z), h_hi(r[j].z), h_lo(r[j].w), h_hi(r[j].w)};
                const f32x4 h0 = x0 * rinv * A0 + S0, h1 = x1 * rinv * A1 + S1; u32x4 w; w.x = cvtpk(h0[0], h0[1]); w.y = cvtpk(h0[2], h0[3]); w.z = cvtpk(h1[0], h1[1]); w.w = cvtpk(h1[2], h1[3]); o16[64 * j] = w; }
            }
        }
    }
    __syncthreads();
}

__device__ __forceinline__ void phase_attn_even(Frame& F) {
    asm volatile("" : "+s"(F.ws), "+s"(F.vcu));
    bf16_t* P = (bf16_t*)(F.ws + WS_PROJ); bf16_t* MX = (bf16_t*)(F.ws + WS_MIXED); bf16_t* ODL = (bf16_t*)(F.ws + WS_ODL); float* LSE = (float*)(F.ws + WS_LSE);
    for (int it = F.vcu; it < 256; it += F.G) { const int bh = it >> 3, x = it & 7, bb = bh >> 4, h = bh & 15;
        for (int pass = 0; pass < 2; ++pass) { const int qb = pass ? x : 15 - x;
            att::Blk k; const size_t t0 = (size_t)bb * SEQ + (size_t)qb * 256;
            k.Q = P + t0 * EVEN_LD + EC_QSB + h * 128;
            k.K = P + (size_t)bb * SEQ * EVEN_LD + EC_KSB + h * 128;
            k.V = P + (size_t)bb * SEQ * EVEN_LD + EC_VSB + h * 128;
            k.O = MX + t0 * DM + h * 128;
            k.G = P + t0 * EVEN_LD + EC_GSB + h * 128;
            k.LSE = nullptr; k.P0 = qb * 256; k.dil = 1; k.ssq = nullptr; k.qw = nullptr; k.cs = nullptr; k.sn = nullptr;
            att::attn_block<2>(k, F.lds, F.wv); } }
    for (int it = F.vcu; it < 256; it += F.G) { const int bh = it >> 3, kr = it & 7, bb = bh >> 4, h = bh & 15;
#pragma unroll 1
        for (int i = 0; i < 6; ++i) { const int sg = F.wv + 8 * i, pat = sg >> 4, j = sg & 15;
            const int dil = pat == 0 ? 1 : (pat == 1 ? 4 : 16); const int r = pat == 0 ? 0 : (pat == 1 ? (j >> 2) : j);
            const int P0 = pat == 0 ? 512 * kr + 32 * j : (pat == 1 ? 128 * kr + 32 * (j & 3) : 32 * kr);
            att::Blk k; const size_t tb = (size_t)bb * SEQ + r, t0 = tb + (size_t)P0 * dil;
            k.Q = P + t0 * EVEN_LD + EC_QDL + h * 128;
            k.K = P + tb * EVEN_LD + EC_KDL + h * 128;
            k.V = P + tb * EVEN_LD + EC_VDL + h * 128;
            k.O = ODL + (size_t)pat * MTOK * 2048 + t0 * 2048 + h * 128;
            k.G = nullptr;
            k.LSE = LSE + (size_t)pat * MTOK * 16 + t0 * 16 + h;  k.P0 = P0; k.dil = dil; k.ssq = nullptr; k.qw = nullptr; k.cs = nullptr; k.sn = nullptr;
            att::attn_dil_wave(k, F.lds, F.lds + XCH_OFF, F.wv); }
        asm volatile("s_waitcnt vmcnt(0)" ::: "memory");
        __syncthreads();
        F.refresh();
        const size_t tokb = (size_t)bb * SEQ + (size_t)kr * 512;
#pragma unroll 1
        for (int u0 = 0; u0 < 16; u0 += 2) {
            u32x4 r0[2], r1[2], r2[2], rg[2]; float l0[2], l1[2], l2[2]; size_t oo[2];
#pragma unroll
            for (int u = 0; u < 2; ++u) { const int idx = F.tid + NTHR * (u0 + u), c = idx & 15; const size_t tok = tokb + (idx >> 4);
                l0[u] = LSE[tok * 16 + h]; l1[u] = LSE[(size_t)MTOK * 16 + tok * 16 + h]; l2[u] = LSE[(size_t)2 * MTOK * 16 + tok * 16 + h];
                r0[u] = *(const u32x4*)(ODL + tok * 2048 + h * 128 + c * 8);
                r1[u] = *(const u32x4*)(ODL + (size_t)MTOK * 2048 + tok * 2048 + h * 128 + c * 8);
                r2[u] = *(const u32x4*)(ODL + (size_t)2 * MTOK * 2048 + tok * 2048 + h * 128 + c * 8);
                rg[u] = __builtin_nontemporal_load((const u32x4*)(P + tok * EVEN_LD + EC_GDL + h * 128 + c * 8));
                oo[u] = tok * DM + 2048 + h * 128 + c * 8; }
#pragma unroll
            for (int u = 0; u < 2; ++u) {
                const float mx = fmaxf(l0[u], fmaxf(l1[u], l2[u]));
                float w0 = __builtin_amdgcn_exp2f(l0[u] - mx), w1 = __builtin_amdgcn_exp2f(l1[u] - mx), w2 = __builtin_amdgcn_exp2f(l2[u] - mx);
                const float inv = 1.0f / (w0 + w1 + w2); w0 *= inv; w1 *= inv; w2 *= inv;
                float x0[8], x1[8], x2[8], g[8], o[8];
                unpack8(r0[u], x0); unpack8(r1[u], x1); unpack8(r2[u], x2); unpack8(rg[u], g);
#pragma unroll
                for (int e = 0; e < 8; ++e) o[e] = (w0 * x0[e] + w1 * x1[e] + w2 * x2[e]) * g[e];
                *(u32x4*)(MX + oo[u]) = pack8u(o);
            }
        }
        __syncthreads();
    }
}
__device__ __forceinline__ void phase_attn_mla(Frame& F, CArgs& a, int lp) {
    asm volatile("" : "+s"(F.ws), "+s"(F.vcu));
    const bf16_t* QR = (const bf16_t*)(F.ws + WS_QRAW); const bf16_t* KF = (const bf16_t*)(F.ws + WS_KF); const bf16_t* VF = (const bf16_t*)(F.ws + WS_VF);
    const bf16_t* P2 = (const bf16_t*)(F.ws + WS_PROJ); bf16_t* MX = (bf16_t*)(F.ws + WS_MIXED);
    const float* ssq = (const float*)(F.ws + WS_CTL + CTL_SSQCQ) + (size_t)lp * MTOK;
    for (int it = F.vcu; it < 512; it += F.G) { const int bh = it >> 3, x = it & 7, bb = bh >> 5, h = bh & 31;
        for (int pass = 0; pass < 2; ++pass) { const int qb = pass ? x : 15 - x;
            att::Blk k; const size_t t0 = (size_t)bb * SEQ + (size_t)qb * 256;
            k.Q = QR + t0 * UQ_N + h * 192;
            k.K = KF + (size_t)bh * SEQ * 192;
            k.V = VF + (size_t)bh * SEQ * 128;
            k.O = MX + t0 * DM + h * 128;
            k.G = P2 + t0 * ODD_INP + OC_G + h * 128;
            k.LSE = nullptr; k.P0 = qb * 256; k.dil = 1;
            k.ssq = ssq + t0; k.qw = (const float*)a.in[IN_ODQN] + lp * 192; k.cs = (const float*)(F.ws + WS_COSM) + t0 * 32; k.sn = (const float*)(F.ws + WS_SINM) + t0 * 32;
            att::attn_block<0>(k, F.lds, F.wv); } }
}

__device__ __forceinline__ void gemm_even_in(Frame& F, CArgs& a, int lp) {
    pg8::Gemm g{(const bf16_t*)(F.ws + WS_H), (const bf16_t*)(F.ws + WS_WEVIN) + (size_t)lp * EVEN_IN * DM, MTOK, EVEN_IN, DM, DM, DM};
    pg8::StaticOrder S; S.init(MTOK, EVEN_IN, F.G, (int)blockIdx.x);
    pg8::EpiEvenIn E{(bf16_t*)(F.ws + WS_PROJ), (const float*)a.in[IN_EVQN] + lp * 128, (const float*)a.in[IN_EVKN] + lp * 128,
                     (const unsigned short*)(F.ws + WS_COSF), (const unsigned short*)(F.ws + WS_SINF), F.lds + XCH_OFF};
    pg8::gemm_phase<pg8::EpiEvenIn, pg8::StaticOrder>(F.lds, g, S, E, F.wv);
}
__device__ __forceinline__ void gemm_odd_in(Frame& F, CArgs& a, int lp) {
    pg8::Gemm g{(const bf16_t*)(F.ws + WS_H), (const bf16_t*)(F.ws + WS_WODIN) + (size_t)lp * ODD_INP * DM, MTOK, ODD_INP, DM, DM, DM};
    pg8::StaticOrder S; S.init(MTOK, ODD_INP, F.G, (int)blockIdx.x);
    pg8::EpiBf16Op E{(bf16_t*)(F.ws + WS_PROJ), ODD_INP, 2, (const float*)a.in[IN_ODKN] + lp * 192, (const float*)(F.ws + WS_COSM), (const float*)(F.ws + WS_SINM), (float*)(F.ws + WS_CTL + CTL_SSQCQ) + (size_t)lp * MTOK, (float*)(F.ws + WS_CTL + CTL_SSQKV) + (size_t)lp * 2 * MTOK, (float*)(F.ws + WS_CTL + CTL_SSQKV) + (size_t)lp * 2 * MTOK + 1};
    pg8::gemm_phase<pg8::EpiBf16Op, pg8::StaticOrder>(F.lds, g, S, E, F.wv);
}
__device__ __forceinline__ void gemm_odd_up(Frame& F, CArgs& a, int lp) {
    { pg8::Gemm g{(const bf16_t*)(F.ws + WS_PROJ) + OC_CQ, (const bf16_t*)(F.ws + WS_WUQ) + (size_t)lp * UQ_N * QLORA, MTOK, UQ_N, QLORA, ODD_INP, QLORA};
      pg8::StaticOrder S; S.init(MTOK, UQ_N, F.G, (int)blockIdx.x);
      pg8::EpiBf16Op E{(bf16_t*)(F.ws + WS_QRAW), UQ_N, 0, nullptr, nullptr, nullptr, nullptr, nullptr, nullptr};
      pg8::gemm_phase<pg8::EpiBf16Op, pg8::StaticOrder>(F.lds, g, S, E, F.wv); }
    { pg8::Gemm g{(const bf16_t*)(F.ws + WS_PROJ) + OC_CKV, (const bf16_t*)(F.ws + WS_WUKV) + (size_t)lp * UKV_N * KVLORA, MTOK, UKV_N, KVLORA, ODD_INP, KVLORA};
      pg8::StaticOrder S; S.init(MTOK, UKV_N, F.G, (int)blockIdx.x);
      pg8::EpiKV E{(bf16_t*)(F.ws + WS_KF), (bf16_t*)(F.ws + WS_VF), (const bf16_t*)(F.ws + WS_PROJ), (const float*)(F.ws + WS_CTL + CTL_SSQKV) + (size_t)lp * 2 * MTOK, nullptr,
                   (const float*)a.in[IN_ODKN] + lp * 192, (const float*)(F.ws + WS_COSM), (const float*)(F.ws + WS_SINM), F.lds + XCH_OFF};
      pg8::gemm_phase<pg8::EpiKV, pg8::StaticOrder>(F.lds, g, S, E, F.wv); }
}
__device__ __forceinline__ void gemm_out(Frame& F, const bf16_t* Wt, const float* xs32, float* xo32, const float* gate) {
    unsigned short* XH = (unsigned short*)(F.ws + WS_XH);
    pg8::Gemm g{(const bf16_t*)(F.ws + WS_MIXED), Wt, MTOK, DM, DM, DM, DM};
    pg8::StaticOrder S; S.init(MTOK, DM, F.G, (int)blockIdx.x);
    pg8::EpiResid E{xs32, xs32 ? nullptr : XH, xo32, xo32 ? nullptr : XH, gate};
    pg8::gemm_phase<pg8::EpiResid, pg8::StaticOrder>(F.lds, g, S, E, F.wv);
}

constexpr int N_PHASES = 25;
#ifndef REPEAT_MASK
#define REPEAT_MASK 0
#endif
#define REP(idx) ((REPEAT_MASK >> (idx)) & 1)
__global__ void __launch_bounds__(NTHR, 2) mega_fwd(Args args) {
    extern __shared__ __attribute__((aligned(16))) unsigned char lds_raw[];
    Frame F;
    F.lds = (LAS unsigned char*)lds_raw;
    F.tid = threadIdx.x; F.lane = F.tid & 63; F.wave = __builtin_amdgcn_readfirstlane(F.tid >> 6); F.wv = F.wave;
    F.G = gridDim.x; { const int bx = blockIdx.x; F.vcu = (F.G % 8 == 0) ? (bx % 8) * (F.G / 8) + bx / 8 : bx; }
    F.ws = args.ws;
    for (int u = F.tid; u < (LDS_BYTES - LDSCTL_OFF) / 4; u += NTHR) ((LAS unsigned*)(F.lds + LDSCTL_OFF))[u] = 0u;
    __syncthreads();
    const int lo = args.ph_lo, hi = args.ph_hi;
    XcdBarrier bar; bar.bar = (unsigned*)(F.ws + WS_CTL) + CW_BAR; bar.x = 0; bar.st = nullptr; bar.wv = F.wv;
    if (hi - lo > 1) bar = xcd_barrier_post((unsigned*)(F.ws + WS_CTL) + CW_BAR, (volatile LAS unsigned*)(F.lds + MISC_OFF) + 8, F.wv);
#define IN(k) (lo <= (k) && (k) < hi)
#define SEAM(k) do { if (IN(k) && IN((k) + 1)) xcd_barrier(bar); } while (0)
    const float* xin = (const float*)args.in[IN_X];
    float* xout = args.out;
    const float* MOD = (const float*)(F.ws + WS_MOD);

#define KA (*kargs())
#define RUN(k, idx, BODY) do { if (IN(k)) { BODY; if (REP(idx)) { xcd_barrier(bar); BODY; } } SEAM(k); } while (0)
    RUN(0, 0, phase_prologue(F, KA));

    for (int lp = 0; lp < 2; ++lp) {
        const int base = 1 + 12 * lp;
        { const int layer = 2 * lp; const float* xs = (layer == 0) ? xin : nullptr;
        RUN(base + 0, 1, phase_h(F, KA, layer, xs));
        RUN(base + 1, 2, gemm_even_in(F, KA, lp));
        RUN(base + 3, 4, phase_attn_even(F));
        RUN(base + 5, 6, gemm_out(F, (const bf16_t*)(F.ws + WS_WEVOUT) + (size_t)lp * DM * DM, xs, nullptr, MOD + (size_t)(layer * 2) * 12288 + 2 * DM));
        }
        { const int layer = 2 * lp + 1;
        RUN(base + 6, 7, phase_h(F, KA, layer, nullptr));
        RUN(base + 7, 8, gemm_odd_in(F, KA, lp));
        RUN(base + 8, 9, gemm_odd_up(F, KA, lp));
        RUN(base + 10, 11, phase_attn_mla(F, KA, lp));
        RUN(base + 11, 12, gemm_out(F, (const bf16_t*)(F.ws + WS_WODOUT) + (size_t)lp * DM * DM, nullptr, (lp == 1) ? xout : nullptr, MOD + (size_t)(layer * 2) * 12288 + 2 * DM));
        }
    }
#undef RUN
#undef KA
#undef IN
#undef SEAM
}

extern "C" void kernel_launch(void* const* d_in, const int* in_sizes, int n_in, void* d_out, int out_size, void* d_ws, size_t ws_size, hipStream_t stream) {
    static int grid = 0;
    if (grid == 0) {
        if (n_in != 18 || out_size != MTOK * DM || ws_size < WS_END) { fprintf(stderr, "kernel_launch: unexpected shapes (n_in %d, out %d, ws %zu); nothing launched\n", n_in, out_size, ws_size); grid = -1; return; }
        int dev = 0, cus = 0, per_cu = 0;
        if (hipGetDevice(&dev) != hipSuccess || hipDeviceGetAttribute(&cus, hipDeviceAttributeMultiprocessorCount, dev) != hipSuccess) { grid = -1; return; }
        if (hipFuncSetAttribute((const void*)mega_fwd, hipFuncAttributeMaxDynamicSharedMemorySize, LDS_BYTES) != hipSuccess) { fprintf(stderr, "kernel_launch: hipFuncSetAttribute failed\n"); grid = -1; return; }
        if (hipOccupancyMaxActiveBlocksPerMultiprocessor(&per_cu, (const void*)mega_fwd, NTHR, LDS_BYTES) != hipSuccess || per_cu < 1)
            fprintf(stderr, "kernel_launch: note: occupancy query reports %d workgroups per CU\n", per_cu);
        (void)hipGetLastError();
        grid = cus;
    }
    if (grid < 0) return;
    if (hipMemsetAsync((char*)d_ws + WS_CTL, 0, CTL_ZERO_BYTES, stream) != hipSuccess) { fprintf(stderr, "kernel_launch: memset failed\n"); return; }
    Args a{};
    for (int i = 0; i < 18; ++i) a.in[i] = d_in[i];
    a.out = (float*)d_out; a.ws = (unsigned char*)d_ws;
#if MK_N_LAUNCHES == 1
    a.ph_lo = 0; a.ph_hi = N_PHASES;
    hipLaunchKernelGGL(mega_fwd, dim3(grid), dim3(NTHR), LDS_BYTES, stream, a);
#else
    for (int k = 0; k < N_PHASES; ++k) { a.ph_lo = k; a.ph_hi = k + 1; hipLaunchKernelGGL(mega_fwd, dim3(grid), dim3(NTHR), LDS_BYTES, stream, a); }
#endif
}
```

```cpp
#include <hip/hip_runtime.h>
#include <cstdio>
#include <cstdint>

#ifndef MK_N_LAUNCHES
#define MK_N_LAUNCHES 1
#endif

#define LAS __attribute__((address_space(3)))
#define GAS __attribute__((address_space(1)))
typedef unsigned short bf16_t;
typedef short bf16x8 __attribute__((ext_vector_type(8)));
typedef short s16x4 __attribute__((ext_vector_type(4)));
typedef float f32x2 __attribute__((ext_vector_type(2)));
typedef float f32x4 __attribute__((ext_vector_type(4)));
typedef float f32x16 __attribute__((ext_vector_type(16)));
typedef unsigned u32x2 __attribute__((ext_vector_type(2)));
typedef unsigned u32x4 __attribute__((ext_vector_type(4)));
typedef __bf16 hbf16x2 __attribute__((ext_vector_type(2)));

constexpr int NB = 2, SEQ = 4096, DM = 4096, MTOK = NB * SEQ, DEPTH = 4;
constexpr int EVEN_IN = 16384, ODD_IN = 5696, ODD_INP = 5888;
constexpr int EVEN_LD = EVEN_IN + 2176;
constexpr int QLORA = 1024, KVLORA = 512, NH_MLA = 32, NH_SB = 16, NH_DL = 16;
constexpr int UQ_N = 6144, UKV_N = 8192;
constexpr float EPS = 1e-6f;
constexpr float LOG2E = 1.4426950408889634f;
constexpr float QS128 = 1.4426950408889634f * 0.08838834764831845f;
constexpr float QS192 = 1.4426950408889634f * 0.07216878364870322f;
constexpr int EC_QSB = 0, EC_KSB = 2048, EC_VSB = 4096, EC_GSB = 6144, EC_QDL = 8192, EC_KDL = 10240, EC_VDL = 12288, EC_GDL = 14336;
constexpr int OC_CQ = 0, OC_CKV = 1024, OC_G = 1536, OC_KPE = 5632;

constexpr int RING_BYTES_C = 131072;
constexpr size_t MiB = 1u << 20;
constexpr size_t WS_CTL = 0, CTL_ZERO_BYTES = 1 * MiB;
constexpr size_t WS_MOD = 1 * MiB;
constexpr size_t WS_COSF = 2 * MiB, WS_SINF = 4 * MiB;
constexpr size_t WS_COSM = 6 * MiB, WS_SINM = 7 * MiB;
constexpr size_t WS_DIAG = 8 * MiB;
constexpr size_t WS_WEVIN = 16 * MiB;
constexpr size_t WS_WEVOUT = 272 * MiB;
constexpr size_t WS_WODIN = 336 * MiB;
constexpr size_t WS_WUQ = 428 * MiB;
constexpr size_t WS_WUKV = 452 * MiB;
constexpr size_t WS_WODOUT = 468 * MiB;
constexpr size_t WS_H = 544 * MiB;
constexpr size_t WS_PROJ = 1506 * MiB;
constexpr size_t WS_MIXED = 864 * MiB;
constexpr size_t WS_ODL = 928 * MiB;
constexpr size_t WS_LSE = 1024 * MiB;
constexpr size_t WS_QRAW = 1026 * MiB;
constexpr size_t WS_KVRAW = 1122 * MiB;
constexpr size_t WS_XH = 1122 * MiB;
constexpr size_t WS_QF = 1250 * MiB;
constexpr size_t WS_KF = 1346 * MiB;
constexpr size_t WS_VF = 1442 * MiB;
constexpr size_t WS_END = 1800 * MiB;
constexpr int CW_BAR = 4096;
constexpr size_t CTL_SSQCQ = 524288, CTL_SSQKV = CTL_SSQCQ + 2 * MTOK * 4;
static_assert(CTL_SSQKV + 4 * MTOK * 4 <= CTL_ZERO_BYTES, "CTL map");
constexpr int XCH_OFF = RING_BYTES_C + 1024;

constexpr int RING_BYTES = 131072;
constexpr int LDSCTL_OFF = RING_BYTES, MISC_OFF = LDSCTL_OFF + 320;
constexpr int LDS_BYTES = 147456;
constexpr int NWAVES = 8, NTHR = 512;

__device__ __forceinline__ unsigned cvtpk(float lo, float hi) { f32x2 v = {lo, hi}; hbf16x2 b = __builtin_convertvector(v, hbf16x2); return __builtin_bit_cast(unsigned, b); }
typedef _Float16 hf16x2 __attribute__((ext_vector_type(2)));
__device__ __forceinline__ unsigned pkh(float lo, float hi) { hf16x2 h; h.x = (_Float16)lo; h.y = (_Float16)hi; return __builtin_bit_cast(unsigned, h); }
__device__ __forceinline__ float h_lo(unsigned w) { return (float)__builtin_bit_cast(hf16x2, w).x; }
__device__ __forceinline__ float h_hi(unsigned w) { return (float)__builtin_bit_cast(hf16x2, w).y; }
__device__ __forceinline__ float bf_lo(unsigned w) { return __uint_as_float(w << 16); }
__device__ __forceinline__ float bf_hi(unsigned w) { return __uint_as_float(w & 0xffff0000u); }
__device__ __forceinline__ float bf2f(bf16_t b) { return __uint_as_float(((unsigned)b) << 16); }
__device__ __forceinline__ void unpack8(u32x4 w, float (&x)[8]) { x[0] = bf_lo(w.x); x[1] = bf_hi(w.x); x[2] = bf_lo(w.y); x[3] = bf_hi(w.y); x[4] = bf_lo(w.z); x[5] = bf_hi(w.z); x[6] = bf_lo(w.w); x[7] = bf_hi(w.w); }
__device__ __forceinline__ u32x4 pack8u(const float (&x)[8]) { u32x4 w; w.x = cvtpk(x[0], x[1]); w.y = cvtpk(x[2], x[3]); w.z = cvtpk(x[4], x[5]); w.w = cvtpk(x[6], x[7]); return w; }
__device__ __forceinline__ int lane_fresh() { int l; asm volatile("v_mbcnt_lo_u32_b32 %0, -1, 0\n\tv_mbcnt_hi_u32_b32 %0, -1, %0" : "=v"(l)); return l; }
__device__ __forceinline__ float sum16(float v) { auto r = __builtin_amdgcn_permlane16_swap(__float_as_uint(v), __float_as_uint(v), false, false); return __uint_as_float(r[0]) + __uint_as_float(r[1]); }
__device__ __forceinline__ float sum32(float v) { auto r = __builtin_amdgcn_permlane32_swap(__float_as_uint(v), __float_as_uint(v), false, false); return __uint_as_float(r[0]) + __uint_as_float(r[1]); }
__device__ __forceinline__ float dpp_xor1(float v) { return __int_as_float(__builtin_amdgcn_update_dpp(0, __float_as_int(v), 0xB1  , 0xF, 0xF, true)); }
__device__ __forceinline__ float wave_sum(float v) {
    v += __int_as_float(__builtin_amdgcn_update_dpp(0, __float_as_int(v), 0xB1, 0xF, 0xF, true));
    v += __int_as_float(__builtin_amdgcn_update_dpp(0, __float_as_int(v), 0x4E, 0xF, 0xF, true));
    v += __int_as_float(__builtin_amdgcn_update_dpp(0, __float_as_int(v), 0x124, 0xF, 0xF, true));
    v += __int_as_float(__builtin_amdgcn_update_dpp(0, __float_as_int(v), 0x128, 0xF, 0xF, true));
    v = sum16(v); v = sum32(v);
    return v;
}
__device__ __forceinline__ float silu_f(float v) { return v * __builtin_amdgcn_rcpf(1.0f + __builtin_amdgcn_exp2f(-v * LOG2E)); }
__device__ __forceinline__ int opaque_tid(int wv) { int t = wv * 64 + lane_fresh(); asm volatile("" : "+v"(t)); return t; }
#define LDS_WAIT() asm volatile("s_waitcnt lgkmcnt(0)" ::: "memory")
#define VM_WAIT() asm volatile("s_waitcnt vmcnt(0)" ::: "memory")
#define SBAR() __builtin_amdgcn_sched_barrier(0)

namespace pg8 {
constexpr int BM = 256, BK = 64, HALF = 128, HTB = HALF * BK * 2, STAGE_BYTES = 8 * HTB, NXCD = 8, WGM = 8;
__host__ __device__ __forceinline__ int lds_byte(int r, int c) { const int st = (r >> 4) * 2 + (c >> 5), rr = r & 15, cc = c & 31, ob = rr * 64 + cc * 2; return st * 1024 + (ob ^ (((ob >> 9) & 1) << 5)); }
__host__ __device__ __forceinline__ void stage_rc(int b, int& R, int& C) { const int st = b / 1024, sb = b % 1024, swz = sb ^ (((sb >> 9) & 1) << 5); R = (st >> 1) * 16 + swz / 64; C = (st & 1) * 32 + (swz % 64) / 2; }
__host__ __device__ __forceinline__ int perm32(int rho) { const int n = rho >> 4, i = rho & 15; return 8 * (i >> 2) + 4 * n + (i & 3); }
struct Unit { int pm, pn; };
struct Gemm { const bf16_t* A; const bf16_t* Bt; int M, N, K, lda, ldb; };
struct StaticOrder {
    int nM, nN, nwg, G, c;
    __host__ __device__ void init(int M, int N, int G_, int c_) { nM = M / BM; nN = N / BM; nwg = nM * nN; G = G_; c = c_; }
    __host__ __device__ bool next(int i, Unit& u) const {
        const int L = i * G + c; if (L >= nwg) return false;
        int wgid = L; { const int q = nwg / NXCD, r = nwg % NXCD, xcd = wgid % NXCD, off = wgid / NXCD; wgid = (xcd < r ? xcd * (q + 1) : r * (q + 1) + (xcd - r) * q) + off; }
        const int nig = WGM * nN, gid = wgid / nig, fm = gid * WGM, gsz = (nM - fm) < WGM ? (nM - fm) : WGM;
        u.pm = fm + ((wgid % nig) % gsz); u.pn = (wgid % nig) / gsz; return true;
    }
    __device__ __forceinline__ void a_ready(const Unit&) const {}
    __device__ __forceinline__ void done(const Unit&) const {}
};
struct EpiBf16Op {
    static constexpr bool PERM = true;
    bf16_t* O; int ldc;
    int kind;
    const float* knw; const float* cosM; const float* sinM;
    float* ssq_q; float* ssq_kv; float* ssq_pe;
    __device__ __forceinline__ void operator()(const f32x4 (&acc)[2][2][4][2], const Unit& u, int wr, int wc, int fr, int fq) const {
        const int row0 = u.pm * BM + wr * 64 + fr, col0 = u.pn * BM + wc * 32 + 8 * fq;
        float sc = 1.f; bool act = false;
        if (kind == 1) { const int seg = u.pn >> 3; if (seg == 0) sc = QS128; act = (seg == 3) || (seg == 7); }
        else if (kind == 2) { act = (u.pn >= 6) && (u.pn < 22); }
#pragma unroll
        for (int ai = 0; ai < 2; ++ai)
#pragma unroll
            for (int m = 0; m < 4; ++m) { bf16_t* rowp = O + (size_t)(row0 + ai * HALF + m * 16) * ldc + col0;
#pragma unroll
                for (int bj = 0; bj < 2; ++bj) { f32x4 v0 = acc[ai][bj][m][0] * sc, v1 = acc[ai][bj][m][1] * sc;
                    if (kind == 2 && u.pn == 22 && bj == 0 && wc < 2) { const int i4 = 4 * (4 * wc + fq); const size_t row = (size_t)(row0 + ai * HALF + m * 16);
                        const f32x4 w1 = *(const f32x4*)(knw + 128 + i4), w2 = *(const f32x4*)(knw + 160 + i4);
                        const f32x4 c = *(const f32x4*)(cosM + row * 32 + i4), sn = *(const f32x4*)(sinM + row * 32 + i4);
                        const f32x4 x1 = v0 * w1, x2 = v1 * w2; v0 = x1 * c - x2 * sn; v1 = x2 * c + x1 * sn; }
                    if (act) {
#pragma unroll
                        for (int j = 0; j < 4; ++j) { v0[j] = silu_f(v0[j]); v1[j] = silu_f(v1[j]); } }
                    u32x4 w; w.x = cvtpk(v0[0], v0[1]); w.y = cvtpk(v0[2], v0[3]); w.z = cvtpk(v1[0], v1[1]); w.w = cvtpk(v1[2], v1[3]);
                    *(u32x4*)(rowp + bj * HALF) = w; }
                if (kind == 2 && u.pn < 6) { float sq = 0.f;
#pragma unroll
                    for (int bj = 0; bj < 2; ++bj)
#pragma unroll
                        for (int n = 0; n < 2; ++n) { const f32x4 x = acc[ai][bj][m][n]; sq += (x[0] * x[0] + x[1] * x[1]) + (x[2] * x[2] + x[3] * x[3]); }
                    sq = sum16(sq); sq = sum32(sq);
                    if (fq == 0) { if (u.pn < 4) atomicAdd(ssq_q + row0 + ai * HALF + m * 16, sq); else atomicAdd(ssq_kv + 2 * (row0 + ai * HALF + m * 16), sq); } }
                if (kind == 2 && u.pn == 22 && wc < 2) { float sq = 0.f;
#pragma unroll
                    for (int n = 0; n < 2; ++n) { const f32x4 x = acc[ai][0][m][n]; sq += (x[0] * x[0] + x[1] * x[1]) + (x[2] * x[2] + x[3] * x[3]); }
                    sq = sum16(sq); sq = sum32(sq);
                    if (fq == 0) atomicAdd(ssq_pe + 2 * (row0 + ai * HALF + m * 16), sq); } }
    }
};
struct EpiKV {
    static constexpr bool PERM = true;
    bf16_t* KF; bf16_t* VF;
    const bf16_t* P2;
    const float* ssqkv;
    const float* ssqpe;
    const float* knw;
    const float* cosM; const float* sinM;
    LAS unsigned char* xl;
    __device__ __forceinline__ void operator()(const f32x4 (&acc)[2][2][4][2], const Unit& u, int wr, int wc, int fr, int fq) const {
        asm volatile("" : "+v"(fr), "+v"(fq));
        const int rl0 = wr * 64 + fr, q4 = 4 * (4 * wc + fq); const bool ropel = wc < 2;
        LAS f32x2* X = (LAS f32x2*)xl;
        float sq8[8], pe8[8];
#pragma unroll
        for (int rr = 0; rr < 8; ++rr) { const size_t row = (size_t)u.pm * BM + rl0 + (rr >> 2) * HALF + (rr & 3) * 16; const f32x2 t2 = *(const f32x2*)(ssqkv + 2 * row); sq8[rr] = t2[0]; pe8[rr] = t2[1]; }
#pragma unroll
        for (int ai = 0; ai < 2; ++ai)
#pragma unroll
            for (int m = 0; m < 4; ++m) { const int rloc = rl0 + ai * HALF + m * 16;
                float pn = 0.f;
#pragma unroll
                for (int n = 0; n < 2; ++n) { const f32x4 x = acc[ai][0][m][n]; pn += (x[0] * x[0] + x[1] * x[1]) + (x[2] * x[2] + x[3] * x[3]); }
                pn = sum16(pn); pn = sum32(pn);
                if (fq == 0) X[rloc * 4 + wc] = (f32x2){pn, 0.f}; }
        asm volatile("s_waitcnt lgkmcnt(0)" ::: "memory"); __builtin_amdgcn_s_barrier(); asm volatile("" ::: "memory");
        const int bh = (u.pm >> 4) * NH_MLA + u.pn;
        const f32x4 wka = *(const f32x4*)(knw + wc * 32 + fq * 8), wkb = *(const f32x4*)(knw + wc * 32 + fq * 8 + 4);
        float rk8[8];
#pragma unroll
        for (int ai = 0; ai < 2; ++ai)
#pragma unroll
            for (int m = 0; m < 4; ++m) { const int rloc = rl0 + ai * HALF + m * 16; const size_t row = (size_t)u.pm * BM + rloc; const int srow = (int)(row & (SEQ - 1));
                const f32x4 xa = *(const LAS f32x4*)(X + rloc * 4), xb = *(const LAS f32x4*)(X + rloc * 4 + 2);
                const float ssn = (xa[0] + xa[2]) + (xb[0] + xb[2]), spe = pe8[ai * 4 + m];
                const float rkv = __builtin_amdgcn_rsqf(sq8[ai * 4 + m] * (1.0f / KVLORA) + EPS);
                const float rk = __builtin_amdgcn_rsqf((rkv * rkv * ssn + spe) * (1.0f / 192.0f) + EPS), sk = rkv * rk;
                rk8[ai * 4 + m] = rk;
                const size_t trow = (size_t)bh * SEQ + srow;
                { const f32x4 b0 = acc[ai][0][m][0] * wka * sk, b1 = acc[ai][0][m][1] * wkb * sk; u32x4 w;
                  w.x = cvtpk(b0[0], b0[1]); w.y = cvtpk(b0[2], b0[3]); w.z = cvtpk(b1[0], b1[1]); w.w = cvtpk(b1[2], b1[3]);
                  *(u32x4*)(KF + trow * 192 + wc * 32 + fq * 8) = w; }
                { const f32x4 a0 = acc[ai][1][m][0] * rkv, a1 = acc[ai][1][m][1] * rkv; u32x4 w;
                  w.x = cvtpk(a0[0], a0[1]); w.y = cvtpk(a0[2], a0[3]); w.z = cvtpk(a1[0], a1[1]); w.w = cvtpk(a1[2], a1[3]);
                  *(u32x4*)(VF + trow * 128 + wc * 32 + fq * 8) = w; } }
        asm volatile("" ::: "memory");
        if (ropel) {
            u32x4 R8[8];
#pragma unroll
            for (int rr = 0; rr < 8; ++rr) { const size_t row = (size_t)u.pm * BM + rl0 + (rr >> 2) * HALF + (rr & 3) * 16; R8[rr] = *(const u32x4*)(P2 + row * ODD_INP + OC_KPE + wc * 32 + fq * 8); }
#pragma unroll
            for (int rr = 0; rr < 8; ++rr) { const size_t row = (size_t)u.pm * BM + rl0 + (rr >> 2) * HALF + (rr & 3) * 16; const int srow = (int)(row & (SEQ - 1));
                const float rk = rk8[rr]; const size_t trow = (size_t)bh * SEQ + srow;
                float x[8]; unpack8(R8[rr], x);
                u32x2 o1, o2;
                o1.x = cvtpk(x[0] * rk, x[1] * rk); o1.y = cvtpk(x[2] * rk, x[3] * rk); o2.x = cvtpk(x[4] * rk, x[5] * rk); o2.y = cvtpk(x[6] * rk, x[7] * rk);
                *(u32x2*)(KF + trow * 192 + 128 + q4) = o1; *(u32x2*)(KF + trow * 192 + 160 + q4) = o2; }
        }
    }
};
struct EpiEvenIn {
    static constexpr bool PERM = true;
    bf16_t* O;
    const float* qn; const float* kn;
    const float* cosF; const float* sinF;
    LAS unsigned char* xl;
    __device__ __forceinline__ void operator()(const f32x4 (&acc)[2][2][4][2], const Unit& u, int wr, int wc, int fr, int fq) const {
        asm volatile("" : "+v"(fr), "+v"(fq));
        const int row0 = u.pm * BM + wr * 64 + fr, col0 = u.pn * BM + wc * 32 + 8 * fq;
        const int seg = u.pn >> 3;
        if (seg == 4 || seg == 5) {
            const int rl0 = wr * 64 + fr, i4 = 4 * (4 * wc + fq);
            LAS float* X = (LAS float*)xl;
#pragma unroll
            for (int ai = 0; ai < 2; ++ai)
#pragma unroll
                for (int m = 0; m < 4; ++m) { const int rloc = rl0 + ai * HALF + m * 16;
#pragma unroll
                    for (int bj = 0; bj < 2; ++bj) { const f32x4 x = acc[ai][bj][m][0], y = acc[ai][bj][m][1];
                        float s = ((x[0] * x[0] + x[1] * x[1]) + (x[2] * x[2] + x[3] * x[3])) + ((y[0] * y[0] + y[1] * y[1]) + (y[2] * y[2] + y[3] * y[3]));
                        s = sum16(s); s = sum32(s);
                        if (fq == 0) X[(rloc * 2 + bj) * 4 + wc] = s; } }
            asm volatile("s_waitcnt lgkmcnt(0)" ::: "memory"); __builtin_amdgcn_s_barrier(); asm volatile("" ::: "memory");
            const float* wv = (seg == 4) ? qn : kn; const float osc = (seg == 4) ? QS128 : 1.0f;
            const f32x4 w1 = *(const f32x4*)(wv + i4), w2 = *(const f32x4*)(wv + 64 + i4);
#pragma unroll
            for (int ai = 0; ai < 2; ++ai)
#pragma unroll
                for (int m = 0; m < 4; ++m) { const int rloc = rl0 + ai * HALF + m * 16; const size_t row = (size_t)u.pm * BM + rloc;
                    const f32x4 c = *(const f32x4*)(cosF + row * 64 + i4), sn = *(const f32x4*)(sinF + row * 64 + i4);
                    const f32x4 xs0 = *(const LAS f32x4*)(X + (rloc * 2 + 0) * 4), xs1 = *(const LAS f32x4*)(X + (rloc * 2 + 1) * 4);
#pragma unroll
                    for (int bj = 0; bj < 2; ++bj) { const f32x4 xs = bj ? xs1 : xs0;
                        const float rinv = __builtin_amdgcn_rsqf(((xs[0] + xs[1]) + (xs[2] + xs[3])) * (1.0f / 128.0f) + EPS);
                        const f32x4 y1 = acc[ai][bj][m][0] * w1 * rinv, y2 = acc[ai][bj][m][1] * w2 * rinv;
                        const f32x4 o1 = (y1 * c - y2 * sn) * osc, o2 = (y2 * c + y1 * sn) * osc;
                        u32x4 w; w.x = cvtpk(o1[0], o1[1]); w.y = cvtpk(o1[2], o1[3]); w.z = cvtpk(o2[0], o2[1]); w.w = cvtpk(o2[2], o2[3]);
                        *(u32x4*)(O + row * EVEN_LD + col0 + bj * HALF) = w; } }
            return;
        }
        const float sc = (seg == 0) ? QS128 : 1.f; const bool act = (seg == 3) || (seg == 7);
#pragma unroll
        for (int ai = 0; ai < 2; ++ai)
#pragma unroll
            for (int m = 0; m < 4; ++m) { bf16_t* rowp = O + (size_t)(row0 + ai * HALF + m * 16) * EVEN_LD + col0;
#pragma unroll
                for (int bj = 0; bj < 2; ++bj) { f32x4 v0 = acc[ai][bj][m][0] * sc, v1 = acc[ai][bj][m][1] * sc;
                    if (act) {
#pragma unroll
                        for (int j = 0; j < 4; ++j) { v0[j] = silu_f(v0[j]); v1[j] = silu_f(v1[j]); } }
                    u32x4 w; w.x = cvtpk(v0[0], v0[1]); w.y = cvtpk(v0[2], v0[3]); w.z = cvtpk(v1[0], v1[1]); w.w = cvtpk(v1[2], v1[3]);
                    *(u32x4*)(rowp + bj * HALF) = w; } }
    }
};
struct EpiResid {
    static constexpr bool PERM = true;
    const float* xin32; const unsigned short* xin16; float* xout32; unsigned short* xout16; const float* gate;
    __device__ __forceinline__ void operator()(const f32x4 (&acc)[2][2][4][2], const Unit& u, int wr, int wc, int fr, int fq) const {
        const int row0 = u.pm * BM + wr * 64 + fr, col0 = u.pn * BM + wc * 32 + 8 * fq;
        const float* gp = gate + (u.pm >= 16 ? 12288 : 0) + col0;
        f32x4 gv[2][2];
#pragma unroll
        for (int bj = 0; bj < 2; ++bj)
#pragma unroll
            for (int n = 0; n < 2; ++n) gv[bj][n] = *(const f32x4*)(gp + bj * HALF + n * 4);
        const bool in16 = xin16 != nullptr, out16 = xout16 != nullptr;
        if (in16) {
#pragma unroll
            for (int ai = 0; ai < 2; ++ai) {
                u32x4 raw[4][2];
#pragma unroll
                for (int m = 0; m < 4; ++m)
#pragma unroll
                    for (int bj = 0; bj < 2; ++bj) raw[m][bj] = *(const u32x4*)(xin16 + (size_t)(row0 + ai * HALF + m * 16) * DM + col0 + bj * HALF);
#pragma unroll
                for (int m = 0; m < 4; ++m) { const size_t off = (size_t)(row0 + ai * HALF + m * 16) * DM + col0;
#pragma unroll
                    for (int bj = 0; bj < 2; ++bj) { const u32x4 r = raw[m][bj];
                        const f32x4 x0 = {h_lo(r.x), h_hi(r.x), h_lo(r.y), h_hi(r.y)}, x1 = {h_lo(r.z), h_hi(r.z), h_lo(r.w), h_hi(r.w)};
                        const f32x4 y0 = x0 + gv[bj][0] * acc[ai][bj][m][0], y1 = x1 + gv[bj][1] * acc[ai][bj][m][1];
                        if (out16) { u32x4 w; w.x = pkh(y0[0], y0[1]); w.y = pkh(y0[2], y0[3]); w.z = pkh(y1[0], y1[1]); w.w = pkh(y1[2], y1[3]); *(u32x4*)(xout16 + off + bj * HALF) = w; }
                        else { *(f32x4*)(xout32 + off + bj * HALF) = y0; *(f32x4*)(xout32 + off + bj * HALF + 4) = y1; } } }
                asm volatile("" ::: "memory");
            }
            return;
        }
#pragma unroll
        for (int g2 = 0; g2 < 4; ++g2) { const int ai = g2 >> 1, mb = (g2 & 1) * 2;
            f32x4 xo[2][2][2];
#pragma unroll
            for (int m = 0; m < 2; ++m)
#pragma unroll
                for (int bj = 0; bj < 2; ++bj)
#pragma unroll
                    for (int n = 0; n < 2; ++n) xo[m][bj][n] = *(const f32x4*)(xin32 + (size_t)(row0 + ai * HALF + (mb + m) * 16) * DM + col0 + bj * HALF + n * 4);
#pragma unroll
            for (int m = 0; m < 2; ++m) { const size_t off = (size_t)(row0 + ai * HALF + (mb + m) * 16) * DM + col0;
#pragma unroll
                for (int bj = 0; bj < 2; ++bj) { const f32x4 y0 = xo[m][bj][0] + gv[bj][0] * acc[ai][bj][m == 0 ? mb : mb + 1][0], y1 = xo[m][bj][1] + gv[bj][1] * acc[ai][bj][m == 0 ? mb : mb + 1][1];
                    if (out16) { u32x4 w; w.x = pkh(y0[0], y0[1]); w.y = pkh(y0[2], y0[3]); w.z = pkh(y1[0], y1[1]); w.w = pkh(y1[2], y1[3]); *(u32x4*)(xout16 + off + bj * HALF) = w; }
                    else { *(f32x4*)(xout32 + off + bj * HALF) = y0; *(f32x4*)(xout32 + off + bj * HALF + 4) = y1; } } }
            asm volatile("" ::: "memory");
        }
    }
};

template <class Epi, class Sched, bool ALIGN_EPI = true, bool SP2 = true>
__device__ __forceinline__ void gemm_phase(LAS unsigned char* lds, const Gemm g, const Sched& S, const Epi& E, int wv) {
    const int tid = opaque_tid(wv), wid = __builtin_amdgcn_readfirstlane(tid >> 6), lane = tid & 63, wr = wid >> 2, wc = wid & 3, fr = lane & 15, fq = lane >> 4;
    const int K = g.K, nt = K / BK;
    unsigned voffA[2], voffB[2];
#pragma unroll
    for (int i = 0; i < 2; ++i) { int R, C; stage_rc(tid * 16 + i * 8192, R, C); const int Rb = Epi::PERM ? ((R & ~31) + perm32(R & 31)) : R;
        voffA[i] = (unsigned)(R * g.lda + C) * 2u; voffB[i] = (unsigned)(Rb * g.ldb + C) * 2u; }
    const size_t kstep = (size_t)(BK * 2);
    const size_t hstepA = (size_t)HALF * g.lda * 2, hstepB = (size_t)HALF * g.ldb * 2;
    const size_t tstepA = 2 * hstepA, tstepB = 2 * hstepB;
    const unsigned ldsw = (unsigned)wid * 1024u;
    const int aoff = lds_byte(wr * 64 + fr, fq * 8), boff = lds_byte(wc * 32 + fr, fq * 8);
#define PG8_SA(b, h) (((b) * 2 + (h)) * HTB)
#define PG8_SB(b, h) ((4 + (b) * 2 + (h)) * HTB)
#define PG8_STAGE(bufoff, gbase, voff) do { _Pragma("unroll") for (int _i = 0; _i < 2; ++_i) \
        __builtin_amdgcn_global_load_lds((const unsigned*)((const char*)(gbase) + (voff)[_i]), (LAS unsigned*)(lds + (bufoff) + ldsw + _i * 8192), 16, 0, 0); } while (0)
#define PG8_LDA(dst, b, h) do { _Pragma("unroll") for (int m = 0; m < 4; ++m) _Pragma("unroll") for (int k = 0; k < 2; ++k) dst[m][k] = *(const LAS bf16x8*)(lds + PG8_SA(b, h) + aoff + m * 2048 + k * 1024); } while (0)
#define PG8_LDB(dst, b, h) do { _Pragma("unroll") for (int n = 0; n < 2; ++n) _Pragma("unroll") for (int k = 0; k < 2; ++k) dst[n][k] = *(const LAS bf16x8*)(lds + PG8_SB(b, h) + boff + n * 2048 + k * 1024); } while (0)
#define PG8_MMA(ai, bj, At, Bt) do { __builtin_amdgcn_s_setprio(1); _Pragma("unroll") for (int m = 0; m < 4; ++m) _Pragma("unroll") for (int n = 0; n < 2; ++n) _Pragma("unroll") for (int k = 0; k < 2; ++k) \
        acc[ai][bj][m][n] = __builtin_amdgcn_mfma_f32_16x16x32_bf16(Bt[n][k], At[m][k], acc[ai][bj][m][n], 0, 0, 0); __builtin_amdgcn_s_setprio(0); } while (0)
#define PG8_WAIT_V(n) asm volatile("s_waitcnt vmcnt(" #n ")" ::: "memory")
#define PG8_WAIT_L(n) asm volatile("s_waitcnt lgkmcnt(" #n ")" ::: "memory")
#define PG8_BAR __builtin_amdgcn_s_barrier()
#define PG8_SCHED __builtin_amdgcn_sched_barrier(0)
    Unit cur, nxt; int ui = 0;
    if (!S.next(0, cur)) return;
    f32x4 acc[2][2][4][2];
#pragma unroll
    for (int a = 0; a < 2; ++a)
#pragma unroll
        for (int b = 0; b < 2; ++b)
#pragma unroll
            for (int m = 0; m < 4; ++m)
#pragma unroll
                for (int n = 0; n < 2; ++n) acc[a][b][m][n] = (f32x4){0.f, 0.f, 0.f, 0.f};
    bf16x8 At[4][2], B0[2][2], B1[2][2];
    const char* cA = (const char*)g.A + (size_t)cur.pm * tstepA; const char* cB = (const char*)g.Bt + (size_t)cur.pn * tstepB;
    S.a_ready(cur);
    if constexpr (SP2) {
        PG8_STAGE(PG8_SB(0, 0), cB, voffB); PG8_STAGE(PG8_SB(0, 1), cB + hstepB, voffB); PG8_STAGE(PG8_SA(0, 0), cA, voffA); PG8_STAGE(PG8_SA(0, 1), cA + hstepA, voffA);
        if (wr == 1) PG8_BAR;
        PG8_WAIT_V(2); PG8_BAR;
        PG8_STAGE(PG8_SB(1, 0), cB + kstep, voffB); PG8_STAGE(PG8_SA(1, 0), cA + kstep, voffA); PG8_STAGE(PG8_SB(1, 1), cB + hstepB + kstep, voffB);
        PG8_WAIT_V(6); PG8_BAR;
    } else {
        PG8_STAGE(PG8_SB(0, 0), cB, voffB); PG8_STAGE(PG8_SA(0, 0), cA, voffA); PG8_STAGE(PG8_SB(0, 1), cB + hstepB, voffB); PG8_STAGE(PG8_SA(0, 1), cA + hstepA, voffA);
        if (wr == 1) PG8_BAR;
        PG8_WAIT_V(4); PG8_BAR;
        PG8_STAGE(PG8_SB(1, 0), cB + kstep, voffB); PG8_STAGE(PG8_SA(1, 0), cA + kstep, voffA); PG8_STAGE(PG8_SB(1, 1), cB + hstepB + kstep, voffB);
        PG8_WAIT_V(6); PG8_BAR;
    }
    for (;;) {
        const bool has_next = S.next(ui + 1, nxt);
        const char* nA = has_next ? (const char*)g.A + (size_t)nxt.pm * tstepA : cA; const char* nB = has_next ? (const char*)g.Bt + (size_t)nxt.pn * tstepB : cB;
        for (int t = 0; t < nt; t += 2) {
            const bool last = (t == nt - 2);
            const char* a1 = cA + (size_t)(t + 1) * kstep;
            const char* a2 = last ? nA : cA + (size_t)(t + 2) * kstep; const char* b2 = last ? nB : cB + (size_t)(t + 2) * kstep;
            const char* a3 = a2 + kstep; const char* b3 = b2 + kstep;
            if (last && has_next) S.a_ready(nxt);
            if constexpr (SP2) {
            PG8_LDB(B0, 0, 0); PG8_LDB(B1, 0, 1); PG8_SCHED; PG8_LDA(At, 0, 0); PG8_STAGE(PG8_SA(1, 1), a1 + hstepA, voffA);
            PG8_WAIT_V(8); PG8_WAIT_L(0); PG8_BAR; PG8_MMA(0, 0, At, B0); PG8_MMA(0, 1, At, B1); PG8_BAR; PG8_SCHED;
            PG8_LDA(At, 0, 1); PG8_STAGE(PG8_SB(0, 0), b2, voffB); PG8_STAGE(PG8_SB(0, 1), b2 + hstepB, voffB); PG8_STAGE(PG8_SA(0, 0), a2, voffA);
            PG8_WAIT_V(8); PG8_WAIT_L(0); PG8_BAR; PG8_MMA(1, 0, At, B0); PG8_MMA(1, 1, At, B1); PG8_BAR; PG8_SCHED;
            PG8_LDB(B0, 1, 0); PG8_LDB(B1, 1, 1); PG8_SCHED; PG8_LDA(At, 1, 0); PG8_STAGE(PG8_SA(0, 1), a2 + hstepA, voffA);
            PG8_WAIT_V(8); PG8_WAIT_L(0); PG8_BAR; PG8_MMA(0, 0, At, B0); PG8_MMA(0, 1, At, B1); PG8_BAR; PG8_SCHED;
            PG8_LDA(At, 1, 1); PG8_STAGE(PG8_SB(1, 0), b3, voffB); PG8_STAGE(PG8_SB(1, 1), b3 + hstepB, voffB); PG8_STAGE(PG8_SA(1, 0), a3, voffA);
            PG8_WAIT_V(8); PG8_WAIT_L(0); PG8_BAR; PG8_MMA(1, 0, At, B0); PG8_MMA(1, 1, At, B1); PG8_BAR; PG8_SCHED;
            } else {
            PG8_LDB(B0, 0, 0); PG8_SCHED; PG8_LDA(At, 0, 0); PG8_STAGE(PG8_SA(1, 1), a1 + hstepA, voffA);
            PG8_WAIT_L(8); PG8_BAR; PG8_WAIT_L(0); PG8_MMA(0, 0, At, B0); PG8_BAR; PG8_SCHED;
            PG8_LDB(B1, 0, 1); PG8_STAGE(PG8_SB(0, 0), b2, voffB);
            PG8_BAR; PG8_WAIT_L(0); PG8_MMA(0, 1, At, B1); PG8_BAR;
            PG8_LDA(At, 0, 1); PG8_STAGE(PG8_SA(0, 0), a2, voffA);
            PG8_BAR; PG8_WAIT_L(0); PG8_MMA(1, 0, At, B0); PG8_BAR; PG8_SCHED;
            PG8_STAGE(PG8_SB(0, 1), b2 + hstepB, voffB);
            PG8_WAIT_V(6); PG8_BAR; PG8_MMA(1, 1, At, B1); PG8_BAR;
            PG8_LDB(B0, 1, 0); PG8_SCHED; PG8_LDA(At, 1, 0); PG8_STAGE(PG8_SA(0, 1), a2 + hstepA, voffA);
            PG8_WAIT_L(8); PG8_BAR; PG8_WAIT_L(0); PG8_MMA(0, 0, At, B0); PG8_BAR; PG8_SCHED;
            PG8_LDB(B1, 1, 1); PG8_STAGE(PG8_SB(1, 0), b3, voffB);
            PG8_BAR; PG8_WAIT_L(0); PG8_MMA(0, 1, At, B1); PG8_BAR;
            PG8_LDA(At, 1, 1); PG8_STAGE(PG8_SA(1, 0), a3, voffA);
            PG8_BAR; PG8_WAIT_L(0); PG8_MMA(1, 0, At, B0); PG8_BAR; PG8_SCHED;
            PG8_STAGE(PG8_SB(1, 1), b3 + hstepB, voffB);
            PG8_WAIT_V(6); PG8_BAR; PG8_MMA(1, 1, At, B1); PG8_BAR;
            }
        }
        if constexpr (ALIGN_EPI) { if (wr == 0) PG8_BAR; }
        E(acc, cur, wr, wc, fr, fq); S.done(cur);
        if (!has_next) break;
#pragma unroll
        for (int a = 0; a < 2; ++a)
#pragma unroll
            for (int b = 0; b < 2; ++b)
#pragma unroll
                for (int m = 0; m < 4; ++m)
#pragma unroll
                    for (int n = 0; n < 2; ++n) acc[a][b][m][n] = (f32x4){0.f, 0.f, 0.f, 0.f};
        cur = nxt; cA = nA; cB = nB; ++ui;
        if constexpr (ALIGN_EPI) { if (wr == 1) PG8_BAR; }
    }
    PG8_WAIT_V(0);
    if constexpr (!ALIGN_EPI) { if (wr == 0) PG8_BAR; }
    PG8_BAR;
#undef PG8_SA
#undef PG8_SB
#undef PG8_STAGE
#undef PG8_LDA
#undef PG8_LDB
#undef PG8_MMA
#undef PG8_WAIT_V
#undef PG8_WAIT_L
#undef PG8_BAR
#undef PG8_SCHED
}
}

#define XB_TMO      128
#define XB_XCNT(j)  (256  + 64 * (j))
#define XB_XSUB(j)  (1280 + 64 * (j))
#define XB_XGEN(j)  (2304 + 64 * (j))
#define XB_TOP      3328
#define XB_TOPGEN   3392
#define XCD_BAR_WORDS 3456
#define XB_SPIN_CAP (1u << 18)
__device__ __forceinline__ unsigned xb_ld(unsigned* p)              { return __hip_atomic_load(p, __ATOMIC_RELAXED, __HIP_MEMORY_SCOPE_AGENT); }
__device__ __forceinline__ unsigned xb_add(unsigned* p, unsigned v) { return __hip_atomic_fetch_add(p, v, __ATOMIC_RELAXED, __HIP_MEMORY_SCOPE_AGENT); }
__device__ __forceinline__ unsigned xb_xcc_id() { return (unsigned)__builtin_amdgcn_s_getreg((3 << 11) | 20) & 0xFu; }
#define XB_SPIN(cond, bar) do { unsigned _sp = 0; while (cond) { __builtin_amdgcn_s_sleep(1); \
    if ((++_sp & 255u) == 0u) { if (xb_ld(&(bar)[XB_TMO])) break; if (_sp > XB_SPIN_CAP) { atomicAdd(&(bar)[XB_TMO], 1u); break; } } } } while (0)
struct XcdBarrier { unsigned* bar; unsigned x; volatile LAS unsigned* st; int wv; };
__device__ __forceinline__ bool xb_thread0(int wv) { return wv == 0 && lane_fresh() == 0; }
__device__ __forceinline__ XcdBarrier xcd_barrier_post(unsigned* bar, volatile LAS unsigned* st, int wv) {
    XcdBarrier b; b.bar = bar; b.x = xb_xcc_id(); b.st = st; b.wv = wv;
    if (xb_thread0(wv)) (void)xb_add(&bar[XB_XCNT(b.x)], 1u);
    return b;
}
__device__ __forceinline__ void xcd_barrier_complete(unsigned* bar, unsigned x, unsigned& nloc, unsigned& nx) {
    const unsigned G = gridDim.x * gridDim.y * gridDim.z;
    unsigned sum, cnt, mine, sp = 0u;
    for (;;) {
        sum = 0u; cnt = 0u;
#pragma unroll
        for (unsigned j = 0; j < 16; ++j) { const unsigned c = xb_ld(&bar[XB_XCNT(j)]); sum += c; cnt += (c > 0u) ? 1u : 0u; }
        mine = xb_ld(&bar[XB_XCNT(x)]);
        if (sum == G) break;
        __builtin_amdgcn_s_sleep(1);
        if ((++sp & 255u) == 0u) { if (xb_ld(&bar[XB_TMO])) break; if (sp > XB_SPIN_CAP) { atomicAdd(&bar[XB_TMO], 1u); break; } }
    }
    nloc = mine > 0u ? mine : 1u; nx = cnt > 0u ? cnt : 1u;
}
__device__ __forceinline__ void xcd_barrier(const XcdBarrier& b) {
    asm volatile("s_waitcnt vmcnt(0)" ::: "memory");
    __syncthreads();
    if (xb_thread0(b.wv)) {
        unsigned* bar = b.bar; asm volatile("" : "+s"(bar));
        __builtin_amdgcn_s_waitcnt(0);
        unsigned nloc = b.st[0], nx = b.st[1];
        if (nloc == 0u) { xcd_barrier_complete(bar, b.x, nloc, nx); b.st[0] = nloc; b.st[1] = nx; }
        const unsigned old = xb_add(&bar[XB_XSUB(b.x)], 1u);
        const unsigned gen = old / nloc;
        if (old + 1u == (gen + 1u) * nloc) {
            __builtin_amdgcn_fence(__ATOMIC_RELEASE, "agent");
            asm volatile("s_waitcnt vmcnt(0)" ::: "memory");
            const unsigned og = xb_add(&bar[XB_TOP], 1u);
            const unsigned tg = og / nx;
            if (og + 1u == (tg + 1u) * nx) xb_add(&bar[XB_TOPGEN], 1u);
            else XB_SPIN(xb_ld(&bar[XB_TOPGEN]) == tg, bar);
            __builtin_amdgcn_fence(__ATOMIC_ACQUIRE, "agent");
            xb_add(&bar[XB_XGEN(b.x)], 1u);
            asm volatile("s_waitcnt vmcnt(0)" ::: "memory");
        } else {
            XB_SPIN(xb_ld(&bar[XB_XGEN(b.x)]) == gen, bar);
            __builtin_amdgcn_fence(__ATOMIC_ACQUIRE, "agent");
            asm volatile("s_waitcnt vmcnt(0)" ::: "memory");
        }
    }
    __syncthreads();
}

namespace att {
constexpr int KVBLK = 64, QBLK = 32, QB = 256;
constexpr int SHM_V = 16384, SHM_K = 16384, SHM_KR = 8192;
constexpr int V_OFF = 0, K_OFF = 2 * SHM_V, KR_OFF = K_OFF + 2 * SHM_K, WS_OFF = KR_OFF + 2 * SHM_KR, FLG_OFF = WS_OFF + 8 * 256, QR_OFF = FLG_OFF + 64 + 384, ATT_LDS = QR_OFF + 8 * 4096;
constexpr float SB_DONE = 0.f;
constexpr float THR2 = 11.5f;
#define KSWZ(row, colB) ((row) * 256 + ((colB) ^ ((((row) & 7) | ((((row) >> 4) & 1) << 3)) << 4)))
#define KRSWZ(row, colB) ((row) * 128 + ((colB) ^ ((((row) >> 1) & 7) << 4)))
__device__ __forceinline__ int v_st(int k, int c) { const int kk = (k & ~0xC) | ((k & 4) << 1) | ((k & 8) >> 1); return ((kk >> 3) * 4 + (c >> 5)) * 512 + ((kk & 7) * 32 + (c & 31)) * 2; }
__device__ __forceinline__ int v_rd_base(int lane) { return ((lane & 3) << 3) | (((lane >> 2) & 3) << 6) | (((lane >> 4) & 1) << 5) | (((lane >> 5) & 1) << 8); }
constexpr int v_rd_off(int d0, int ks, int half) { return d0 * 512 + ks * 4096 + half * 2048; }
__device__ __forceinline__ int crow(int r, int hi) { return (r & 3) + 8 * (r >> 2) + 4 * hi; }
__device__ __forceinline__ float xhalf(float v, int hi) {
    auto rr = __builtin_amdgcn_permlane32_swap(__float_as_uint(v), __float_as_uint(v), false, false);
    return __uint_as_float(hi ? rr[0] : rr[1]);
}
__device__ __forceinline__ void mask_tile(f32x16& p0, f32x16& p1, int dq, unsigned W) {
    const float NEG = -__builtin_inff();
#pragma unroll
    for (int r = 0; r < 16; ++r) {
        const int c = (r & 3) + 8 * (r >> 2);
        if ((unsigned)(dq - c) >= W) p0[r] = NEG;
        if ((unsigned)(dq - c - 32) >= W) p1[r] = NEG;
    }
}
#define PK4(P, B_, OUT) do { unsigned a0 = cvtpk(P[B_+0], P[B_+1]), a1 = cvtpk(P[B_+2], P[B_+3]);                          \
        unsigned b0 = cvtpk(P[B_+4], P[B_+5]), b1 = cvtpk(P[B_+6], P[B_+7]);                                             \
        auto r0 = __builtin_amdgcn_permlane32_swap(a0, b0, false, false); auto r1 = __builtin_amdgcn_permlane32_swap(a1, b1, false, false); \
        u32x4 w = {r0[0], r1[0], r0[1], r1[1]}; OUT = __builtin_bit_cast(bf16x8, w); } while (0)
__device__ __forceinline__ void softmax_tile(f32x16& p0, f32x16& p1, float m_ref, float& m_reg, float& l_reg, float& alpha) {
    float pmax = p0[0];
#pragma unroll
    for (int r = 1; r < 16; ++r) pmax = fmaxf(pmax, p0[r]);
#pragma unroll
    for (int r = 0; r < 16; ++r) pmax = fmaxf(pmax, p1[r]);
    { auto rr = __builtin_amdgcn_permlane32_swap(__float_as_uint(pmax), __float_as_uint(pmax), false, false);
      pmax = fmaxf(__uint_as_float(rr[0]), __uint_as_float(rr[1])); }
    if (__all((pmax + (m_ref - m_reg)) <= THR2)) { alpha = 1.f;
#pragma unroll
        for (int r = 0; r < 16; ++r) p0[r] = __builtin_amdgcn_exp2f(p0[r]);
#pragma unroll
        for (int r = 0; r < 16; ++r) p1[r] = __builtin_amdgcn_exp2f(p1[r]);
    } else { const float mn = fmaxf(m_reg, pmax + m_ref), dl = mn - m_ref; alpha = __builtin_amdgcn_exp2f(m_reg - mn); m_reg = mn;
#pragma unroll
        for (int r = 0; r < 16; ++r) p0[r] = __builtin_amdgcn_exp2f(p0[r] - dl);
#pragma unroll
        for (int r = 0; r < 16; ++r) p1[r] = __builtin_amdgcn_exp2f(p1[r] - dl);
    }
    float ps = 0.f;
#pragma unroll
    for (int r = 0; r < 16; ++r) ps += p0[r];
#pragma unroll
    for (int r = 0; r < 16; ++r) ps += p1[r];
    { auto rr = __builtin_amdgcn_permlane32_swap(__float_as_uint(ps), __float_as_uint(ps), false, false);
      ps = __uint_as_float(rr[0]) + __uint_as_float(rr[1]); }
    l_reg = l_reg * alpha + ps;
}
__device__ __forceinline__ void sb_half(f32x16& p, float rin, float& rout, int hi) {
#pragma unroll
    for (int r = 0; r < 16; ++r) p[r] = __builtin_amdgcn_rcpf(1.f + __builtin_amdgcn_exp2f(p[r]));
    float s[4], q[4], R[4];
#pragma unroll
    for (int g = 0; g < 4; ++g) s[g] = (p[4 * g] * p[4 * g + 1]) * (p[4 * g + 2] * p[4 * g + 3]);
#pragma unroll
    for (int g = 0; g < 4; ++g) q[g] = xhalf(s[g], hi);
    R[3] = rin; R[2] = R[3] * (s[3] * q[3]); R[1] = R[2] * (s[2] * q[2]); R[0] = R[1] * (s[1] * q[1]);
    rout = R[0] * (s[0] * q[0]);
#pragma unroll
    for (int g = 0; g < 4; ++g) {
        float run = hi ? R[g] : R[g] * q[g];
#pragma unroll
        for (int i = 3; i >= 0; --i) { const float ui = p[4 * g + i]; p[4 * g + i] = (1.f - ui) * run; run *= ui; }
    }
}
__device__ __forceinline__ void sb_tile(f32x16& p0, f32x16& p1, float& carry, int hi) {
    float mid, nc;
    sb_half(p1, carry, mid, hi);
    sb_half(p0, mid, nc, hi);
    carry = nc;
}
template <bool MLA>
__device__ __forceinline__ void qkt(f32x16& p0, f32x16& p1, LAS unsigned char* lds, int KB, int r32, int hi, const bf16x8* qr, const bf16x8* qrr, bool a0, bool a1, float pinit) {
    constexpr int NF = MLA ? 12 : 8, D = 8;
    const float NEG = -__builtin_inff();
    unsigned kb[4];
#pragma unroll
    for (int dd = 0; dd < 4; ++dd) kb[dd] = (unsigned)(K_OFF + KB * SHM_K + KSWZ(r32, (dd * 16 + hi * 8) * 2));
    const unsigned krb = (unsigned)(KR_OFF + KB * SHM_KR);
#define KADDR(i) ((i) < 8 ? (kb[(i) & 3] ^ ((unsigned)(((i) & 7) >> 2) << 7)) : krb + (unsigned)KRSWZ(r32, ((((i) < 8 ? 8 : (i)) - 8) * 16 + hi * 8) * 2))
#define KHOFF(i) ((i) < 8 ? 32u * 256u : 32u * 128u)
#define QFRAG(i) ((i) < 8 ? qr[(i) < 8 ? (i) : 0] : qrr[(i) < 8 ? 0 : (i) - 8])
    bf16x8 F[D];
    if (a0 && a1) {
#pragma unroll
        for (int s_ = 0; s_ < D; ++s_) F[s_] = *(const LAS bf16x8*)(lds + KADDR(s_ % NF) + (s_ / NF) * KHOFF(s_ % NF));
        SBAR();
#pragma unroll
        for (int r = 0; r < 16; ++r) { p0[r] = pinit; p1[r] = pinit; }
        __builtin_amdgcn_s_setprio(1);
#pragma unroll
        for (int s_ = 0; s_ < 2 * NF; ++s_) { const int i = s_ % NF;
            if (s_ < NF) p0 = __builtin_amdgcn_mfma_f32_32x32x16_bf16(F[s_ % D], QFRAG(i), p0, 0, 0, 0);
            else p1 = __builtin_amdgcn_mfma_f32_32x32x16_bf16(F[s_ % D], QFRAG(i), p1, 0, 0, 0);
            if (s_ + D < 2 * NF) F[s_ % D] = *(const LAS bf16x8*)(lds + KADDR((s_ + D) % NF) + ((s_ + D) / NF) * KHOFF((s_ + D) % NF));
            SBAR(); }
    } else if (a0) {
#pragma unroll
        for (int s_ = 0; s_ < D; ++s_) F[s_] = *(const LAS bf16x8*)(lds + KADDR(s_));
        SBAR();
#pragma unroll
        for (int r = 0; r < 16; ++r) { p0[r] = pinit; p1[r] = NEG; }
        __builtin_amdgcn_s_setprio(1);
#pragma unroll
        for (int s_ = 0; s_ < NF; ++s_) { p0 = __builtin_amdgcn_mfma_f32_32x32x16_bf16(F[s_ % D], QFRAG(s_), p0, 0, 0, 0);
            if (s_ + D < NF) F[s_ % D] = *(const LAS bf16x8*)(lds + KADDR(s_ + D));
            SBAR(); }
    } else {
#pragma unroll
        for (int s_ = 0; s_ < D; ++s_) F[s_] = *(const LAS bf16x8*)(lds + KADDR(s_) + KHOFF(s_));
        SBAR();
#pragma unroll
        for (int r = 0; r < 16; ++r) { p1[r] = pinit; p0[r] = NEG; }
        __builtin_amdgcn_s_setprio(1);
#pragma unroll
        for (int s_ = 0; s_ < NF; ++s_) { p1 = __builtin_amdgcn_mfma_f32_32x32x16_bf16(F[s_ % D], QFRAG(s_), p1, 0, 0, 0);
            if (s_ + D < NF) F[s_ % D] = *(const LAS bf16x8*)(lds + KADDR(s_ + D) + KHOFF(s_ + D));
            SBAR(); }
    }
    __builtin_amdgcn_s_setprio(0);
#undef KADDR
#undef KHOFF
#undef QFRAG
}
__device__ __forceinline__ void pv_tile(f32x16* o, unsigned vb0, const f32x16& p0, const f32x16& p1, bool a0, bool a1) {
#define TRRD(dst, off) asm volatile("ds_read_b64_tr_b16 %0, %1 offset:%2" : "=&v"(dst) : "v"(vb0), "i"(off) : "memory")
#define PV_RD(ks, S) do { constexpr int b_ = V_OFF + v_rd_off(0, ks, 0); \
        TRRD(S##l0, b_); TRRD(S##h0, b_ + 2048); TRRD(S##l1, b_ + 512); TRRD(S##h1, b_ + 512 + 2048); TRRD(S##l2, b_ + 1024); TRRD(S##h2, b_ + 1024 + 2048); TRRD(S##l3, b_ + 1536); TRRD(S##h3, b_ + 1536 + 2048); } while (0)
#define PV_MM(S, P, B_) do { bf16x8 pa; PK4(P, B_, pa); __builtin_amdgcn_s_setprio(1); \
        o[0] = __builtin_amdgcn_mfma_f32_32x32x16_bf16(pa, (bf16x8){S##l0[0], S##l0[1], S##l0[2], S##l0[3], S##h0[0], S##h0[1], S##h0[2], S##h0[3]}, o[0], 0, 0, 0);   \
        o[1] = __builtin_amdgcn_mfma_f32_32x32x16_bf16(pa, (bf16x8){S##l1[0], S##l1[1], S##l1[2], S##l1[3], S##h1[0], S##h1[1], S##h1[2], S##h1[3]}, o[1], 0, 0, 0);   \
        o[2] = __builtin_amdgcn_mfma_f32_32x32x16_bf16(pa, (bf16x8){S##l2[0], S##l2[1], S##l2[2], S##l2[3], S##h2[0], S##h2[1], S##h2[2], S##h2[3]}, o[2], 0, 0, 0);   \
        o[3] = __builtin_amdgcn_mfma_f32_32x32x16_bf16(pa, (bf16x8){S##l3[0], S##l3[1], S##l3[2], S##l3[3], S##h3[0], S##h3[1], S##h3[2], S##h3[3]}, o[3], 0, 0, 0); __builtin_amdgcn_s_setprio(0); } while (0)
    s16x4 Al0, Al1, Al2, Al3, Ah0, Ah1, Ah2, Ah3, Bl0, Bl1, Bl2, Bl3, Bh0, Bh1, Bh2, Bh3;
    if (a0) {
        PV_RD(0, A); PV_RD(1, B);
        asm volatile("s_waitcnt lgkmcnt(8)" ::: "memory"); SBAR(); PV_MM(A, p0, 0); SBAR();
        asm volatile("s_waitcnt lgkmcnt(0)" ::: "memory"); SBAR(); PV_MM(B, p0, 8); SBAR();
    }
    if (a1) {
        PV_RD(2, A); PV_RD(3, B);
        asm volatile("s_waitcnt lgkmcnt(8)" ::: "memory"); SBAR(); PV_MM(A, p1, 0); SBAR();
        asm volatile("s_waitcnt lgkmcnt(0)" ::: "memory"); SBAR(); PV_MM(B, p1, 8);
    }
#undef PV_MM
#undef PV_RD
#undef TRRD
}

struct Blk {
    const bf16_t* Q;
    const bf16_t* K;
    const bf16_t* V;
    bf16_t* O;
    const bf16_t* G;
    float* LSE;
    int P0;
    int dil;
    const float* ssq;
    const float* qw;
    const float* cs; const float* sn;
};
template <int MODE>
__device__ __forceinline__ void attn_block(const Blk& b, LAS unsigned char* lds, int wv) {
    constexpr bool MLA = MODE == 0, DIL = MODE == 1, SB = MODE == 2;
    constexpr int NQR = 8;
    const int qs = MLA ? UQ_N : (DIL ? b.dil * EVEN_LD : EVEN_LD), ks = MLA ? 192 : qs, vs = MLA ? 128 : qs;
    const int os = DIL ? b.dil * 2048 : DM, gs = MLA ? ODD_INP : EVEN_LD, ls = DIL ? b.dil * 16 : 0;
    const int tid = opaque_tid(wv), wid = __builtin_amdgcn_readfirstlane(tid >> 6), lane = tid & 63, r32 = lane & 31, hi = lane >> 5;
    int j_lo = 0; const int j_hi = b.P0 / KVBLK + 4;
    if (DIL) j_lo = b.P0 >= 256 ? b.P0 / KVBLK - 2 : 0;
    int NT = j_hi - j_lo;
    const int qlo = b.P0 + wid * QBLK, qm = qlo + r32 - 4 * hi;
    LAS float* wsf = (LAS float*)(lds + WS_OFF) + wid * 64; LAS float* li_l = wsf; LAS float* al_l = wsf + 32;
    const unsigned vb0 = (unsigned)(size_t)(lds + V_OFF) + (unsigned)v_rd_base(lane);
    unsigned kdo[2], vdo[2], krdo = 0u;
#pragma unroll
    for (int i = 0; i < 2; ++i) { const int row = 4 * (2 * wid + i) + (lane >> 4);
        kdo[i] = (unsigned)row * (unsigned)(ks * 2) + ((((unsigned)lane & 15u) << 4) ^ ((unsigned)((row & 7) | (((row >> 4) & 1) << 3)) << 4));
        const int key = (((lane >> 2) & 3) | (((lane >> 4) & 1) << 3)) + (((wid & 1) << 2) | ((wid >> 1) << 4));
        vdo[i] = (unsigned)key * (unsigned)(vs * 2) + (unsigned)(((2 * i + (lane >> 5)) * 32 + (lane & 3) * 8) * 2); }
    if constexpr (MLA) { const int row = 8 * wid + (lane >> 3); krdo = (unsigned)row * (unsigned)(ks * 2) + 256u + ((((unsigned)lane & 7u) << 4) ^ ((unsigned)((row >> 1) & 7) << 4)); }
#define TILE_J(t) (SB ? (j_hi - 1 - (t)) : (j_lo + (t)))
#define TDMA(j, bf) do { const char* kt_ = (const char*)b.K + (size_t)(j) * KVBLK * ks * 2; const char* vt_ = (const char*)b.V + (size_t)(j) * KVBLK * vs * 2; \
        _Pragma("unroll") for (int i_ = 0; i_ < 2; ++i_) __builtin_amdgcn_global_load_lds((const unsigned*)(kt_ + kdo[i_]), (LAS unsigned*)(lds + K_OFF + (bf) * SHM_K + (2 * wid + i_) * 1024), 16, 0, 0); \
        _Pragma("unroll") for (int i_ = 0; i_ < 2; ++i_) __builtin_amdgcn_global_load_lds((const unsigned*)(vt_ + vdo[i_]), (LAS unsigned*)(lds + V_OFF + (bf) * SHM_V + (2 * wid + i_) * 1024), 16, 0, 0); \
        if constexpr (MLA) __builtin_amdgcn_global_load_lds((const unsigned*)(kt_ + krdo), (LAS unsigned*)(lds + KR_OFF + (bf) * SHM_KR + wid * 1024), 16, 0, 0); } while (0)
    TDMA(TILE_J(0), 0);
    bf16x8 qr[NQR]; bf16x8 qrr[4];
    if constexpr (!MLA) { const bf16_t* qp = b.Q + (size_t)(wid * QBLK + r32) * qs + hi * 8;
#pragma unroll
      for (int d0 = 0; d0 < NQR; ++d0) qr[d0] = *(const bf16x8*)(qp + d0 * 16); }
    else {
      const int row = wid * QBLK + r32;
      const bf16_t* qp = b.Q + (size_t)row * qs + hi * 8;
      u32x4 raw[12];
#pragma unroll
      for (int d0 = 0; d0 < 12; ++d0) raw[d0] = *(const u32x4*)(qp + d0 * 16);
      const float rq = __builtin_amdgcn_rsqf(b.ssq[row] * (1.0f / QLORA) + EPS);
      float ss = 0.f;
#pragma unroll
      for (int d0 = 0; d0 < 12; ++d0) { float x[8]; unpack8(raw[d0], x);
#pragma unroll
          for (int e = 0; e < 8; ++e) ss += x[e] * x[e]; }
      ss += xhalf(ss, hi);
      const float sc = rq * __builtin_amdgcn_rsqf(rq * rq * ss * (1.0f / 192.0f) + EPS) * QS192;
#pragma unroll
      for (int d0 = 0; d0 < 8; ++d0) { float x[8]; unpack8(raw[d0], x); const f32x4 wa = *(const f32x4*)(b.qw + d0 * 16 + hi * 8), wb = *(const f32x4*)(b.qw + d0 * 16 + hi * 8 + 4);
#pragma unroll
          for (int e = 0; e < 4; ++e) { x[e] *= sc * wa[e]; x[4 + e] *= sc * wb[e]; }
          qr[d0] = __builtin_bit_cast(bf16x8, pack8u(x)); }
#pragma unroll
      for (int d1 = 0; d1 < 2; ++d1) { float x1[8], x2[8], o1[8], o2[8]; unpack8(raw[8 + d1], x1); unpack8(raw[10 + d1], x2);
          const int i0 = d1 * 16 + hi * 8;
#pragma unroll
          for (int e = 0; e < 8; ++e) { const float y1 = x1[e] * sc * b.qw[128 + i0 + e], y2 = x2[e] * sc * b.qw[160 + i0 + e]; const float c = b.cs[row * 32 + i0 + e], s = b.sn[row * 32 + i0 + e];
              o1[e] = y1 * c - y2 * s; o2[e] = y2 * c + y1 * s; }
          qrr[d1] = __builtin_bit_cast(bf16x8, pack8u(o1)); qrr[d1 + 2] = __builtin_bit_cast(bf16x8, pack8u(o2)); }
    }
    f32x16 o[4];
#pragma unroll
    for (int d = 0; d < 4; ++d)
#pragma unroll
        for (int r = 0; r < 16; ++r) o[d][r] = 0.f;
    float m_reg = -1e30f, l_reg = 0.f, carry = SB ? 1.f : 0.f;
#define TILE_FLAGS(t, act_, needm_, kb_) const int kb_ = TILE_J(t) * KVBLK; bool act_, needm_, a0_, a1_; \
        if (MLA) { a0_ = kb_ <= qlo + QBLK - 1; a1_ = kb_ + 32 <= qlo + QBLK - 1; needm_ = kb_ + KVBLK - 1 > qlo; } \
        else if (DIL) { a0_ = (kb_ <= qlo + QBLK - 1) && (kb_ + 31 >= qlo - 128); a1_ = (kb_ + 32 <= qlo + QBLK - 1) && (kb_ + KVBLK - 1 >= qlo - 128); \
                        needm_ = (kb_ + KVBLK - 1 > qlo) || (kb_ <= qlo + QBLK - 1 - 129); } \
        else { a0_ = kb_ <= qlo + QBLK - 2; a1_ = kb_ + 32 <= qlo + QBLK - 2; needm_ = kb_ + KVBLK - 1 > qlo - 1; } \
        act_ = a0_ || a1_;
    LAS unsigned* flg = (LAS unsigned*)(lds + FLG_OFF);
    constexpr bool NOPP = true;
    const bool h0 = NOPP ? true : (wid < 4);
#define SBDONE(td) ({ bool r_ = false; if constexpr (SB) { const u32x4 f0_ = *(const LAS u32x4*)(flg + ((td) & 1) * 8), f1_ = *(const LAS u32x4*)(flg + ((td) & 1) * 8 + 4); \
            r_ = (f0_.x & f0_.y & f0_.z & f0_.w & f1_.x & f1_.y & f1_.z & f1_.w) != 0u; } r_; })
    VM_WAIT();
    __syncthreads();
    bool stopped = false;
    for (int t = 0; t < NT; ++t) {
        if (SB && (NOPP || !h0) && t >= 1) { if (SBDONE(t - 1)) break; }
        if (t + 1 < NT) TDMA(TILE_J(t + 1), (t + 1) & 1);
        TILE_FLAGS(t, act_, needm_, kb_)
        f32x16 p0, p1;
        const float m_ref_ = SB ? 0.f : (m_reg < -1e29f ? 0.f : m_reg);
        if (act_) qkt<MLA>(p0, p1, lds, t & 1, r32, hi, qr, qrr, a0_, a1_, -m_ref_);
        if constexpr (!NOPP) __syncthreads();
        if (SB && !NOPP && h0 && t >= 1) { if (SBDONE(t - 1)) { stopped = true; break; } }
        if (act_) {
            if (needm_) { if (SB) mask_tile(p0, p1, qm - kb_ - 1, 0x7fffffffu); else mask_tile(p0, p1, qm - kb_, DIL ? 129u : 0x7fffffffu); }
            if constexpr (SB) { sb_tile(p0, p1, carry, hi); }
            else { float alpha_; softmax_tile(p0, p1, m_ref_, m_reg, l_reg, alpha_);
                if (__any(alpha_ < 1.f)) { if (hi == 0) al_l[r32] = alpha_; LDS_WAIT();
#pragma unroll
                    for (int d_ = 0; d_ < 4; ++d_)
#pragma unroll
                        for (int r = 0; r < 16; ++r) o[d_][r] *= al_l[crow(r, hi)]; } }
            pv_tile(o, vb0 + (unsigned)((t & 1) * SHM_V), p0, p1, a0_, a1_); }
        if constexpr (SB) { const bool dn_ = __all(carry <= SB_DONE); if (lane == 0) flg[(t & 1) * 8 + wid] = dn_ ? 1u : 0u; }
        VM_WAIT();
        __syncthreads();
    }
    if (!NOPP && h0 && !stopped) __syncthreads();
#undef SBDONE
#undef TILE_FLAGS
#undef TDMA
#undef TILE_J
    u32x4 gpre[8];
    if (b.G) {
#pragma unroll
        for (int i = 0; i < 8; ++i) { const int id = lane + 64 * i, row = id >> 4, c = id & 15; gpre[i] = *(const u32x4*)(b.G + (size_t)(wid * QBLK + row) * gs + c * 8); } }
    if constexpr (!SB) {
        if (hi == 0) li_l[r32] = l_reg;
        LDS_WAIT();
        if constexpr (DIL) { if (hi == 0) b.LSE[(size_t)(wid * QBLK + r32) * ls] = m_reg + __builtin_amdgcn_logf(l_reg); }
#pragma unroll
        for (int r = 0; r < 16; ++r) { const float rl = __builtin_amdgcn_rcpf(li_l[crow(r, hi)]);
#pragma unroll
            for (int d = 0; d < 4; ++d) o[d][r] *= rl; }
    }
    LAS unsigned char* ost = lds + wid * 8192;
#pragma unroll
    for (int r = 0; r < 16; ++r) { const int orow = crow(r, hi);
#pragma unroll
        for (int d = 0; d < 4; d += 2) {
            const float x = o[d][r], y = o[d + 1][r]; const bool odd = (r32 & 1) != 0;
            const float got = dpp_xor1(odd ? x : y);
            const unsigned w = odd ? cvtpk(got, y) : cvtpk(x, got);
            *(LAS unsigned*)(ost + orow * 256 + ((odd ? d + 1 : d) * 32 + (r32 & ~1)) * 2) = w; } }
    LDS_WAIT();
#pragma unroll
    for (int i = 0; i < 8; ++i) { const int id = lane + 64 * i, row = id >> 4, c = id & 15;
        u32x4 w = *(const LAS u32x4*)(ost + row * 256 + c * 16);
        if (b.G) { const u32x4 g = gpre[i]; float x[8], y[8]; unpack8(w, x); unpack8(g, y);
#pragma unroll
            for (int e = 0; e < 8; ++e) x[e] *= y[e];
            w = pack8u(x); }
        *(u32x4*)(b.O + (size_t)(wid * QBLK + row) * os + c * 8) = w; }
    __syncthreads();
}
__device__ __forceinline__ void attn_dil_wave(const Blk& b, LAS unsigned char* lds, LAS unsigned char* scratch, int wv) {
    const int qs = b.dil * EVEN_LD, os = b.dil * 2048, ls = b.dil * 16;
    const int tid = opaque_tid(wv), wid = __builtin_amdgcn_readfirstlane(tid >> 6), lane = tid & 63, r32 = lane & 31, hi = lane >> 5;
    const int qlo = b.P0, qm = qlo + r32 - 4 * hi;
    const int hlast = qlo >> 5, hfirst = qlo >= 128 ? hlast - 4 : 0, n = hlast - hfirst + 1;
    LAS unsigned char* kbuf = lds + wid * 16384; LAS unsigned char* vbuf = kbuf + 8192;
    LAS float* li_l = (LAS float*)(scratch + wid * 256); LAS float* al_l = li_l + 32;
    bf16x8 qr[8];
    { const bf16_t* qp = b.Q + (size_t)r32 * qs + hi * 8;
#pragma unroll
      for (int d0 = 0; d0 < 8; ++d0) qr[d0] = *(const bf16x8*)(qp + d0 * 16); }
    const unsigned rs2 = (unsigned)qs * 2u;
    const unsigned kl = (unsigned)(lane >> 4) * rs2 + ((((unsigned)lane & 15u) ^ ((unsigned)lane >> 4)) << 4);
    const unsigned vl = (unsigned)(((lane >> 2) & 3) | (((lane >> 4) & 1) << 3)) * rs2 + (unsigned)(((lane >> 5) * 32 + (lane & 3) * 8) * 2);
#define KDMA(hh) do { const char* kb_ = (const char*)b.K + (size_t)(hh) * 32 * rs2; _Pragma("unroll") for (int c_ = 0; c_ < 8; ++c_) \
        __builtin_amdgcn_global_load_lds((const unsigned*)(kb_ + (size_t)(4 * c_) * rs2 + (kl ^ (unsigned)(((c_ & 1) << 6) | ((c_ >> 2) << 7)))), (LAS unsigned*)(kbuf + c_ * 1024), 16, 0, 0); } while (0)
#define VDMA(hh) do { const char* vb_ = (const char*)b.V + (size_t)(hh) * 32 * rs2; _Pragma("unroll") for (int c_ = 0; c_ < 8; ++c_) \
        __builtin_amdgcn_global_load_lds((const unsigned*)(vb_ + (size_t)((((c_ >> 1) & 1) << 2) | ((c_ >> 2) << 4)) * rs2 + (c_ & 1) * 128 + vl), (LAS unsigned*)(vbuf + c_ * 1024), 16, 0, 0); } while (0)
    KDMA(hfirst); VDMA(hfirst);
    f32x16 o[4];
#pragma unroll
    for (int d = 0; d < 4; ++d)
#pragma unroll
        for (int r = 0; r < 16; ++r) o[d][r] = 0.f;
    float m_reg = -1e30f, l_reg = 0.f;
    const unsigned vb0 = (unsigned)(size_t)vbuf + (unsigned)v_rd_base(lane);
    unsigned kb[4];
#pragma unroll
    for (int dd = 0; dd < 4; ++dd) kb[dd] = (unsigned)(wid * 16384 + KSWZ(r32, (dd * 16 + hi * 8) * 2));
    const float NEG = -__builtin_inff();
    for (int i = 0; i < n; ++i) { const int hh = hfirst + i; const bool more = i + 1 < n;
        asm volatile("s_waitcnt vmcnt(8)" ::: "memory");
        const float m_ref = m_reg < -1e29f ? 0.f : m_reg;
        f32x16 p;
#pragma unroll
        for (int r = 0; r < 16; ++r) p[r] = -m_ref;
        { bf16x8 F[8];
#pragma unroll
          for (int d0 = 0; d0 < 8; ++d0) F[d0] = *(const LAS bf16x8*)(lds + (kb[d0 & 3] ^ ((unsigned)(d0 >> 2) << 7)));
          SBAR();
          __builtin_amdgcn_s_setprio(1);
#pragma unroll
          for (int d0 = 0; d0 < 8; ++d0) p = __builtin_amdgcn_mfma_f32_32x32x16_bf16(F[d0], qr[d0], p, 0, 0, 0);
          __builtin_amdgcn_s_setprio(0); }
        LDS_WAIT(); asm volatile("" ::: "memory");
        if (more) KDMA(hh + 1);
        if (hh == hlast || hh * 32 < qlo + 31 - 128) { const int dq = qm - hh * 32;
#pragma unroll
            for (int r = 0; r < 16; ++r) { const int c = (r & 3) + 8 * (r >> 2); if ((unsigned)(dq - c) >= 129u) p[r] = NEG; } }
        { float pmax = p[0];
#pragma unroll
          for (int r = 1; r < 16; ++r) pmax = fmaxf(pmax, p[r]);
          { auto rr = __builtin_amdgcn_permlane32_swap(__float_as_uint(pmax), __float_as_uint(pmax), false, false); pmax = fmaxf(__uint_as_float(rr[0]), __uint_as_float(rr[1])); }
          float alpha;
          if (__all((pmax + (m_ref - m_reg)) <= THR2)) { alpha = 1.f;
#pragma unroll
              for (int r = 0; r < 16; ++r) p[r] = __builtin_amdgcn_exp2f(p[r]); }
          else { const float mn = fmaxf(m_reg, pmax + m_ref), dl = mn - m_ref; alpha = __builtin_amdgcn_exp2f(m_reg - mn); m_reg = mn;
#pragma unroll
              for (int r = 0; r < 16; ++r) p[r] = __builtin_amdgcn_exp2f(p[r] - dl); }
          float ps = 0.f;
#pragma unroll
          for (int r = 0; r < 16; ++r) ps += p[r];
          { auto rr = __builtin_amdgcn_permlane32_swap(__float_as_uint(ps), __float_as_uint(ps), false, false); ps = __uint_as_float(rr[0]) + __uint_as_float(rr[1]); }
          l_reg = l_reg * alpha + ps;
          if (__any(alpha < 1.f)) { if (hi == 0) al_l[r32] = alpha; LDS_WAIT();
#pragma unroll
              for (int d_ = 0; d_ < 4; ++d_)
#pragma unroll
                  for (int r = 0; r < 16; ++r) o[d_][r] *= al_l[crow(r, hi)];
              LDS_WAIT(); } }
        if (more) asm volatile("s_waitcnt vmcnt(8)" ::: "memory"); else asm volatile("s_waitcnt vmcnt(0)" ::: "memory");
        pv_tile(o, vb0, p, p, true, false);
        LDS_WAIT(); asm volatile("" ::: "memory");
        if (more) VDMA(hh + 1);
    }
#undef KDMA
#undef VDMA
    if (hi == 0) li_l[r32] = l_reg;
    LDS_WAIT();
    if (hi == 0) b.LSE[(size_t)r32 * ls] = m_reg + __builtin_amdgcn_logf(l_reg);
#pragma unroll
    for (int r = 0; r < 16; ++r) { const float rl = __builtin_amdgcn_rcpf(li_l[crow(r, hi)]);
#pragma unroll
        for (int d = 0; d < 4; ++d) o[d][r] *= rl; }
    LAS unsigned char* ost = kbuf;
#pragma unroll
    for (int r = 0; r < 16; ++r) { const int orow = crow(r, hi);
#pragma unroll
        for (int d = 0; d < 4; d += 2) {
            const float x = o[d][r], y = o[d + 1][r]; const bool odd = (r32 & 1) != 0;
            const float got = dpp_xor1(odd ? x : y);
            const unsigned w = odd ? cvtpk(got, y) : cvtpk(x, got);
            *(LAS unsigned*)(ost + orow * 256 + ((odd ? d + 1 : d) * 32 + (r32 & ~1)) * 2) = w; } }
    LDS_WAIT();
#pragma unroll 2
    for (int i = 0; i < 8; ++i) { const int id = lane + 64 * i, row = id >> 4, c = id & 15;
        const u32x4 w = *(const LAS u32x4*)(ost + row * 256 + c * 16);
        *(u32x4*)(b.O + (size_t)row * os + c * 8) = w; }
    LDS_WAIT(); asm volatile("" ::: "memory");
}
}

struct Args { const void* in[18]; float* out; unsigned char* ws; int ph_lo, ph_hi; };
typedef const __attribute__((address_space(4))) Args CArgs;
__device__ __forceinline__ CArgs* kargs() { CArgs* p = (CArgs*)__builtin_amdgcn_kernarg_segment_ptr(); asm volatile("" : "+s"(p)); return p; }
enum { IN_X = 0, IN_C, IN_POS, IN_ADAW, IN_ADAB, IN_NORMW, IN_EVWIN, IN_EVQN, IN_EVKN, IN_EVWOUT, IN_ODWIN, IN_ODQLN, IN_ODKVLN, IN_ODWUQ, IN_ODWUKV, IN_ODQN, IN_ODKN, IN_ODWOUT };

struct Frame {
    LAS unsigned char* lds;
    int tid, lane, wave, vcu, G, wv;
    unsigned char* ws;
    __device__ __forceinline__ void refresh() { tid = opaque_tid(wv); lane = tid & 63; wave = __builtin_amdgcn_readfirstlane(tid >> 6); }
};

__device__ __forceinline__ void transpose_item(const float* W, int N, const float* kscale, bf16_t* Bt, int ldb, int k0, int n0, int brow0, LAS unsigned char* scr, int lane, int dl_perm = -1) {
    const int kq = lane >> 4, nq = lane & 15;
    f32x4 v[16];
#pragma unroll
    for (int i = 0; i < 16; ++i) { const int k = 8 * (i >> 1) + 2 * kq + (i & 1); v[i] = __builtin_nontemporal_load((const f32x4*)(W + (size_t)(k0 + k) * N + n0 + 4 * nq)); }
#pragma unroll
    for (int i = 0; i < 8; ++i) { const int k = 8 * i + 2 * kq; f32x4 a = v[2 * i], c = v[2 * i + 1];
        if (kscale) { const float s0 = kscale[k0 + k], s1 = kscale[k0 + k + 1]; a = a * s0; c = c * s1; }
#pragma unroll
        for (int j = 0; j < 4; ++j) *(LAS unsigned*)(scr + (4 * nq + j) * 144 + k * 2) = cvtpk(a[j], c[j]); }
    LDS_WAIT(); asm volatile("" ::: "memory");
#pragma unroll
    for (int jj = 0; jj < 8; ++jj) { const int n = (lane >> 3) + 8 * jj, c = lane & 7;
        const u32x4 w = *(const LAS u32x4*)(scr + n * 144 + c * 16);
        const int drow = dl_perm < 0 ? brow0 + n : (dl_perm == 2 ? brow0 + 8 * ((n & 31) >> 2) + (n & 3) + 4 * (n >> 5) : brow0 + 8 * (n >> 2) + (n & 3) + 4 * dl_perm);
        *(u32x4*)(Bt + (size_t)drow * ldb + k0 + 8 * c) = w; }
    LDS_WAIT(); asm volatile("" ::: "memory");
}

__device__ __forceinline__ void phase_prologue(Frame& F, CArgs& a) {
    F.refresh();
    const float* cvec = (const float*)a.in[IN_C];
    const float* adaw = (const float*)a.in[IN_ADAW]; const float* adab = (const float*)a.in[IN_ADAB];
    LAS float* sl = (LAS float*)F.lds;
    LAS float* red = (LAS float*)(F.lds + 32768);
    for (int i = F.tid; i < 2 * DM; i += NTHR) sl[i] = silu_f(cvec[i]);
    __syncthreads();
    float* MOD = (float*)(F.ws + WS_MOD);
    for (int item = F.vcu; item < DEPTH * 192; item += F.G) {
        const int l = item / 192, ct = item % 192, cq = F.tid & 15, ir = F.tid >> 4;
        const float* wp = adaw + ((size_t)l * DM + ir) * 12288 + ct * 64 + cq * 4;
        f32x4 a0 = {0.f, 0.f, 0.f, 0.f}, a1 = {0.f, 0.f, 0.f, 0.f};
#pragma unroll 8
        for (int k = 0; k < 128; ++k) { const f32x4 w = __builtin_nontemporal_load((const f32x4*)(wp + (size_t)(32 * k) * 12288)); const float s0 = sl[ir + 32 * k], s1 = sl[DM + ir + 32 * k]; a0 += w * s0; a1 += w * s1; }
#pragma unroll
        for (int j = 0; j < 4; ++j) { red[(ir * 64 + cq * 4 + j) * 2 + 0] = a0[j]; red[(ir * 64 + cq * 4 + j) * 2 + 1] = a1[j]; }
        __syncthreads();
        if (F.tid < 128) { const int col = F.tid & 63, bb = F.tid >> 6; float s = 0.f;
#pragma unroll 8
            for (int r = 0; r < 32; ++r) s += red[(r * 64 + col) * 2 + bb];
            MOD[(size_t)(l * 2 + bb) * 12288 + ct * 64 + col] = s + adab[l * 12288 + ct * 64 + col]; }
        __syncthreads();
    }
    LAS unsigned char* scr = F.lds + F.wave * 9216;
    const int gw = F.vcu * NWAVES + F.wave, NGW = F.G * NWAVES;
    constexpr int I_EVIN = (DM / 64) * (EVEN_IN / 64), I_EVOUT = (DM / 64) * (DM / 64), I_ODIN = (DM / 64) * (ODD_IN / 64), I_UQ = (QLORA / 64) * (UQ_N / 64), I_UKV = (KVLORA / 64) * (UKV_N / 64), I_ODOUT = I_EVOUT;
    constexpr int I_PER = I_EVIN + I_EVOUT + I_ODIN + I_UQ + I_UKV + I_ODOUT;
    for (int it = gw; it < 2 * I_PER; it += NGW) {
        const int i = it / I_PER; int r = it % I_PER;
        if (r < I_EVIN) { const int nb = EVEN_IN / 64, kb = r / nb, nn = r % nb;
            const int n0 = nn * 64; const bool dl = n0 >= EC_QDL && n0 < EC_VDL;
            transpose_item((const float*)a.in[IN_EVWIN] + (size_t)i * DM * EVEN_IN, EVEN_IN, nullptr, (bf16_t*)(F.ws + WS_WEVIN) + (size_t)i * EVEN_IN * DM, DM, kb * 64, n0, dl ? (n0 & ~127) : n0, scr, F.lane, dl ? ((n0 >> 6) & 1) : -1); continue; } r -= I_EVIN;
        if (r < I_EVOUT) { const int nb = DM / 64, kb = r / nb, nn = r % nb;
            transpose_item((const float*)a.in[IN_EVWOUT] + (size_t)i * DM * DM, DM, nullptr, (bf16_t*)(F.ws + WS_WEVOUT) + (size_t)i * DM * DM, DM, kb * 64, nn * 64, nn * 64, scr, F.lane); continue; } r -= I_EVOUT;
        if (r < I_ODIN) { const int nb = ODD_IN / 64, kb = r / nb, nn = r % nb; const int n0 = nn * 64;
            const int brow = n0 < 1536 ? n0 : (n0 < 1600 ? OC_KPE + (n0 - 1536) : n0 - 64);
            transpose_item((const float*)a.in[IN_ODWIN] + (size_t)i * DM * ODD_IN, ODD_IN, nullptr, (bf16_t*)(F.ws + WS_WODIN) + (size_t)i * ODD_INP * DM, DM, kb * 64, n0, brow, scr, F.lane, n0 == 1536 ? 2 : -1); continue; } r -= I_ODIN;
        if (r < I_UQ) { const int nb = UQ_N / 64, kb = r / nb, nn = r % nb;
            transpose_item((const float*)a.in[IN_ODWUQ] + (size_t)i * QLORA * UQ_N, UQ_N, (const float*)a.in[IN_ODQLN] + i * QLORA, (bf16_t*)(F.ws + WS_WUQ) + (size_t)i * UQ_N * QLORA, QLORA, kb * 64, nn * 64, nn * 64, scr, F.lane); continue; } r -= I_UQ;
        if (r < I_UKV) { const int nb = UKV_N / 64, kb = r / nb, nn = r % nb;
            transpose_item((const float*)a.in[IN_ODWUKV] + (size_t)i * KVLORA * UKV_N, UKV_N, (const float*)a.in[IN_ODKVLN] + i * KVLORA, (bf16_t*)(F.ws + WS_WUKV) + (size_t)i * UKV_N * KVLORA, KVLORA, kb * 64, nn * 64, nn * 64, scr, F.lane); continue; } r -= I_UKV;
        { const int nb = DM / 64, kb = r / nb, nn = r % nb;
            transpose_item((const float*)a.in[IN_ODWOUT] + (size_t)i * DM * DM, DM, nullptr, (bf16_t*)(F.ws + WS_WODOUT) + (size_t)i * DM * DM, DM, kb * 64, nn * 64, nn * 64, scr, F.lane); }
    }
    const size_t gt = (size_t)F.vcu * NTHR + F.tid, NGT = (size_t)F.G * NTHR;
    for (size_t i = gt; i < (size_t)2 * 192 * DM / 8; i += NGT) { const size_t li = i / (192 * DM / 8), rem = i % (192 * DM / 8);
        *(u32x4*)((bf16_t*)(F.ws + WS_WODIN) + li * (size_t)ODD_INP * DM + (size_t)ODD_IN * DM + rem * 8) = (u32x4){0u, 0u, 0u, 0u}; }
    const int* pos = (const int*)a.in[IN_POS];
    for (size_t i = gt; i < (size_t)MTOK * 96; i += NGT) { const int tok = (int)(i / 96), j = (int)(i % 96);
        const float p = (float)pos[tok];
        if (j < 64) { const float inv = (float)pow(10000.0, -(double)j / 64.0); const float ang = p * inv;
            ((float*)(F.ws + WS_COSF))[tok * 64 + j] = (float)cos((double)ang); ((float*)(F.ws + WS_SINF))[tok * 64 + j] = (float)sin((double)ang); }
        else { const int jj = j - 64; const float inv = (float)pow(10000.0, -(double)jj / 32.0); const float ang = p * inv;
            ((float*)(F.ws + WS_COSM))[tok * 32 + jj] = (float)cos((double)ang); ((float*)(F.ws + WS_SINM))[tok * 32 + jj] = (float)sin((double)ang); } }
}

__device__ __forceinline__ void phase_h(Frame& F, CArgs& a, int layer, const float* xsrc) {
    F.refresh();
    const float* MOD = (const float*)(F.ws + WS_MOD); const float* nw = (const float*)a.in[IN_NORMW] + layer * DM;
    bf16_t* H = (bf16_t*)(F.ws + WS_H);
    LAS float* Acol = (LAS float*)F.lds; LAS float* Scol = Acol + DM;
    int cur_b = -1;
    for (int rb = F.vcu; rb < MTOK / 32; rb += F.G) {
        const int bb = rb / (SEQ / 32);
        if (bb != cur_b) { __syncthreads();
            const float* mp = MOD + (size_t)(layer * 2 + bb) * 12288;
            for (int i = F.tid; i < DM; i += NTHR) { Acol[i] = nw[i] * (1.0f + mp[DM + i]); Scol[i] = mp[i]; }
            __syncthreads(); cur_b = bb; }
#pragma unroll 1
        for (int rr = 0; rr < 4; ++rr) { const int row = rb * 32 + F.wave * 4 + rr;
            if (xsrc) {
            const f32x4* xr = (const f32x4*)(xsrc + (size_t)row * DM) + F.lane;
            f32x4 v[16]; float s = 0.f;
#pragma unroll
            for (int j = 0; j < 16; ++j) { v[j] = __builtin_nontemporal_load(xr + 64 * j); s += (v[j][0] * v[j][0] + v[j][1] * v[j][1]) + (v[j][2] * v[j][2] + v[j][3] * v[j][3]); }
            const float rinv = __builtin_amdgcn_rsqf(wave_sum(s) * (1.0f / DM) + EPS);
            u32x2* o8 = (u32x2*)(H + (size_t)row * DM) + F.lane;
#pragma unroll
            for (int j = 0; j < 16; ++j) { const int c = 4 * F.lane + 256 * j; const f32x4 A = *(const LAS f32x4*)(Acol + c), Sh = *(const LAS f32x4*)(Scol + c);
                const f32x4 h = v[j] * rinv * A + Sh; u32x2 w; w.x = cvtpk(h[0], h[1]); w.y = cvtpk(h[2], h[3]); o8[64 * j] = w; }
            } else {
            const u32x4* xr = (const u32x4*)((const unsigned short*)(F.ws + WS_XH) + (size_t)row * DM) + F.lane;
            u32x4 r[8]; float s = 0.f;
#pragma unroll
            for (int j = 0; j < 8; ++j) r[j] = __builtin_nontemporal_load(xr + 64 * j);
#pragma unroll
            for (int j = 0; j < 8; ++j) { const float a0 = h_lo(r[j].x), a1 = h_hi(r[j].x), a2 = h_lo(r[j].y), a3 = h_hi(r[j].y), a4 = h_lo(r[j].z), a5 = h_hi(r[j].z), a6 = h_lo(r[j].w), a7 = h_hi(r[j].w);
                s += ((a0 * a0 + a1 * a1) + (a2 * a2 + a3 * a3)) + ((a4 * a4 + a5 * a5) + (a6 * a6 + a7 * a7)); }
            const float rinv = __builtin_amdgcn_rsqf(wave_sum(s) * (1.0f / DM) + EPS);
            u32x4* o16 = (u32x4*)(H + (size_t)row * DM) + F.lane;
#pragma unroll
            for (int j = 0; j < 8; ++j) { const int c = 8 * F.lane + 512 * j;
                const f32x4 A0 = *(const LAS f32x4*)(Acol + c), A1 = *(const LAS f32x4*)(Acol + c + 4), S0 = *(const LAS f32x4*)(Scol + c), S1 = *(const LAS f32x4*)(Scol + c + 4);
                const f32x4 x0 = {h_lo(r[j].x), h_hi(r[j].x), h_lo(r[j].y), h_hi(r[j].y)}, x1 = {h_lo(r[j].z), h_hi(r[j].z), h_lo(r[j].w), h_hi(r[j].w)};
                const f32x4 h0 = x0 * rinv * A0 + S0, h1 = x1 * rinv * A1 + S1; u32x4 w; w.x = cvtpk(h0[0], h0[1]); w.y = cvtpk(h0[2], h0[3]); w.z = cvtpk(h1[0], h1[1]); w.w = cvtpk(h1[2], h1[3]); o16[64 * j] = w; }
            }
        }
    }
    __syncthreads();
}

__device__ __forceinline__ void phase_attn_even(Frame& F) {
    asm volatile("" : "+s"(F.ws), "+s"(F.vcu));
    bf16_t* P = (bf16_t*)(F.ws + WS_PROJ); bf16_t* MX = (bf16_t*)(F.ws + WS_MIXED); bf16_t* ODL = (bf16_t*)(F.ws + WS_ODL); float* LSE = (float*)(F.ws + WS_LSE);
    for (int it = F.vcu; it < 256; it += F.G) { const int bh = it >> 3, x = it & 7, bb = bh >> 4, h = bh & 15;
        for (int pass = 0; pass < 2; ++pass) { const int qb = pass ? x : 15 - x;
            att::Blk k; const size_t t0 = (size_t)bb * SEQ + (size_t)qb * 256;
            k.Q = P + t0 * EVEN_LD + EC_QSB + h * 128;
            k.K = P + (size_t)bb * SEQ * EVEN_LD + EC_KSB + h * 128;
            k.V = P + (size_t)bb * SEQ * EVEN_LD + EC_VSB + h * 128;
            k.O = MX + t0 * DM + h * 128;
            k.G = P + t0 * EVEN_LD + EC_GSB + h * 128;
            k.LSE = nullptr; k.P0 = qb * 256; k.dil = 1; k.ssq = nullptr; k.qw = nullptr; k.cs = nullptr; k.sn = nullptr;
            att::attn_block<2>(k, F.lds, F.wv); } }
    for (int it = F.vcu; it < 256; it += F.G) { const int bh = it >> 3, kr = it & 7, bb = bh >> 4, h = bh & 15;
#pragma unroll 1
        for (int i = 0; i < 6; ++i) { const int sg = F.wv + 8 * i, pat = sg >> 4, j = sg & 15;
            const int dil = pat == 0 ? 1 : (pat == 1 ? 4 : 16); const int r = pat == 0 ? 0 : (pat == 1 ? (j >> 2) : j);
            const int P0 = pat == 0 ? 512 * kr + 32 * j : (pat == 1 ? 128 * kr + 32 * (j & 3) : 32 * kr);
            att::Blk k; const size_t tb = (size_t)bb * SEQ + r, t0 = tb + (size_t)P0 * dil;
            k.Q = P + t0 * EVEN_LD + EC_QDL + h * 128;
            k.K = P + tb * EVEN_LD + EC_KDL + h * 128;
            k.V = P + tb * EVEN_LD + EC_VDL + h * 128;
            k.O = ODL + (size_t)pat * MTOK * 2048 + t0 * 2048 + h * 128;
            k.G = nullptr;
            k.LSE = LSE + (size_t)pat * MTOK * 16 + t0 * 16 + h;  k.P0 = P0; k.dil = dil; k.ssq = nullptr; k.qw = nullptr; k.cs = nullptr; k.sn = nullptr;
            att::attn_dil_wave(k, F.lds, F.lds + XCH_OFF, F.wv); }
        asm volatile("s_waitcnt vmcnt(0)" ::: "memory");
        __syncthreads();
        F.refresh();
        const size_t tokb = (size_t)bb * SEQ + (size_t)kr * 512;
#pragma unroll 1
        for (int u0 = 0; u0 < 16; u0 += 2) {
            u32x4 r0[2], r1[2], r2[2], rg[2]; float l0[2], l1[2], l2[2]; size_t oo[2];
#pragma unroll
            for (int u = 0; u < 2; ++u) { const int idx = F.tid + NTHR * (u0 + u), c = idx & 15; const size_t tok = tokb + (idx >> 4);
                l0[u] = LSE[tok * 16 + h]; l1[u] = LSE[(size_t)MTOK * 16 + tok * 16 + h]; l2[u] = LSE[(size_t)2 * MTOK * 16 + tok * 16 + h];
                r0[u] = *(const u32x4*)(ODL + tok * 2048 + h * 128 + c * 8);
                r1[u] = *(const u32x4*)(ODL + (size_t)MTOK * 2048 + tok * 2048 + h * 128 + c * 8);
                r2[u] = *(const u32x4*)(ODL + (size_t)2 * MTOK * 2048 + tok * 2048 + h * 128 + c * 8);
                rg[u] = __builtin_nontemporal_load((const u32x4*)(P + tok * EVEN_LD + EC_GDL + h * 128 + c * 8));
                oo[u] = tok * DM + 2048 + h * 128 + c * 8; }
#pragma unroll
            for (int u = 0; u < 2; ++u) {
                const float mx = fmaxf(l0[u], fmaxf(l1[u], l2[u]));
                float w0 = __builtin_amdgcn_exp2f(l0[u] - mx), w1 = __builtin_amdgcn_exp2f(l1[u] - mx), w2 = __builtin_amdgcn_exp2f(l2[u] - mx);
                const float inv = 1.0f / (w0 + w1 + w2); w0 *= inv; w1 *= inv; w2 *= inv;
                float x0[8], x1[8], x2[8], g[8], o[8];
                unpack8(r0[u], x0); unpack8(r1[u], x1); unpack8(r2[u], x2); unpack8(rg[u], g);
#pragma unroll
                for (int e = 0; e < 8; ++e) o[e] = (w0 * x0[e] + w1 * x1[e] + w2 * x2[e]) * g[e];
                *(u32x4*)(MX + oo[u]) = pack8u(o);
            }
        }
        __syncthreads();
    }
}
__device__ __forceinline__ void phase_attn_mla(Frame& F, CArgs& a, int lp) {
    asm volatile("" : "+s"(F.ws), "+s"(F.vcu));
    const bf16_t* QR = (const bf16_t*)(F.ws + WS_QRAW); const bf16_t* KF = (const bf16_t*)(F.ws + WS_KF); const bf16_t* VF = (const bf16_t*)(F.ws + WS_VF);
    const bf16_t* P2 = (const bf16_t*)(F.ws + WS_PROJ); bf16_t* MX = (bf16_t*)(F.ws + WS_MIXED);
    const float* ssq = (const float*)(F.ws + WS_CTL + CTL_SSQCQ) + (size_t)lp * MTOK;
    for (int it = F.vcu; it < 512; it += F.G) { const int bh = it >> 3, x = it & 7, bb = bh >> 5, h = bh & 31;
        for (int pass = 0; pass < 2; ++pass) { const int qb = pass ? x : 15 - x;
            att::Blk k; const size_t t0 = (size_t)bb * SEQ + (size_t)qb * 256;
            k.Q = QR + t0 * UQ_N + h * 192;
            k.K = KF + (size_t)bh * SEQ * 192;
            k.V = VF + (size_t)bh * SEQ * 128;
            k.O = MX + t0 * DM + h * 128;
            k.G = P2 + t0 * ODD_INP + OC_G + h * 128;
            k.LSE = nullptr; k.P0 = qb * 256; k.dil = 1;
            k.ssq = ssq + t0; k.qw = (const float*)a.in[IN_ODQN] + lp * 192; k.cs = (const float*)(F.ws + WS_COSM) + t0 * 32; k.sn = (const float*)(F.ws + WS_SINM) + t0 * 32;
            att::attn_block<0>(k, F.lds, F.wv); } }
}

__device__ __forceinline__ void gemm_even_in(Frame& F, CArgs& a, int lp) {
    pg8::Gemm g{(const bf16_t*)(F.ws + WS_H), (const bf16_t*)(F.ws + WS_WEVIN) + (size_t)lp * EVEN_IN * DM, MTOK, EVEN_IN, DM, DM, DM};
    pg8::StaticOrder S; S.init(MTOK, EVEN_IN, F.G, (int)blockIdx.x);
    pg8::EpiEvenIn E{(bf16_t*)(F.ws + WS_PROJ), (const float*)a.in[IN_EVQN] + lp * 128, (const float*)a.in[IN_EVKN] + lp * 128,
                     (const float*)(F.ws + WS_COSF), (const float*)(F.ws + WS_SINF), F.lds + XCH_OFF};
    pg8::gemm_phase<pg8::EpiEvenIn, pg8::StaticOrder>(F.lds, g, S, E, F.wv);
}
__device__ __forceinline__ void gemm_odd_in(Frame& F, CArgs& a, int lp) {
    pg8::Gemm g{(const bf16_t*)(F.ws + WS_H), (const bf16_t*)(F.ws + WS_WODIN) + (size_t)lp * ODD_INP * DM, MTOK, ODD_INP, DM, DM, DM};
    pg8::StaticOrder S; S.init(MTOK, ODD_INP, F.G, (int)blockIdx.x);
    pg8::EpiBf16Op E{(bf16_t*)(F.ws + WS_PROJ), ODD_INP, 2, (const float*)a.in[IN_ODKN] + lp * 192, (const float*)(F.ws + WS_COSM), (const float*)(F.ws + WS_SINM), (float*)(F.ws + WS_CTL + CTL_SSQCQ) + (size_t)lp * MTOK, (float*)(F.ws + WS_CTL + CTL_SSQKV) + (size_t)lp * 2 * MTOK, (float*)(F.ws + WS_CTL + CTL_SSQKV) + (size_t)lp * 2 * MTOK + 1};
    pg8::gemm_phase<pg8::EpiBf16Op, pg8::StaticOrder>(F.lds, g, S, E, F.wv);
}
__device__ __forceinline__ void gemm_odd_up(Frame& F, CArgs& a, int lp) {
    { pg8::Gemm g{(const bf16_t*)(F.ws + WS_PROJ) + OC_CQ, (const bf16_t*)(F.ws + WS_WUQ) + (size_t)lp * UQ_N * QLORA, MTOK, UQ_N, QLORA, ODD_INP, QLORA};
      pg8::StaticOrder S; S.init(MTOK, UQ_N, F.G, (int)blockIdx.x);
      pg8::EpiBf16Op E{(bf16_t*)(F.ws + WS_QRAW), UQ_N, 0, nullptr, nullptr, nullptr, nullptr, nullptr, nullptr};
      pg8::gemm_phase<pg8::EpiBf16Op, pg8::StaticOrder>(F.lds, g, S, E, F.wv); }
    { pg8::Gemm g{(const bf16_t*)(F.ws + WS_PROJ) + OC_CKV, (const bf16_t*)(F.ws + WS_WUKV) + (size_t)lp * UKV_N * KVLORA, MTOK, UKV_N, KVLORA, ODD_INP, KVLORA};
      pg8::StaticOrder S; S.init(MTOK, UKV_N, F.G, (int)blockIdx.x);
      pg8::EpiKV E{(bf16_t*)(F.ws + WS_KF), (bf16_t*)(F.ws + WS_VF), (const bf16_t*)(F.ws + WS_PROJ), (const float*)(F.ws + WS_CTL + CTL_SSQKV) + (size_t)lp * 2 * MTOK, nullptr,
                   (const float*)a.in[IN_ODKN] + lp * 192, (const float*)(F.ws + WS_COSM), (const float*)(F.ws + WS_SINM), F.lds + XCH_OFF};
      pg8::gemm_phase<pg8::EpiKV, pg8::StaticOrder>(F.lds, g, S, E, F.wv); }
}
__device__ __forceinline__ void gemm_out(Frame& F, const bf16_t* Wt, const float* xs32, float* xo32, const float* gate) {
    unsigned short* XH = (unsigned short*)(F.ws + WS_XH);
    pg8::Gemm g{(const bf16_t*)(F.ws + WS_MIXED), Wt, MTOK, DM, DM, DM, DM};
    pg8::StaticOrder S; S.init(MTOK, DM, F.G, (int)blockIdx.x);
    pg8::EpiResid E{xs32, xs32 ? nullptr : XH, xo32, xo32 ? nullptr : XH, gate};
    pg8::gemm_phase<pg8::EpiResid, pg8::StaticOrder>(F.lds, g, S, E, F.wv);
}

constexpr int N_PHASES = 25;
#ifndef REPEAT_MASK
#define REPEAT_MASK 0
#endif
#define REP(idx) ((REPEAT_MASK >> (idx)) & 1)
__global__ void __launch_bounds__(NTHR, 2) mega_fwd(Args args) {
    extern __shared__ __attribute__((aligned(16))) unsigned char lds_raw[];
    Frame F;
    F.lds = (LAS unsigned char*)lds_raw;
    F.tid = threadIdx.x; F.lane = F.tid & 63; F.wave = __builtin_amdgcn_readfirstlane(F.tid >> 6); F.wv = F.wave;
    F.G = gridDim.x; { const int bx = blockIdx.x; F.vcu = (F.G % 8 == 0) ? (bx % 8) * (F.G / 8) + bx / 8 : bx; }
    F.ws = args.ws;
    for (int u = F.tid; u < (LDS_BYTES - LDSCTL_OFF) / 4; u += NTHR) ((LAS unsigned*)(F.lds + LDSCTL_OFF))[u] = 0u;
    __syncthreads();
    const int lo = args.ph_lo, hi = args.ph_hi;
    XcdBarrier bar; bar.bar = (unsigned*)(F.ws + WS_CTL) + CW_BAR; bar.x = 0; bar.st = nullptr; bar.wv = F.wv;
    if (hi - lo > 1) bar = xcd_barrier_post((unsigned*)(F.ws + WS_CTL) + CW_BAR, (volatile LAS unsigned*)(F.lds + MISC_OFF) + 8, F.wv);
#define IN(k) (lo <= (k) && (k) < hi)
#define SEAM(k) do { if (IN(k) && IN((k) + 1)) xcd_barrier(bar); } while (0)
    const float* xin = (const float*)args.in[IN_X];
    float* xout = args.out;
    const float* MOD = (const float*)(F.ws + WS_MOD);

#define KA (*kargs())
#define RUN(k, idx, BODY) do { if (IN(k)) { BODY; if (REP(idx)) { xcd_barrier(bar); BODY; } } SEAM(k); } while (0)
    RUN(0, 0, phase_prologue(F, KA));

    for (int lp = 0; lp < 2; ++lp) {
        const int base = 1 + 12 * lp;
        { const int layer = 2 * lp; const float* xs = (layer == 0) ? xin : nullptr;
        RUN(base + 0, 1, phase_h(F, KA, layer, xs));
        RUN(base + 1, 2, gemm_even_in(F, KA, lp));
        RUN(base + 3, 4, phase_attn_even(F));
        RUN(base + 5, 6, gemm_out(F, (const bf16_t*)(F.ws + WS_WEVOUT) + (size_t)lp * DM * DM, xs, nullptr, MOD + (size_t)(layer * 2) * 12288 + 2 * DM));
        }
        { const int layer = 2 * lp + 1;
        RUN(base + 6, 7, phase_h(F, KA, layer, nullptr));
        RUN(base + 7, 8, gemm_odd_in(F, KA, lp));
        RUN(base + 8, 9, gemm_odd_up(F, KA, lp));
        RUN(base + 10, 11, phase_attn_mla(F, KA, lp));
        RUN(base + 11, 12, gemm_out(F, (const bf16_t*)(F.ws + WS_WODOUT) + (size_t)lp * DM * DM, nullptr, (lp == 1) ? xout : nullptr, MOD + (size_t)(layer * 2) * 12288 + 2 * DM));
        }
    }
#undef RUN
#undef KA
#undef IN
#undef SEAM
}

extern "C" void kernel_launch(void* const* d_in, const int* in_sizes, int n_in, void* d_out, int out_size, void* d_ws, size_t ws_size, hipStream_t stream) {
    static int grid = 0;
    if (grid == 0) {
        if (n_in != 18 || out_size != MTOK * DM || ws_size < WS_END) { fprintf(stderr, "kernel_launch: unexpected shapes (n_in %d, out %d, ws %zu); nothing launched\n", n_in, out_size, ws_size); grid = -1; return; }
        int dev = 0, cus = 0, per_cu = 0;
        if (hipGetDevice(&dev) != hipSuccess || hipDeviceGetAttribute(&cus, hipDeviceAttributeMultiprocessorCount, dev) != hipSuccess) { grid = -1; return; }
        if (hipFuncSetAttribute((const void*)mega_fwd, hipFuncAttributeMaxDynamicSharedMemorySize, LDS_BYTES) != hipSuccess) { fprintf(stderr, "kernel_launch: hipFuncSetAttribute failed\n"); grid = -1; return; }
        if (hipOccupancyMaxActiveBlocksPerMultiprocessor(&per_cu, (const void*)mega_fwd, NTHR, LDS_BYTES) != hipSuccess || per_cu < 1)
            fprintf(stderr, "kernel_launch: note: occupancy query reports %d workgroups per CU\n", per_cu);
        (void)hipGetLastError();
        grid = cus;
    }
    if (grid < 0) return;
    if (hipMemsetAsync((char*)d_ws + WS_CTL, 0, CTL_ZERO_BYTES, stream) != hipSuccess) { fprintf(stderr, "kernel_launch: memset failed\n"); return; }
    Args a{};
    for (int i = 0; i < 18; ++i) a.in[i] = d_in[i];
    a.out = (float*)d_out; a.ws = (unsigned char*)d_ws;
#if MK_N_LAUNCHES == 1
    a.ph_lo = 0; a.ph_hi = N_PHASES;
    hipLaunchKernelGGL(mega_fwd, dim3(grid), dim3(NTHR), LDS_BYTES, stream, a);
#else
    for (int k = 0; k < N_PHASES; ++k) { a.ph_lo = k; a.ph_hi = k + 1; hipLaunchKernelGGL(mega_fwd, dim3(grid), dim3(NTHR), LDS_BYTES, stream, a); }
#endif
}
```

```cpp
#include <hip/hip_runtime.h>
#include <cstdio>
#include <cstdint>

#ifndef MK_N_LAUNCHES
#define MK_N_LAUNCHES 1
#endif

#define LAS __attribute__((address_space(3)))
#define GAS __attribute__((address_space(1)))
typedef unsigned short bf16_t;
typedef short bf16x8 __attribute__((ext_vector_type(8)));
typedef short s16x4 __attribute__((ext_vector_type(4)));
typedef float f32x2 __attribute__((ext_vector_type(2)));
typedef float f32x4 __attribute__((ext_vector_type(4)));
typedef float f32x16 __attribute__((ext_vector_type(16)));
typedef unsigned u32x2 __attribute__((ext_vector_type(2)));
typedef unsigned u32x4 __attribute__((ext_vector_type(4)));
typedef __bf16 hbf16x2 __attribute__((ext_vector_type(2)));

constexpr int NB = 2, SEQ = 4096, DM = 4096, MTOK = NB * SEQ, DEPTH = 4;
constexpr int EVEN_IN = 16384, ODD_IN = 5696, ODD_INP = 5888;
constexpr int EVEN_LD = EVEN_IN + 2176;
constexpr int QLORA = 1024, KVLORA = 512, NH_MLA = 32, NH_SB = 16, NH_DL = 16;
constexpr int UQ_N = 6144, UKV_N = 8192;
constexpr float EPS = 1e-6f;
constexpr float LOG2E = 1.4426950408889634f;
constexpr float QS128 = 1.4426950408889634f * 0.08838834764831845f;
constexpr float QS192 = 1.4426950408889634f * 0.07216878364870322f;
constexpr int EC_QSB = 0, EC_KSB = 2048, EC_VSB = 4096, EC_GSB = 6144, EC_QDL = 8192, EC_KDL = 10240, EC_VDL = 12288, EC_GDL = 14336;
constexpr int OC_CQ = 0, OC_CKV = 1024, OC_G = 1536, OC_KPE = 5632;

constexpr int RING_BYTES_C = 131072;
constexpr size_t MiB = 1u << 20;
constexpr size_t WS_CTL = 0, CTL_ZERO_BYTES = 1 * MiB;
constexpr size_t WS_MOD = 1 * MiB;
constexpr size_t WS_COSF = 2 * MiB, WS_SINF = 4 * MiB;
constexpr size_t WS_COSM = 6 * MiB, WS_SINM = 7 * MiB;
constexpr size_t WS_DIAG = 8 * MiB;
constexpr size_t WS_WEVIN = 16 * MiB;
constexpr size_t WS_WEVOUT = 272 * MiB;
constexpr size_t WS_WODIN = 336 * MiB;
constexpr size_t WS_WUQ = 428 * MiB;
constexpr size_t WS_WUKV = 452 * MiB;
constexpr size_t WS_WODOUT = 468 * MiB;
constexpr size_t WS_H = 544 * MiB;
constexpr size_t WS_PROJ = 1506 * MiB;
constexpr size_t WS_MIXED = 864 * MiB;
constexpr size_t WS_ODL = 928 * MiB;
constexpr size_t WS_LSE = 1024 * MiB;
constexpr size_t WS_QRAW = 1026 * MiB;
constexpr size_t WS_KVRAW = 1122 * MiB;
constexpr size_t WS_XH = 1122 * MiB;
constexpr size_t WS_QF = 1250 * MiB;
constexpr size_t WS_KF = 1346 * MiB;
constexpr size_t WS_VF = 1442 * MiB;
constexpr size_t WS_END = 1800 * MiB;
constexpr int CW_BAR = 4096;
constexpr size_t CTL_SSQCQ = 524288, CTL_SSQKV = CTL_SSQCQ + 2 * MTOK * 4;
static_assert(CTL_SSQKV + 4 * MTOK * 4 <= CTL_ZERO_BYTES, "CTL map");
constexpr int XCH_OFF = RING_BYTES_C + 1024;

constexpr int RING_BYTES = 131072;
constexpr int LDSCTL_OFF = RING_BYTES, MISC_OFF = LDSCTL_OFF + 320;
constexpr int LDS_BYTES = 147456;
constexpr int NWAVES = 8, NTHR = 512;

__device__ __forceinline__ unsigned cvtpk(float lo, float hi) { f32x2 v = {lo, hi}; hbf16x2 b = __builtin_convertvector(v, hbf16x2); return __builtin_bit_cast(unsigned, b); }
typedef _Float16 hf16x2 __attribute__((ext_vector_type(2)));
__device__ __forceinline__ unsigned pkh(float lo, float hi) { hf16x2 h; h.x = (_Float16)lo; h.y = (_Float16)hi; return __builtin_bit_cast(unsigned, h); }
__device__ __forceinline__ float h_lo(unsigned w) { return (float)__builtin_bit_cast(hf16x2, w).x; }
__device__ __forceinline__ float h_hi(unsigned w) { return (float)__builtin_bit_cast(hf16x2, w).y; }
__device__ __forceinline__ float bf_lo(unsigned w) { return __uint_as_float(w << 16); }
__device__ __forceinline__ float bf_hi(unsigned w) { return __uint_as_float(w & 0xffff0000u); }
__device__ __forceinline__ float bf2f(bf16_t b) { return __uint_as_float(((unsigned)b) << 16); }
__device__ __forceinline__ void unpack8(u32x4 w, float (&x)[8]) { x[0] = bf_lo(w.x); x[1] = bf_hi(w.x); x[2] = bf_lo(w.y); x[3] = bf_hi(w.y); x[4] = bf_lo(w.z); x[5] = bf_hi(w.z); x[6] = bf_lo(w.w); x[7] = bf_hi(w.w); }
__device__ __forceinline__ u32x4 pack8u(const float (&x)[8]) { u32x4 w; w.x = cvtpk(x[0], x[1]); w.y = cvtpk(x[2], x[3]); w.z = cvtpk(x[4], x[5]); w.w = cvtpk(x[6], x[7]); return w; }
__device__ __forceinline__ int lane_fresh() { int l; asm volatile("v_mbcnt_lo_u32_b32 %0, -1, 0\n\tv_mbcnt_hi_u32_b32 %0, -1, %0" : "=v"(l)); return l; }
__device__ __forceinline__ float sum16(float v) { auto r = __builtin_amdgcn_permlane16_swap(__float_as_uint(v), __float_as_uint(v), false, false); return __uint_as_float(r[0]) + __uint_as_float(r[1]); }
__device__ __forceinline__ float sum32(float v) { auto r = __builtin_amdgcn_permlane32_swap(__float_as_uint(v), __float_as_uint(v), false, false); return __uint_as_float(r[0]) + __uint_as_float(r[1]); }
__device__ __forceinline__ float dpp_xor1(float v) { return __int_as_float(__builtin_amdgcn_update_dpp(0, __float_as_int(v), 0xB1  , 0xF, 0xF, true)); }
__device__ __forceinline__ float wave_sum(float v) {
    v += __int_as_float(__builtin_amdgcn_update_dpp(0, __float_as_int(v), 0xB1, 0xF, 0xF, true));
    v += __int_as_float(__builtin_amdgcn_update_dpp(0, __float_as_int(v), 0x4E, 0xF, 0xF, true));
    v += __int_as_float(__builtin_amdgcn_update_dpp(0, __float_as_int(v), 0x124, 0xF, 0xF, true));
    v += __int_as_float(__builtin_amdgcn_update_dpp(0, __float_as_int(v), 0x128, 0xF, 0xF, true));
    v = sum16(v); v = sum32(v);
    return v;
}
__device__ __forceinline__ float silu_f(float v) { return v * __builtin_amdgcn_rcpf(1.0f + __builtin_amdgcn_exp2f(-v * LOG2E)); }
__device__ __forceinline__ int opaque_tid(int wv) { int t = wv * 64 + lane_fresh(); asm volatile("" : "+v"(t)); return t; }
#define LDS_WAIT() asm volatile("s_waitcnt lgkmcnt(0)" ::: "memory")
#define VM_WAIT() asm volatile("s_waitcnt vmcnt(0)" ::: "memory")
#define SBAR() __builtin_amdgcn_sched_barrier(0)

namespace pg8 {
constexpr int BM = 256, BK = 64, HALF = 128, HTB = HALF * BK * 2, STAGE_BYTES = 8 * HTB, NXCD = 8, WGM = 8;
__host__ __device__ __forceinline__ int lds_byte(int r, int c) { const int st = (r >> 4) * 2 + (c >> 5), rr = r & 15, cc = c & 31, ob = rr * 64 + cc * 2; return st * 1024 + (ob ^ (((ob >> 9) & 1) << 5)); }
__host__ __device__ __forceinline__ void stage_rc(int b, int& R, int& C) { const int st = b / 1024, sb = b % 1024, swz = sb ^ (((sb >> 9) & 1) << 5); R = (st >> 1) * 16 + swz / 64; C = (st & 1) * 32 + (swz % 64) / 2; }
__host__ __device__ __forceinline__ int perm32(int rho) { const int n = rho >> 4, i = rho & 15; return 8 * (i >> 2) + 4 * n + (i & 3); }
struct Unit { int pm, pn; };
struct Gemm { const bf16_t* A; const bf16_t* Bt; int M, N, K, lda, ldb; };
struct StaticOrder {
    int nM, nN, nwg, G, c;
    __host__ __device__ void init(int M, int N, int G_, int c_) { nM = M / BM; nN = N / BM; nwg = nM * nN; G = G_; c = c_; }
    __host__ __device__ bool next(int i, Unit& u) const {
        const int L = i * G + c; if (L >= nwg) return false;
        int wgid = L; { const int q = nwg / NXCD, r = nwg % NXCD, xcd = wgid % NXCD, off = wgid / NXCD; wgid = (xcd < r ? xcd * (q + 1) : r * (q + 1) + (xcd - r) * q) + off; }
        const int nig = WGM * nN, gid = wgid / nig, fm = gid * WGM, gsz = (nM - fm) < WGM ? (nM - fm) : WGM;
        u.pm = fm + ((wgid % nig) % gsz); u.pn = (wgid % nig) / gsz; return true;
    }
    __device__ __forceinline__ void a_ready(const Unit&) const {}
    __device__ __forceinline__ void done(const Unit&) const {}
};
struct EpiBf16Op {
    static constexpr bool PERM = true;
    bf16_t* O; int ldc;
    int kind;
    const float* knw; const float* cosM; const float* sinM;
    float* ssq_q; float* ssq_kv; float* ssq_pe;
    __device__ __forceinline__ void operator()(const f32x4 (&acc)[2][2][4][2], const Unit& u, int wr, int wc, int fr, int fq) const {
        const int row0 = u.pm * BM + wr * 64 + fr, col0 = u.pn * BM + wc * 32 + 8 * fq;
        float sc = 1.f; bool act = false;
        if (kind == 1) { const int seg = u.pn >> 3; if (seg == 0) sc = QS128; act = (seg == 3) || (seg == 7); }
        else if (kind == 2) { act = (u.pn >= 6) && (u.pn < 22); }
#pragma unroll
        for (int ai = 0; ai < 2; ++ai)
#pragma unroll
            for (int m = 0; m < 4; ++m) { bf16_t* rowp = O + (size_t)(row0 + ai * HALF + m * 16) * ldc + col0;
#pragma unroll
                for (int bj = 0; bj < 2; ++bj) { f32x4 v0 = acc[ai][bj][m][0] * sc, v1 = acc[ai][bj][m][1] * sc;
                    if (kind == 2 && u.pn == 22 && bj == 0 && wc < 2) { const int i4 = 4 * (4 * wc + fq); const size_t row = (size_t)(row0 + ai * HALF + m * 16);
                        const f32x4 w1 = *(const f32x4*)(knw + 128 + i4), w2 = *(const f32x4*)(knw + 160 + i4);
                        const f32x4 c = *(const f32x4*)(cosM + row * 32 + i4), sn = *(const f32x4*)(sinM + row * 32 + i4);
                        const f32x4 x1 = v0 * w1, x2 = v1 * w2; v0 = x1 * c - x2 * sn; v1 = x2 * c + x1 * sn; }
                    if (act) {
#pragma unroll
                        for (int j = 0; j < 4; ++j) { v0[j] = silu_f(v0[j]); v1[j] = silu_f(v1[j]); } }
                    u32x4 w; w.x = cvtpk(v0[0], v0[1]); w.y = cvtpk(v0[2], v0[3]); w.z = cvtpk(v1[0], v1[1]); w.w = cvtpk(v1[2], v1[3]);
                    *(u32x4*)(rowp + bj * HALF) = w; }
                if (kind == 2 && u.pn < 6) { float sq = 0.f;
#pragma unroll
                    for (int bj = 0; bj < 2; ++bj)
#pragma unroll
                        for (int n = 0; n < 2; ++n) { const f32x4 x = acc[ai][bj][m][n]; sq += (x[0] * x[0] + x[1] * x[1]) + (x[2] * x[2] + x[3] * x[3]); }
                    sq = sum16(sq); sq = sum32(sq);
                    if (fq == 0) { if (u.pn < 4) atomicAdd(ssq_q + row0 + ai * HALF + m * 16, sq); else atomicAdd(ssq_kv + 2 * (row0 + ai * HALF + m * 16), sq); } }
                if (kind == 2 && u.pn == 22 && wc < 2) { float sq = 0.f;
#pragma unroll
                    for (int n = 0; n < 2; ++n) { const f32x4 x = acc[ai][0][m][n]; sq += (x[0] * x[0] + x[1] * x[1]) + (x[2] * x[2] + x[3] * x[3]); }
                    sq = sum16(sq); sq = sum32(sq);
                    if (fq == 0) atomicAdd(ssq_pe + 2 * (row0 + ai * HALF + m * 16), sq); } }
    }
};
struct EpiKV {
    static constexpr bool PERM = true;
    bf16_t* KF; bf16_t* VF;
    const bf16_t* P2;
    const float* ssqkv;
    const float* ssqpe;
    const float* knw;
    const float* cosM; const float* sinM;
    LAS unsigned char* xl;
    __device__ __forceinline__ void operator()(const f32x4 (&acc)[2][2][4][2], const Unit& u, int wr, int wc, int fr, int fq) const {
        asm volatile("" : "+v"(fr), "+v"(fq));
        const int rl0 = wr * 64 + fr, q4 = 4 * (4 * wc + fq); const bool ropel = wc < 2;
        LAS f32x2* X = (LAS f32x2*)xl;
        float sq8[8], pe8[8];
#pragma unroll
        for (int rr = 0; rr < 8; ++rr) { const size_t row = (size_t)u.pm * BM + rl0 + (rr >> 2) * HALF + (rr & 3) * 16; const f32x2 t2 = *(const f32x2*)(ssqkv + 2 * row); sq8[rr] = t2[0]; pe8[rr] = t2[1]; }
#pragma unroll
        for (int ai = 0; ai < 2; ++ai)
#pragma unroll
            for (int m = 0; m < 4; ++m) { const int rloc = rl0 + ai * HALF + m * 16;
                float pn = 0.f;
#pragma unroll
                for (int n = 0; n < 2; ++n) { const f32x4 x = acc[ai][0][m][n]; pn += (x[0] * x[0] + x[1] * x[1]) + (x[2] * x[2] + x[3] * x[3]); }
                pn = sum16(pn); pn = sum32(pn);
                if (fq == 0) X[rloc * 4 + wc] = (f32x2){pn, 0.f}; }
        asm volatile("s_waitcnt lgkmcnt(0)" ::: "memory"); __builtin_amdgcn_s_barrier(); asm volatile("" ::: "memory");
        const int bh = (u.pm >> 4) * NH_MLA + u.pn;
        const f32x4 wka = *(const f32x4*)(knw + wc * 32 + fq * 8), wkb = *(const f32x4*)(knw + wc * 32 + fq * 8 + 4);
        float rk8[8];
        u32x4 R8[8];
#pragma unroll
        for (int ai = 0; ai < 2; ++ai)
#pragma unroll
            for (int m = 0; m < 4; ++m) { const int rloc = rl0 + ai * HALF + m * 16; const size_t row = (size_t)u.pm * BM + rloc; const int srow = (int)(row & (SEQ - 1));
                const f32x4 xa = *(const LAS f32x4*)(X + rloc * 4), xb = *(const LAS f32x4*)(X + rloc * 4 + 2);
                const float ssn = (xa[0] + xa[2]) + (xb[0] + xb[2]), spe = pe8[ai * 4 + m];
                const float rkv = __builtin_amdgcn_rsqf(sq8[ai * 4 + m] * (1.0f / KVLORA) + EPS);
                const float rk = __builtin_amdgcn_rsqf((rkv * rkv * ssn + spe) * (1.0f / 192.0f) + EPS), sk = rkv * rk;
                rk8[ai * 4 + m] = rk;
                const size_t trow = (size_t)bh * SEQ + srow;
                { const f32x4 b0 = acc[ai][0][m][0] * wka * sk, b1 = acc[ai][0][m][1] * wkb * sk; u32x4 w;
                  w.x = cvtpk(b0[0], b0[1]); w.y = cvtpk(b0[2], b0[3]); w.z = cvtpk(b1[0], b1[1]); w.w = cvtpk(b1[2], b1[3]);
                  *(u32x4*)(KF + trow * 192 + wc * 32 + fq * 8) = w; }
                { const f32x4 a0 = acc[ai][1][m][0] * rkv, a1 = acc[ai][1][m][1] * rkv; u32x4 w;
                  w.x = cvtpk(a0[0], a0[1]); w.y = cvtpk(a0[2], a0[3]); w.z = cvtpk(a1[0], a1[1]); w.w = cvtpk(a1[2], a1[3]);
                  *(u32x4*)(VF + trow * 128 + wc * 32 + fq * 8) = w; }
                if (ropel) R8[ai * 4 + m] = *(const u32x4*)(P2 + row * ODD_INP + OC_KPE + wc * 32 + fq * 8); }
        asm volatile("" ::: "memory");
        if (ropel) {
#pragma unroll
            for (int rr = 0; rr < 8; ++rr) { const size_t row = (size_t)u.pm * BM + rl0 + (rr >> 2) * HALF + (rr & 3) * 16; const int srow = (int)(row & (SEQ - 1));
                const float rk = rk8[rr]; const size_t trow = (size_t)bh * SEQ + srow;
                float x[8]; unpack8(R8[rr], x);
                u32x2 o1, o2;
                o1.x = cvtpk(x[0] * rk, x[1] * rk); o1.y = cvtpk(x[2] * rk, x[3] * rk); o2.x = cvtpk(x[4] * rk, x[5] * rk); o2.y = cvtpk(x[6] * rk, x[7] * rk);
                *(u32x2*)(KF + trow * 192 + 128 + q4) = o1; *(u32x2*)(KF + trow * 192 + 160 + q4) = o2; }
        }
    }
};
struct EpiEvenIn {
    static constexpr bool PERM = true;
    bf16_t* O;
    const float* qn; const float* kn;
    const float* cosF; const float* sinF;
    LAS unsigned char* xl;
    __device__ __forceinline__ void operator()(const f32x4 (&acc)[2][2][4][2], const Unit& u, int wr, int wc, int fr, int fq) const {
        asm volatile("" : "+v"(fr), "+v"(fq));
        const int row0 = u.pm * BM + wr * 64 + fr, col0 = u.pn * BM + wc * 32 + 8 * fq;
        const int seg = u.pn >> 3;
        if (seg == 4 || seg == 5) {
            const int rl0 = wr * 64 + fr, i4 = 4 * (4 * wc + fq);
            LAS float* X = (LAS float*)xl;
#pragma unroll
            for (int ai = 0; ai < 2; ++ai)
#pragma unroll
                for (int m = 0; m < 4; ++m) { const int rloc = rl0 + ai * HALF + m * 16;
#pragma unroll
                    for (int bj = 0; bj < 2; ++bj) { const f32x4 x = acc[ai][bj][m][0], y = acc[ai][bj][m][1];
                        float s = ((x[0] * x[0] + x[1] * x[1]) + (x[2] * x[2] + x[3] * x[3])) + ((y[0] * y[0] + y[1] * y[1]) + (y[2] * y[2] + y[3] * y[3]));
                        s = sum16(s); s = sum32(s);
                        if (fq == 0) X[(rloc * 2 + bj) * 4 + wc] = s; } }
            asm volatile("s_waitcnt lgkmcnt(0)" ::: "memory"); __builtin_amdgcn_s_barrier(); asm volatile("" ::: "memory");
            const float* wv = (seg == 4) ? qn : kn; const float osc = (seg == 4) ? QS128 : 1.0f;
            const f32x4 w1 = *(const f32x4*)(wv + i4), w2 = *(const f32x4*)(wv + 64 + i4);
#pragma unroll
            for (int ai = 0; ai < 2; ++ai)
#pragma unroll
                for (int m = 0; m < 4; ++m) { const int rloc = rl0 + ai * HALF + m * 16; const size_t row = (size_t)u.pm * BM + rloc;
                    const f32x4 c = *(const f32x4*)(cosF + row * 64 + i4), sn = *(const f32x4*)(sinF + row * 64 + i4);
                    const f32x4 xs0 = *(const LAS f32x4*)(X + (rloc * 2 + 0) * 4), xs1 = *(const LAS f32x4*)(X + (rloc * 2 + 1) * 4);
#pragma unroll
                    for (int bj = 0; bj < 2; ++bj) { const f32x4 xs = bj ? xs1 : xs0;
                        const float rinv = __builtin_amdgcn_rsqf(((xs[0] + xs[1]) + (xs[2] + xs[3])) * (1.0f / 128.0f) + EPS);
                        const f32x4 y1 = acc[ai][bj][m][0] * w1 * rinv, y2 = acc[ai][bj][m][1] * w2 * rinv;
                        const f32x4 o1 = (y1 * c - y2 * sn) * osc, o2 = (y2 * c + y1 * sn) * osc;
                        u32x4 w; w.x = cvtpk(o1[0], o1[1]); w.y = cvtpk(o1[2], o1[3]); w.z = cvtpk(o2[0], o2[1]); w.w = cvtpk(o2[2], o2[3]);
                        *(u32x4*)(O + row * EVEN_LD + col0 + bj * HALF) = w; } }
            return;
        }
        const float sc = (seg == 0) ? QS128 : 1.f; const bool act = (seg == 3) || (seg == 7);
#pragma unroll
        for (int ai = 0; ai < 2; ++ai)
#pragma unroll
            for (int m = 0; m < 4; ++m) { bf16_t* rowp = O + (size_t)(row0 + ai * HALF + m * 16) * EVEN_LD + col0;
#pragma unroll
                for (int bj = 0; bj < 2; ++bj) { f32x4 v0 = acc[ai][bj][m][0] * sc, v1 = acc[ai][bj][m][1] * sc;
                    if (act) {
#pragma unroll
                        for (int j = 0; j < 4; ++j) { v0[j] = silu_f(v0[j]); v1[j] = silu_f(v1[j]); } }
                    u32x4 w; w.x = cvtpk(v0[0], v0[1]); w.y = cvtpk(v0[2], v0[3]); w.z = cvtpk(v1[0], v1[1]); w.w = cvtpk(v1[2], v1[3]);
                    *(u32x4*)(rowp + bj * HALF) = w; } }
    }
};
struct EpiResid {
    static constexpr bool PERM = true;
    const float* xin32; const unsigned short* xin16; float* xout32; unsigned short* xout16; const float* gate;
    __device__ __forceinline__ void operator()(const f32x4 (&acc)[2][2][4][2], const Unit& u, int wr, int wc, int fr, int fq) const {
        const int row0 = u.pm * BM + wr * 64 + fr, col0 = u.pn * BM + wc * 32 + 8 * fq;
        const float* gp = gate + (u.pm >= 16 ? 12288 : 0) + col0;
        f32x4 gv[2][2];
#pragma unroll
        for (int bj = 0; bj < 2; ++bj)
#pragma unroll
            for (int n = 0; n < 2; ++n) gv[bj][n] = *(const f32x4*)(gp + bj * HALF + n * 4);
        const bool in16 = xin16 != nullptr, out16 = xout16 != nullptr;
        if (in16) {
#pragma unroll
            for (int ai = 0; ai < 2; ++ai) {
                u32x4 raw[4][2];
#pragma unroll
                for (int m = 0; m < 4; ++m)
#pragma unroll
                    for (int bj = 0; bj < 2; ++bj) raw[m][bj] = *(const u32x4*)(xin16 + (size_t)(row0 + ai * HALF + m * 16) * DM + col0 + bj * HALF);
#pragma unroll
                for (int m = 0; m < 4; ++m) { const size_t off = (size_t)(row0 + ai * HALF + m * 16) * DM + col0;
#pragma unroll
                    for (int bj = 0; bj < 2; ++bj) { const u32x4 r = raw[m][bj];
                        const f32x4 x0 = {h_lo(r.x), h_hi(r.x), h_lo(r.y), h_hi(r.y)}, x1 = {h_lo(r.z), h_hi(r.z), h_lo(r.w), h_hi(r.w)};
                        const f32x4 y0 = x0 + gv[bj][0] * acc[ai][bj][m][0], y1 = x1 + gv[bj][1] * acc[ai][bj][m][1];
                        if (out16) { u32x4 w; w.x = pkh(y0[0], y0[1]); w.y = pkh(y0[2], y0[3]); w.z = pkh(y1[0], y1[1]); w.w = pkh(y1[2], y1[3]); *(u32x4*)(xout16 + off + bj * HALF) = w; }
                        else { *(f32x4*)(xout32 + off + bj * HALF) = y0; *(f32x4*)(xout32 + off + bj * HALF + 4) = y1; } } }
                asm volatile("" ::: "memory");
            }
            return;
        }
#pragma unroll
        for (int g2 = 0; g2 < 4; ++g2) { const int ai = g2 >> 1, mb = (g2 & 1) * 2;
            f32x4 xo[2][2][2];
#pragma unroll
            for (int m = 0; m < 2; ++m)
#pragma unroll
                for (int bj = 0; bj < 2; ++bj)
#pragma unroll
                    for (int n = 0; n < 2; ++n) xo[m][bj][n] = *(const f32x4*)(xin32 + (size_t)(row0 + ai * HALF + (mb + m) * 16) * DM + col0 + bj * HALF + n * 4);
#pragma unroll
            for (int m = 0; m < 2; ++m) { const size_t off = (size_t)(row0 + ai * HALF + (mb + m) * 16) * DM + col0;
#pragma unroll
                for (int bj = 0; bj < 2; ++bj) { const f32x4 y0 = xo[m][bj][0] + gv[bj][0] * acc[ai][bj][m == 0 ? mb : mb + 1][0], y1 = xo[m][bj][1] + gv[bj][1] * acc[ai][bj][m == 0 ? mb : mb + 1][1];
                    if (out16) { u32x4 w; w.x = pkh(y0[0], y0[1]); w.y = pkh(y0[2], y0[3]); w.z = pkh(y1[0], y1[1]); w.w = pkh(y1[2], y1[3]); *(u32x4*)(xout16 + off + bj * HALF) = w; }
                    else { *(f32x4*)(xout32 + off + bj * HALF) = y0; *(f32x4*)(xout32 + off + bj * HALF + 4) = y1; } } }
            asm volatile("" ::: "memory");
        }
    }
};

template <class Epi, class Sched, bool ALIGN_EPI = true, bool SP2 = true>
__device__ __forceinline__ void gemm_phase(LAS unsigned char* lds, const Gemm g, const Sched& S, const Epi& E, int wv) {
    const int tid = opaque_tid(wv), wid = __builtin_amdgcn_readfirstlane(tid >> 6), lane = tid & 63, wr = wid >> 2, wc = wid & 3, fr = lane & 15, fq = lane >> 4;
    const int K = g.K, nt = K / BK;
    unsigned voffA[2], voffB[2];
#pragma unroll
    for (int i = 0; i < 2; ++i) { int R, C; stage_rc(tid * 16 + i * 8192, R, C); const int Rb = Epi::PERM ? ((R & ~31) + perm32(R & 31)) : R;
        voffA[i] = (unsigned)(R * g.lda + C) * 2u; voffB[i] = (unsigned)(Rb * g.ldb + C) * 2u; }
    const size_t kstep = (size_t)(BK * 2);
    const size_t hstepA = (size_t)HALF * g.lda * 2, hstepB = (size_t)HALF * g.ldb * 2;
    const size_t tstepA = 2 * hstepA, tstepB = 2 * hstepB;
    const unsigned ldsw = (unsigned)wid * 1024u;
    const int aoff = lds_byte(wr * 64 + fr, fq * 8), boff = lds_byte(wc * 32 + fr, fq * 8);
#define PG8_SA(b, h) (((b) * 2 + (h)) * HTB)
#define PG8_SB(b, h) ((4 + (b) * 2 + (h)) * HTB)
#define PG8_STAGE(bufoff, gbase, voff) do { _Pragma("unroll") for (int _i = 0; _i < 2; ++_i) \
        __builtin_amdgcn_global_load_lds((const unsigned*)((const char*)(gbase) + (voff)[_i]), (LAS unsigned*)(lds + (bufoff) + ldsw + _i * 8192), 16, 0, 0); } while (0)
#define PG8_LDA(dst, b, h) do { _Pragma("unroll") for (int m = 0; m < 4; ++m) _Pragma("unroll") for (int k = 0; k < 2; ++k) dst[m][k] = *(const LAS bf16x8*)(lds + PG8_SA(b, h) + aoff + m * 2048 + k * 1024); } while (0)
#define PG8_LDB(dst, b, h) do { _Pragma("unroll") for (int n = 0; n < 2; ++n) _Pragma("unroll") for (int k = 0; k < 2; ++k) dst[n][k] = *(const LAS bf16x8*)(lds + PG8_SB(b, h) + boff + n * 2048 + k * 1024); } while (0)
#define PG8_MMA(ai, bj, At, Bt) do { __builtin_amdgcn_s_setprio(1); _Pragma("unroll") for (int m = 0; m < 4; ++m) _Pragma("unroll") for (int n = 0; n < 2; ++n) _Pragma("unroll") for (int k = 0; k < 2; ++k) \
        acc[ai][bj][m][n] = __builtin_amdgcn_mfma_f32_16x16x32_bf16(Bt[n][k], At[m][k], acc[ai][bj][m][n], 0, 0, 0); __builtin_amdgcn_s_setprio(0); } while (0)
#define PG8_WAIT_V(n) asm volatile("s_waitcnt vmcnt(" #n ")" ::: "memory")
#define PG8_WAIT_L(n) asm volatile("s_waitcnt lgkmcnt(" #n ")" ::: "memory")
#define PG8_BAR __builtin_amdgcn_s_barrier()
#define PG8_SCHED __builtin_amdgcn_sched_barrier(0)
    Unit cur, nxt; int ui = 0;
    if (!S.next(0, cur)) return;
    f32x4 acc[2][2][4][2];
#pragma unroll
    for (int a = 0; a < 2; ++a)
#pragma unroll
        for (int b = 0; b < 2; ++b)
#pragma unroll
            for (int m = 0; m < 4; ++m)
#pragma unroll
                for (int n = 0; n < 2; ++n) acc[a][b][m][n] = (f32x4){0.f, 0.f, 0.f, 0.f};
    bf16x8 At[4][2], B0[2][2], B1[2][2];
    const char* cA = (const char*)g.A + (size_t)cur.pm * tstepA; const char* cB = (const char*)g.Bt + (size_t)cur.pn * tstepB;
    S.a_ready(cur);
    if constexpr (SP2) {
        PG8_STAGE(PG8_SB(0, 0), cB, voffB); PG8_STAGE(PG8_SB(0, 1), cB + hstepB, voffB); PG8_STAGE(PG8_SA(0, 0), cA, voffA); PG8_STAGE(PG8_SA(0, 1), cA + hstepA, voffA);
        if (wr == 1) PG8_BAR;
        PG8_WAIT_V(2); PG8_BAR;
        PG8_STAGE(PG8_SB(1, 0), cB + kstep, voffB); PG8_STAGE(PG8_SA(1, 0), cA + kstep, voffA); PG8_STAGE(PG8_SB(1, 1), cB + hstepB + kstep, voffB);
        PG8_WAIT_V(6); PG8_BAR;
    } else {
        PG8_STAGE(PG8_SB(0, 0), cB, voffB); PG8_STAGE(PG8_SA(0, 0), cA, voffA); PG8_STAGE(PG8_SB(0, 1), cB + hstepB, voffB); PG8_STAGE(PG8_SA(0, 1), cA + hstepA, voffA);
        if (wr == 1) PG8_BAR;
        PG8_WAIT_V(4); PG8_BAR;
        PG8_STAGE(PG8_SB(1, 0), cB + kstep, voffB); PG8_STAGE(PG8_SA(1, 0), cA + kstep, voffA); PG8_STAGE(PG8_SB(1, 1), cB + hstepB + kstep, voffB);
        PG8_WAIT_V(6); PG8_BAR;
    }
    for (;;) {
        const bool has_next = S.next(ui + 1, nxt);
        const char* nA = has_next ? (const char*)g.A + (size_t)nxt.pm * tstepA : cA; const char* nB = has_next ? (const char*)g.Bt + (size_t)nxt.pn * tstepB : cB;
        for (int t = 0; t < nt; t += 2) {
            const bool last = (t == nt - 2);
            const char* a1 = cA + (size_t)(t + 1) * kstep;
            const char* a2 = last ? nA : cA + (size_t)(t + 2) * kstep; const char* b2 = last ? nB : cB + (size_t)(t + 2) * kstep;
            const char* a3 = a2 + kstep; const char* b3 = b2 + kstep;
            if (last && has_next) S.a_ready(nxt);
            if constexpr (SP2) {
            PG8_LDB(B0, 0, 0); PG8_LDB(B1, 0, 1); PG8_SCHED; PG8_LDA(At, 0, 0); PG8_STAGE(PG8_SA(1, 1), a1 + hstepA, voffA);
            PG8_WAIT_V(8); PG8_WAIT_L(0); PG8_BAR; PG8_MMA(0, 0, At, B0); PG8_MMA(0, 1, At, B1); PG8_BAR; PG8_SCHED;
            PG8_LDA(At, 0, 1); PG8_STAGE(PG8_SB(0, 0), b2, voffB); PG8_STAGE(PG8_SB(0, 1), b2 + hstepB, voffB); PG8_STAGE(PG8_SA(0, 0), a2, voffA);
            PG8_WAIT_V(8); PG8_WAIT_L(0); PG8_BAR; PG8_MMA(1, 0, At, B0); PG8_MMA(1, 1, At, B1); PG8_BAR; PG8_SCHED;
            PG8_LDB(B0, 1, 0); PG8_LDB(B1, 1, 1); PG8_SCHED; PG8_LDA(At, 1, 0); PG8_STAGE(PG8_SA(0, 1), a2 + hstepA, voffA);
            PG8_WAIT_V(8); PG8_WAIT_L(0); PG8_BAR; PG8_MMA(0, 0, At, B0); PG8_MMA(0, 1, At, B1); PG8_BAR; PG8_SCHED;
            PG8_LDA(At, 1, 1); PG8_STAGE(PG8_SB(1, 0), b3, voffB); PG8_STAGE(PG8_SB(1, 1), b3 + hstepB, voffB); PG8_STAGE(PG8_SA(1, 0), a3, voffA);
            PG8_WAIT_V(8); PG8_WAIT_L(0); PG8_BAR; PG8_MMA(1, 0, At, B0); PG8_MMA(1, 1, At, B1); PG8_BAR; PG8_SCHED;
            } else {
            PG8_LDB(B0, 0, 0); PG8_SCHED; PG8_LDA(At, 0, 0); PG8_STAGE(PG8_SA(1, 1), a1 + hstepA, voffA);
            PG8_WAIT_L(8); PG8_BAR; PG8_WAIT_L(0); PG8_MMA(0, 0, At, B0); PG8_BAR; PG8_SCHED;
            PG8_LDB(B1, 0, 1); PG8_STAGE(PG8_SB(0, 0), b2, voffB);
            PG8_BAR; PG8_WAIT_L(0); PG8_MMA(0, 1, At, B1); PG8_BAR;
            PG8_LDA(At, 0, 1); PG8_STAGE(PG8_SA(0, 0), a2, voffA);
            PG8_BAR; PG8_WAIT_L(0); PG8_MMA(1, 0, At, B0); PG8_BAR; PG8_SCHED;
            PG8_STAGE(PG8_SB(0, 1), b2 + hstepB, voffB);
            PG8_WAIT_V(6); PG8_BAR; PG8_MMA(1, 1, At, B1); PG8_BAR;
            PG8_LDB(B0, 1, 0); PG8_SCHED; PG8_LDA(At, 1, 0); PG8_STAGE(PG8_SA(0, 1), a2 + hstepA, voffA);
            PG8_WAIT_L(8); PG8_BAR; PG8_WAIT_L(0); PG8_MMA(0, 0, At, B0); PG8_BAR; PG8_SCHED;
            PG8_LDB(B1, 1, 1); PG8_STAGE(PG8_SB(1, 0), b3, voffB);
            PG8_BAR; PG8_WAIT_L(0); PG8_MMA(0, 1, At, B1); PG8_BAR;
            PG8_LDA(At, 1, 1); PG8_STAGE(PG8_SA(1, 0), a3, voffA);
            PG8_BAR; PG8_WAIT_L(0); PG8_MMA(1, 0, At, B0); PG8_BAR; PG8_SCHED;
            PG8_STAGE(PG8_SB(1, 1), b3 + hstepB, voffB);
            PG8_WAIT_V(6); PG8_BAR; PG8_MMA(1, 1, At, B1); PG8_BAR;
            }
        }
        if constexpr (ALIGN_EPI) { if (wr == 0) PG8_BAR; }
        E(acc, cur, wr, wc, fr, fq); S.done(cur);
        if (!has_next) break;
#pragma unroll
        for (int a = 0; a < 2; ++a)
#pragma unroll
            for (int b = 0; b < 2; ++b)
#pragma unroll
                for (int m = 0; m < 4; ++m)
#pragma unroll
                    for (int n = 0; n < 2; ++n) acc[a][b][m][n] = (f32x4){0.f, 0.f, 0.f, 0.f};
        cur = nxt; cA = nA; cB = nB; ++ui;
        if constexpr (ALIGN_EPI) { if (wr == 1) PG8_BAR; }
    }
    PG8_WAIT_V(0);
    if constexpr (!ALIGN_EPI) { if (wr == 0) PG8_BAR; }
    PG8_BAR;
#undef PG8_SA
#undef PG8_SB
#undef PG8_STAGE
#undef PG8_LDA
#undef PG8_LDB
#undef PG8_MMA
#undef PG8_WAIT_V
#undef PG8_WAIT_L
#undef PG8_BAR
#undef PG8_SCHED
}
}

#define XB_TMO      128
#define XB_XCNT(j)  (256  + 64 * (j))
#define XB_XSUB(j)  (1280 + 64 * (j))
#define XB_XGEN(j)  (2304 + 64 * (j))
#define XB_TOP      3328
#define XB_TOPGEN   3392
#define XCD_BAR_WORDS 3456
#define XB_SPIN_CAP (1u << 18)
__device__ __forceinline__ unsigned xb_ld(unsigned* p)              { return __hip_atomic_load(p, __ATOMIC_RELAXED, __HIP_MEMORY_SCOPE_AGENT); }
__device__ __forceinline__ unsigned xb_add(unsigned* p, unsigned v) { return __hip_atomic_fetch_add(p, v, __ATOMIC_RELAXED, __HIP_MEMORY_SCOPE_AGENT); }
__device__ __forceinline__ unsigned xb_xcc_id() { return (unsigned)__builtin_amdgcn_s_getreg((3 << 11) | 20) & 0xFu; }
#define XB_SPIN(cond, bar) do { unsigned _sp = 0; while (cond) { __builtin_amdgcn_s_sleep(1); \
    if ((++_sp & 255u) == 0u) { if (xb_ld(&(bar)[XB_TMO])) break; if (_sp > XB_SPIN_CAP) { atomicAdd(&(bar)[XB_TMO], 1u); break; } } } } while (0)
struct XcdBarrier { unsigned* bar; unsigned x; volatile LAS unsigned* st; int wv; };
__device__ __forceinline__ bool xb_thread0(int wv) { return wv == 0 && lane_fresh() == 0; }
__device__ __forceinline__ XcdBarrier xcd_barrier_post(unsigned* bar, volatile LAS unsigned* st, int wv) {
    XcdBarrier b; b.bar = bar; b.x = xb_xcc_id(); b.st = st; b.wv = wv;
    if (xb_thread0(wv)) (void)xb_add(&bar[XB_XCNT(b.x)], 1u);
    return b;
}
__device__ __forceinline__ void xcd_barrier_complete(unsigned* bar, unsigned x, unsigned& nloc, unsigned& nx) {
    const unsigned G = gridDim.x * gridDim.y * gridDim.z;
    unsigned sum, cnt, mine, sp = 0u;
    for (;;) {
        sum = 0u; cnt = 0u;
#pragma unroll
        for (unsigned j = 0; j < 16; ++j) { const unsigned c = xb_ld(&bar[XB_XCNT(j)]); sum += c; cnt += (c > 0u) ? 1u : 0u; }
        mine = xb_ld(&bar[XB_XCNT(x)]);
        if (sum == G) break;
        __builtin_amdgcn_s_sleep(1);
        if ((++sp & 255u) == 0u) { if (xb_ld(&bar[XB_TMO])) break; if (sp > XB_SPIN_CAP) { atomicAdd(&bar[XB_TMO], 1u); break; } }
    }
    nloc = mine > 0u ? mine : 1u; nx = cnt > 0u ? cnt : 1u;
}
__device__ __forceinline__ void xcd_barrier(const XcdBarrier& b) {
    asm volatile("s_waitcnt vmcnt(0)" ::: "memory");
    __syncthreads();
    if (xb_thread0(b.wv)) {
        unsigned* bar = b.bar; asm volatile("" : "+s"(bar));
        __builtin_amdgcn_s_waitcnt(0);
        unsigned nloc = b.st[0], nx = b.st[1];
        if (nloc == 0u) { xcd_barrier_complete(bar, b.x, nloc, nx); b.st[0] = nloc; b.st[1] = nx; }
        const unsigned old = xb_add(&bar[XB_XSUB(b.x)], 1u);
        const unsigned gen = old / nloc;
        if (old + 1u == (gen + 1u) * nloc) {
            __builtin_amdgcn_fence(__ATOMIC_RELEASE, "agent");
            asm volatile("s_waitcnt vmcnt(0)" ::: "memory");
            const unsigned og = xb_add(&bar[XB_TOP], 1u);
            const unsigned tg = og / nx;
            if (og + 1u == (tg + 1u) * nx) xb_add(&bar[XB_TOPGEN], 1u);
            else XB_SPIN(xb_ld(&bar[XB_TOPGEN]) == tg, bar);
            __builtin_amdgcn_fence(__ATOMIC_ACQUIRE, "agent");
            xb_add(&bar[XB_XGEN(b.x)], 1u);
            asm volatile("s_waitcnt vmcnt(0)" ::: "memory");
        } else {
            XB_SPIN(xb_ld(&bar[XB_XGEN(b.x)]) == gen, bar);
            __builtin_amdgcn_fence(__ATOMIC_ACQUIRE, "agent");
            asm volatile("s_waitcnt vmcnt(0)" ::: "memory");
        }
    }
    __syncthreads();
}

namespace att {
constexpr int KVBLK = 64, QBLK = 32, QB = 256;
constexpr int SHM_V = 16384, SHM_K = 16384, SHM_KR = 8192;
constexpr int V_OFF = 0, K_OFF = 2 * SHM_V, KR_OFF = K_OFF + 2 * SHM_K, WS_OFF = KR_OFF + 2 * SHM_KR, FLG_OFF = WS_OFF + 8 * 256, QR_OFF = FLG_OFF + 64 + 384, ATT_LDS = QR_OFF + 8 * 4096;
constexpr float SB_DONE = 0.f;
constexpr float THR2 = 11.5f;
#define KSWZ(row, colB) ((row) * 256 + ((colB) ^ ((((row) & 7) | ((((row) >> 4) & 1) << 3)) << 4)))
#define KRSWZ(row, colB) ((row) * 128 + ((colB) ^ ((((row) >> 1) & 7) << 4)))
__device__ __forceinline__ int v_st(int k, int c) { const int kk = (k & ~0xC) | ((k & 4) << 1) | ((k & 8) >> 1); return ((kk >> 3) * 4 + (c >> 5)) * 512 + ((kk & 7) * 32 + (c & 31)) * 2; }
__device__ __forceinline__ int v_rd_base(int lane) { return ((lane & 3) << 3) | (((lane >> 2) & 3) << 6) | (((lane >> 4) & 1) << 5) | (((lane >> 5) & 1) << 8); }
constexpr int v_rd_off(int d0, int ks, int half) { return d0 * 512 + ks * 4096 + half * 2048; }
__device__ __forceinline__ int crow(int r, int hi) { return (r & 3) + 8 * (r >> 2) + 4 * hi; }
__device__ __forceinline__ float xhalf(float v, int hi) {
    auto rr = __builtin_amdgcn_permlane32_swap(__float_as_uint(v), __float_as_uint(v), false, false);
    return __uint_as_float(hi ? rr[0] : rr[1]);
}
__device__ __forceinline__ void mask_tile(f32x16& p0, f32x16& p1, int dq, unsigned W) {
    const float NEG = -__builtin_inff();
#pragma unroll
    for (int r = 0; r < 16; ++r) {
        const int c = (r & 3) + 8 * (r >> 2);
        if ((unsigned)(dq - c) >= W) p0[r] = NEG;
        if ((unsigned)(dq - c - 32) >= W) p1[r] = NEG;
    }
}
#define PK4(P, B_, OUT) do { unsigned a0 = cvtpk(P[B_+0], P[B_+1]), a1 = cvtpk(P[B_+2], P[B_+3]);                          \
        unsigned b0 = cvtpk(P[B_+4], P[B_+5]), b1 = cvtpk(P[B_+6], P[B_+7]);                                             \
        auto r0 = __builtin_amdgcn_permlane32_swap(a0, b0, false, false); auto r1 = __builtin_amdgcn_permlane32_swap(a1, b1, false, false); \
        u32x4 w = {r0[0], r1[0], r0[1], r1[1]}; OUT = __builtin_bit_cast(bf16x8, w); } while (0)
__device__ __forceinline__ void softmax_tile(f32x16& p0, f32x16& p1, float& m_reg, float& l_reg, float& alpha) {
    float pmax = p0[0];
#pragma unroll
    for (int r = 1; r < 16; ++r) pmax = fmaxf(pmax, p0[r]);
#pragma unroll
    for (int r = 0; r < 16; ++r) pmax = fmaxf(pmax, p1[r]);
    { auto rr = __builtin_amdgcn_permlane32_swap(__float_as_uint(pmax), __float_as_uint(pmax), false, false);
      pmax = fmaxf(__uint_as_float(rr[0]), __uint_as_float(rr[1])); }
    float mn;
    if (__all((pmax - m_reg) <= THR2)) { mn = m_reg; alpha = 1.f; }
    else { mn = fmaxf(m_reg, pmax); alpha = __builtin_amdgcn_exp2f(m_reg - mn); m_reg = mn; }
#pragma unroll
    for (int r = 0; r < 16; ++r) p0[r] = __builtin_amdgcn_exp2f(p0[r] - mn);
#pragma unroll
    for (int r = 0; r < 16; ++r) p1[r] = __builtin_amdgcn_exp2f(p1[r] - mn);
    float ps = 0.f;
#pragma unroll
    for (int r = 0; r < 16; ++r) ps += p0[r];
#pragma unroll
    for (int r = 0; r < 16; ++r) ps += p1[r];
    { auto rr = __builtin_amdgcn_permlane32_swap(__float_as_uint(ps), __float_as_uint(ps), false, false);
      ps = __uint_as_float(rr[0]) + __uint_as_float(rr[1]); }
    l_reg = l_reg * alpha + ps;
}
__device__ __forceinline__ void sb_half(f32x16& p, float rin, float& rout, int hi) {
#pragma unroll
    for (int r = 0; r < 16; ++r) p[r] = __builtin_amdgcn_rcpf(1.f + __builtin_amdgcn_exp2f(p[r]));
    float s[4], q[4], R[4];
#pragma unroll
    for (int g = 0; g < 4; ++g) s[g] = (p[4 * g] * p[4 * g + 1]) * (p[4 * g + 2] * p[4 * g + 3]);
#pragma unroll
    for (int g = 0; g < 4; ++g) q[g] = xhalf(s[g], hi);
    R[3] = rin; R[2] = R[3] * (s[3] * q[3]); R[1] = R[2] * (s[2] * q[2]); R[0] = R[1] * (s[1] * q[1]);
    rout = R[0] * (s[0] * q[0]);
#pragma unroll
    for (int g = 0; g < 4; ++g) {
        float run = hi ? R[g] : R[g] * q[g];
#pragma unroll
        for (int i = 3; i >= 0; --i) { const float ui = p[4 * g + i]; p[4 * g + i] = (1.f - ui) * run; run *= ui; }
    }
}
__device__ __forceinline__ void sb_tile(f32x16& p0, f32x16& p1, float& carry, int hi) {
    float mid, nc;
    sb_half(p1, carry, mid, hi);
    sb_half(p0, mid, nc, hi);
    carry = nc;
}
template <bool MLA>
__device__ __forceinline__ void qkt(f32x16& p0, f32x16& p1, LAS unsigned char* lds, int KB, int r32, int hi, const bf16x8* qr, const bf16x8* qrr, bool a0, bool a1) {
    constexpr int NF = MLA ? 12 : 8, D = 8;
    const float NEG = -__builtin_inff();
    unsigned kb[4];
#pragma unroll
    for (int dd = 0; dd < 4; ++dd) kb[dd] = (unsigned)(K_OFF + KB * SHM_K + KSWZ(r32, (dd * 16 + hi * 8) * 2));
    const unsigned krb = (unsigned)(KR_OFF + KB * SHM_KR);
#define KADDR(i) ((i) < 8 ? (kb[(i) & 3] ^ ((unsigned)(((i) & 7) >> 2) << 7)) : krb + (unsigned)KRSWZ(r32, ((((i) < 8 ? 8 : (i)) - 8) * 16 + hi * 8) * 2))
#define KHOFF(i) ((i) < 8 ? 32u * 256u : 32u * 128u)
#define QFRAG(i) ((i) < 8 ? qr[(i) < 8 ? (i) : 0] : qrr[(i) < 8 ? 0 : (i) - 8])
    bf16x8 F[D];
    if (a0 && a1) {
#pragma unroll
        for (int s_ = 0; s_ < D; ++s_) F[s_] = *(const LAS bf16x8*)(lds + KADDR(s_ % NF) + (s_ / NF) * KHOFF(s_ % NF));
        SBAR();
#pragma unroll
        for (int r = 0; r < 16; ++r) { p0[r] = 0.f; p1[r] = 0.f; }
        __builtin_amdgcn_s_setprio(1);
#pragma unroll
        for (int s_ = 0; s_ < 2 * NF; ++s_) { const int i = s_ % NF;
            if (s_ < NF) p0 = __builtin_amdgcn_mfma_f32_32x32x16_bf16(F[s_ % D], QFRAG(i), p0, 0, 0, 0);
            else p1 = __builtin_amdgcn_mfma_f32_32x32x16_bf16(F[s_ % D], QFRAG(i), p1, 0, 0, 0);
            if (s_ + D < 2 * NF) F[s_ % D] = *(const LAS bf16x8*)(lds + KADDR((s_ + D) % NF) + ((s_ + D) / NF) * KHOFF((s_ + D) % NF));
            SBAR(); }
    } else if (a0) {
#pragma unroll
        for (int s_ = 0; s_ < D; ++s_) F[s_] = *(const LAS bf16x8*)(lds + KADDR(s_));
        SBAR();
#pragma unroll
        for (int r = 0; r < 16; ++r) { p0[r] = 0.f; p1[r] = NEG; }
        __builtin_amdgcn_s_setprio(1);
#pragma unroll
        for (int s_ = 0; s_ < NF; ++s_) { p0 = __builtin_amdgcn_mfma_f32_32x32x16_bf16(F[s_ % D], QFRAG(s_), p0, 0, 0, 0);
            if (s_ + D < NF) F[s_ % D] = *(const LAS bf16x8*)(lds + KADDR(s_ + D));
            SBAR(); }
    } else {
#pragma unroll
        for (int s_ = 0; s_ < D; ++s_) F[s_] = *(const LAS bf16x8*)(lds + KADDR(s_) + KHOFF(s_));
        SBAR();
#pragma unroll
        for (int r = 0; r < 16; ++r) { p1[r] = 0.f; p0[r] = NEG; }
        __builtin_amdgcn_s_setprio(1);
#pragma unroll
        for (int s_ = 0; s_ < NF; ++s_) { p1 = __builtin_amdgcn_mfma_f32_32x32x16_bf16(F[s_ % D], QFRAG(s_), p1, 0, 0, 0);
            if (s_ + D < NF) F[s_ % D] = *(const LAS bf16x8*)(lds + KADDR(s_ + D) + KHOFF(s_ + D));
            SBAR(); }
    }
    __builtin_amdgcn_s_setprio(0);
#undef KADDR
#undef KHOFF
#undef QFRAG
}
__device__ __forceinline__ void pv_tile(f32x16* o, unsigned vb0, const f32x16& p0, const f32x16& p1, bool a0, bool a1) {
#define TRRD(dst, off) asm volatile("ds_read_b64_tr_b16 %0, %1 offset:%2" : "=&v"(dst) : "v"(vb0), "i"(off) : "memory")
#define PV_RD(ks, S) do { constexpr int b_ = V_OFF + v_rd_off(0, ks, 0); \
        TRRD(S##l0, b_); TRRD(S##h0, b_ + 2048); TRRD(S##l1, b_ + 512); TRRD(S##h1, b_ + 512 + 2048); TRRD(S##l2, b_ + 1024); TRRD(S##h2, b_ + 1024 + 2048); TRRD(S##l3, b_ + 1536); TRRD(S##h3, b_ + 1536 + 2048); } while (0)
#define PV_MM(S, P, B_) do { bf16x8 pa; PK4(P, B_, pa); __builtin_amdgcn_s_setprio(1); \
        o[0] = __builtin_amdgcn_mfma_f32_32x32x16_bf16(pa, (bf16x8){S##l0[0], S##l0[1], S##l0[2], S##l0[3], S##h0[0], S##h0[1], S##h0[2], S##h0[3]}, o[0], 0, 0, 0);   \
        o[1] = __builtin_amdgcn_mfma_f32_32x32x16_bf16(pa, (bf16x8){S##l1[0], S##l1[1], S##l1[2], S##l1[3], S##h1[0], S##h1[1], S##h1[2], S##h1[3]}, o[1], 0, 0, 0);   \
        o[2] = __builtin_amdgcn_mfma_f32_32x32x16_bf16(pa, (bf16x8){S##l2[0], S##l2[1], S##l2[2], S##l2[3], S##h2[0], S##h2[1], S##h2[2], S##h2[3]}, o[2], 0, 0, 0);   \
        o[3] = __builtin_amdgcn_mfma_f32_32x32x16_bf16(pa, (bf16x8){S##l3[0], S##l3[1], S##l3[2], S##l3[3], S##h3[0], S##h3[1], S##h3[2], S##h3[3]}, o[3], 0, 0, 0); __builtin_amdgcn_s_setprio(0); } while (0)
    s16x4 Al0, Al1, Al2, Al3, Ah0, Ah1, Ah2, Ah3, Bl0, Bl1, Bl2, Bl3, Bh0, Bh1, Bh2, Bh3;
    if (a0) {
        PV_RD(0, A); PV_RD(1, B);
        asm volatile("s_waitcnt lgkmcnt(8)" ::: "memory"); SBAR(); PV_MM(A, p0, 0); SBAR();
        asm volatile("s_waitcnt lgkmcnt(0)" ::: "memory"); SBAR(); PV_MM(B, p0, 8); SBAR();
    }
    if (a1) {
        PV_RD(2, A); PV_RD(3, B);
        asm volatile("s_waitcnt lgkmcnt(8)" ::: "memory"); SBAR(); PV_MM(A, p1, 0); SBAR();
        asm volatile("s_waitcnt lgkmcnt(0)" ::: "memory"); SBAR(); PV_MM(B, p1, 8);
    }
#undef PV_MM
#undef PV_RD
#undef TRRD
}

struct Blk {
    const bf16_t* Q;
    const bf16_t* K;
    const bf16_t* V;
    bf16_t* O;
    const bf16_t* G;
    float* LSE;
    int P0;
    int dil;
    const float* ssq;
    const float* qw;
    const float* cs; const float* sn;
};
template <int MODE>
__device__ __forceinline__ void attn_block(const Blk& b, LAS unsigned char* lds, int wv) {
    constexpr bool MLA = MODE == 0, DIL = MODE == 1, SB = MODE == 2;
    constexpr int NQR = 8;
    const int qs = MLA ? UQ_N : (DIL ? b.dil * EVEN_LD : EVEN_LD), ks = MLA ? 192 : qs, vs = MLA ? 128 : qs;
    const int os = DIL ? b.dil * 2048 : DM, gs = MLA ? ODD_INP : EVEN_LD, ls = DIL ? b.dil * 16 : 0;
    const int tid = opaque_tid(wv), wid = __builtin_amdgcn_readfirstlane(tid >> 6), lane = tid & 63, r32 = lane & 31, hi = lane >> 5;
    int j_lo = 0; const int j_hi = b.P0 / KVBLK + 4;
    if (DIL) j_lo = b.P0 >= 256 ? b.P0 / KVBLK - 2 : 0;
    int NT = j_hi - j_lo;
    const int qlo = b.P0 + wid * QBLK, qm = qlo + r32 - 4 * hi;
    LAS float* wsf = (LAS float*)(lds + WS_OFF) + wid * 64; LAS float* li_l = wsf; LAS float* al_l = wsf + 32;
    const unsigned vb0 = (unsigned)(size_t)(lds + V_OFF) + (unsigned)v_rd_base(lane);
    unsigned kdo[2], vdo[2], krdo = 0u;
#pragma unroll
    for (int i = 0; i < 2; ++i) { const int row = 4 * (2 * wid + i) + (lane >> 4);
        kdo[i] = (unsigned)row * (unsigned)(ks * 2) + ((((unsigned)lane & 15u) << 4) ^ ((unsigned)((row & 7) | (((row >> 4) & 1) << 3)) << 4));
        const int key = (((lane >> 2) & 3) | (((lane >> 4) & 1) << 3)) + (((wid & 1) << 2) | ((wid >> 1) << 4));
        vdo[i] = (unsigned)key * (unsigned)(vs * 2) + (unsigned)(((2 * i + (lane >> 5)) * 32 + (lane & 3) * 8) * 2); }
    if constexpr (MLA) { const int row = 8 * wid + (lane >> 3); krdo = (unsigned)row * (unsigned)(ks * 2) + 256u + ((((unsigned)lane & 7u) << 4) ^ ((unsigned)((row >> 1) & 7) << 4)); }
#define TILE_J(t) (SB ? (j_hi - 1 - (t)) : (j_lo + (t)))
#define TDMA(j, bf) do { const char* kt_ = (const char*)b.K + (size_t)(j) * KVBLK * ks * 2; const char* vt_ = (const char*)b.V + (size_t)(j) * KVBLK * vs * 2; \
        _Pragma("unroll") for (int i_ = 0; i_ < 2; ++i_) __builtin_amdgcn_global_load_lds((const unsigned*)(kt_ + kdo[i_]), (LAS unsigned*)(lds + K_OFF + (bf) * SHM_K + (2 * wid + i_) * 1024), 16, 0, 0); \
        _Pragma("unroll") for (int i_ = 0; i_ < 2; ++i_) __builtin_amdgcn_global_load_lds((const unsigned*)(vt_ + vdo[i_]), (LAS unsigned*)(lds + V_OFF + (bf) * SHM_V + (2 * wid + i_) * 1024), 16, 0, 0); \
        if constexpr (MLA) __builtin_amdgcn_global_load_lds((const unsigned*)(kt_ + krdo), (LAS unsigned*)(lds + KR_OFF + (bf) * SHM_KR + wid * 1024), 16, 0, 0); } while (0)
    TDMA(TILE_J(0), 0);
    bf16x8 qr[NQR]; bf16x8 qrr[4];
    if constexpr (!MLA) { const bf16_t* qp = b.Q + (size_t)(wid * QBLK + r32) * qs + hi * 8;
#pragma unroll
      for (int d0 = 0; d0 < NQR; ++d0) qr[d0] = *(const bf16x8*)(qp + d0 * 16); }
    else {
      const int row = wid * QBLK + r32;
      const bf16_t* qp = b.Q + (size_t)row * qs + hi * 8;
      u32x4 raw[12];
#pragma unroll
      for (int d0 = 0; d0 < 12; ++d0) raw[d0] = *(const u32x4*)(qp + d0 * 16);
      f32x4 wq[16], w1r[2][2], w2r[2][2], csr[2][2], snr[2][2];
#pragma unroll
      for (int d0 = 0; d0 < 8; ++d0) { wq[2 * d0] = *(const f32x4*)(b.qw + d0 * 16 + hi * 8); wq[2 * d0 + 1] = *(const f32x4*)(b.qw + d0 * 16 + hi * 8 + 4); }
#pragma unroll
      for (int d1 = 0; d1 < 2; ++d1)
#pragma unroll
          for (int h4 = 0; h4 < 2; ++h4) { const int i0 = d1 * 16 + hi * 8 + 4 * h4;
              w1r[d1][h4] = *(const f32x4*)(b.qw + 128 + i0); w2r[d1][h4] = *(const f32x4*)(b.qw + 160 + i0);
              csr[d1][h4] = *(const f32x4*)(b.cs + row * 32 + i0); snr[d1][h4] = *(const f32x4*)(b.sn + row * 32 + i0); }
      const float rq = __builtin_amdgcn_rsqf(b.ssq[row] * (1.0f / QLORA) + EPS);
      float ss = 0.f;
#pragma unroll
      for (int d0 = 0; d0 < 12; ++d0) { float x[8]; unpack8(raw[d0], x);
#pragma unroll
          for (int e = 0; e < 8; ++e) ss += x[e] * x[e]; }
      ss += xhalf(ss, hi);
      const float sc = rq * __builtin_amdgcn_rsqf(rq * rq * ss * (1.0f / 192.0f) + EPS) * QS192;
#pragma unroll
      for (int d0 = 0; d0 < 8; ++d0) { float x[8]; unpack8(raw[d0], x); const f32x4 wa = wq[2 * d0], wb = wq[2 * d0 + 1];
#pragma unroll
          for (int e = 0; e < 4; ++e) { x[e] *= sc * wa[e]; x[4 + e] *= sc * wb[e]; }
          qr[d0] = __builtin_bit_cast(bf16x8, pack8u(x)); }
#pragma unroll
      for (int d1 = 0; d1 < 2; ++d1) { float x1[8], x2[8], o1[8], o2[8]; unpack8(raw[8 + d1], x1); unpack8(raw[10 + d1], x2);
          const int i0 = d1 * 16 + hi * 8;
#pragma unroll
          for (int e = 0; e < 8; ++e) { const float y1 = x1[e] * sc * w1r[d1][e >> 2][e & 3], y2 = x2[e] * sc * w2r[d1][e >> 2][e & 3]; const float c = csr[d1][e >> 2][e & 3], s = snr[d1][e >> 2][e & 3];
              o1[e] = y1 * c - y2 * s; o2[e] = y2 * c + y1 * s; }
          qrr[d1] = __builtin_bit_cast(bf16x8, pack8u(o1)); qrr[d1 + 2] = __builtin_bit_cast(bf16x8, pack8u(o2)); }
    }
    f32x16 o[4];
#pragma unroll
    for (int d = 0; d < 4; ++d)
#pragma unroll
        for (int r = 0; r < 16; ++r) o[d][r] = 0.f;
    float m_reg = -1e30f, l_reg = 0.f, carry = SB ? 1.f : 0.f;
#define TILE_FLAGS(t, act_, needm_, kb_) const int kb_ = TILE_J(t) * KVBLK; bool act_, needm_, a0_, a1_; \
        if (MLA) { a0_ = kb_ <= qlo + QBLK - 1; a1_ = kb_ + 32 <= qlo + QBLK - 1; needm_ = kb_ + KVBLK - 1 > qlo; } \
        else if (DIL) { a0_ = (kb_ <= qlo + QBLK - 1) && (kb_ + 31 >= qlo - 128); a1_ = (kb_ + 32 <= qlo + QBLK - 1) && (kb_ + KVBLK - 1 >= qlo - 128); \
                        needm_ = (kb_ + KVBLK - 1 > qlo) || (kb_ <= qlo + QBLK - 1 - 129); } \
        else { a0_ = kb_ <= qlo + QBLK - 2; a1_ = kb_ + 32 <= qlo + QBLK - 2; needm_ = kb_ + KVBLK - 1 > qlo - 1; } \
        act_ = a0_ || a1_;
    LAS unsigned* flg = (LAS unsigned*)(lds + FLG_OFF);
    constexpr bool NOPP = true;
    const bool h0 = NOPP ? true : (wid < 4);
#define SBDONE(td) ({ bool r_ = false; if constexpr (SB) { const u32x4 f0_ = *(const LAS u32x4*)(flg + ((td) & 1) * 8), f1_ = *(const LAS u32x4*)(flg + ((td) & 1) * 8 + 4); \
            r_ = (f0_.x & f0_.y & f0_.z & f0_.w & f1_.x & f1_.y & f1_.z & f1_.w) != 0u; } r_; })
    VM_WAIT();
    __syncthreads();
    bool stopped = false;
    for (int t = 0; t < NT; ++t) {
        if (SB && (NOPP || !h0) && t >= 1) { if (SBDONE(t - 1)) break; }
        if (t + 1 < NT) TDMA(TILE_J(t + 1), (t + 1) & 1);
        TILE_FLAGS(t, act_, needm_, kb_)
        f32x16 p0, p1;
        if (act_) qkt<MLA>(p0, p1, lds, t & 1, r32, hi, qr, qrr, a0_, a1_);
        if constexpr (!NOPP) __syncthreads();
        if (SB && !NOPP && h0 && t >= 1) { if (SBDONE(t - 1)) { stopped = true; break; } }
        if (act_) {
            if (needm_) { if (SB) mask_tile(p0, p1, qm - kb_ - 1, 0x7fffffffu); else mask_tile(p0, p1, qm - kb_, DIL ? 129u : 0x7fffffffu); }
            if constexpr (SB) { sb_tile(p0, p1, carry, hi); }
            else { float alpha_; softmax_tile(p0, p1, m_reg, l_reg, alpha_);
                if (__any(alpha_ < 1.f)) { if (hi == 0) al_l[r32] = alpha_; LDS_WAIT();
#pragma unroll
                    for (int d_ = 0; d_ < 4; ++d_)
#pragma unroll
                        for (int r = 0; r < 16; ++r) o[d_][r] *= al_l[crow(r, hi)]; } }
            pv_tile(o, vb0 + (unsigned)((t & 1) * SHM_V), p0, p1, a0_, a1_); }
        if constexpr (SB) { const bool dn_ = __all(carry <= SB_DONE); if (lane == 0) flg[(t & 1) * 8 + wid] = dn_ ? 1u : 0u; }
        VM_WAIT();
        __syncthreads();
    }
    if (!NOPP && h0 && !stopped) __syncthreads();
#undef SBDONE
#undef TILE_FLAGS
#undef TDMA
#undef TILE_J
    u32x4 gpre[8];
    if (b.G) {
#pragma unroll
        for (int i = 0; i < 8; ++i) { const int id = lane + 64 * i, row = id >> 4, c = id & 15; gpre[i] = *(const u32x4*)(b.G + (size_t)(wid * QBLK + row) * gs + c * 8); } }
    if constexpr (!SB) {
        if (hi == 0) li_l[r32] = l_reg;
        LDS_WAIT();
        if constexpr (DIL) { if (hi == 0) b.LSE[(size_t)(wid * QBLK + r32) * ls] = m_reg + __builtin_amdgcn_logf(l_reg); }
#pragma unroll
        for (int r = 0; r < 16; ++r) { const float rl = __builtin_amdgcn_rcpf(li_l[crow(r, hi)]);
#pragma unroll
            for (int d = 0; d < 4; ++d) o[d][r] *= rl; }
    }
    LAS unsigned char* ost = lds + wid * 8192;
#pragma unroll
    for (int r = 0; r < 16; ++r) { const int orow = crow(r, hi);
#pragma unroll
        for (int d = 0; d < 4; d += 2) {
            const float x = o[d][r], y = o[d + 1][r]; const bool odd = (r32 & 1) != 0;
            const float got = dpp_xor1(odd ? x : y);
            const unsigned w = odd ? cvtpk(got, y) : cvtpk(x, got);
            *(LAS unsigned*)(ost + orow * 256 + ((odd ? d + 1 : d) * 32 + (r32 & ~1)) * 2) = w; } }
    LDS_WAIT();
#pragma unroll
    for (int i = 0; i < 8; ++i) { const int id = lane + 64 * i, row = id >> 4, c = id & 15;
        u32x4 w = *(const LAS u32x4*)(ost + row * 256 + c * 16);
        if (b.G) { const u32x4 g = gpre[i]; float x[8], y[8]; unpack8(w, x); unpack8(g, y);
#pragma unroll
            for (int e = 0; e < 8; ++e) x[e] *= y[e];
            w = pack8u(x); }
        *(u32x4*)(b.O + (size_t)(wid * QBLK + row) * os + c * 8) = w; }
    __syncthreads();
}
__device__ __forceinline__ void attn_dil_wave(const Blk& b, LAS unsigned char* lds, LAS unsigned char* scratch, int wv) {
    const int qs = b.dil * EVEN_LD, os = b.dil * 2048, ls = b.dil * 16;
    const int tid = opaque_tid(wv), wid = __builtin_amdgcn_readfirstlane(tid >> 6), lane = tid & 63, r32 = lane & 31, hi = lane >> 5;
    const int qlo = b.P0, qm = qlo + r32 - 4 * hi;
    const int hlast = qlo >> 5, hfirst = qlo >= 128 ? hlast - 4 : 0, n = hlast - hfirst + 1;
    LAS unsigned char* kbuf = lds + wid * 16384; LAS unsigned char* vbuf = kbuf + 8192;
    LAS float* li_l = (LAS float*)(scratch + wid * 256); LAS float* al_l = li_l + 32;
    bf16x8 qr[8];
    { const bf16_t* qp = b.Q + (size_t)r32 * qs + hi * 8;
#pragma unroll
      for (int d0 = 0; d0 < 8; ++d0) qr[d0] = *(const bf16x8*)(qp + d0 * 16); }
    const unsigned rs2 = (unsigned)qs * 2u;
    const unsigned kl = (unsigned)(lane >> 4) * rs2 + ((((unsigned)lane & 15u) ^ ((unsigned)lane >> 4)) << 4);
    const unsigned vl = (unsigned)(((lane >> 2) & 3) | (((lane >> 4) & 1) << 3)) * rs2 + (unsigned)(((lane >> 5) * 32 + (lane & 3) * 8) * 2);
#define KDMA(hh) do { const char* kb_ = (const char*)b.K + (size_t)(hh) * 32 * rs2; _Pragma("unroll") for (int c_ = 0; c_ < 8; ++c_) \
        __builtin_amdgcn_global_load_lds((const unsigned*)(kb_ + (size_t)(4 * c_) * rs2 + (kl ^ (unsigned)(((c_ & 1) << 6) | ((c_ >> 2) << 7)))), (LAS unsigned*)(kbuf + c_ * 1024), 16, 0, 0); } while (0)
#define VDMA(hh) do { const char* vb_ = (const char*)b.V + (size_t)(hh) * 32 * rs2; _Pragma("unroll") for (int c_ = 0; c_ < 8; ++c_) \
        __builtin_amdgcn_global_load_lds((const unsigned*)(vb_ + (size_t)((((c_ >> 1) & 1) << 2) | ((c_ >> 2) << 4)) * rs2 + (c_ & 1) * 128 + vl), (LAS unsigned*)(vbuf + c_ * 1024), 16, 0, 0); } while (0)
    KDMA(hfirst); VDMA(hfirst);
    f32x16 o[4];
#pragma unroll
    for (int d = 0; d < 4; ++d)
#pragma unroll
        for (int r = 0; r < 16; ++r) o[d][r] = 0.f;
    float m_reg = -1e30f, l_reg = 0.f;
    const unsigned vb0 = (unsigned)(size_t)vbuf + (unsigned)v_rd_base(lane);
    unsigned kb[4];
#pragma unroll
    for (int dd = 0; dd < 4; ++dd) kb[dd] = (unsigned)(wid * 16384 + KSWZ(r32, (dd * 16 + hi * 8) * 2));
    const float NEG = -__builtin_inff();
    for (int i = 0; i < n; ++i) { const int hh = hfirst + i; const bool more = i + 1 < n;
        asm volatile("s_waitcnt vmcnt(8)" ::: "memory");
        f32x16 p;
#pragma unroll
        for (int r = 0; r < 16; ++r) p[r] = 0.f;
        { bf16x8 F[8];
#pragma unroll
          for (int d0 = 0; d0 < 8; ++d0) F[d0] = *(const LAS bf16x8*)(lds + (kb[d0 & 3] ^ ((unsigned)(d0 >> 2) << 7)));
          SBAR();
          __builtin_amdgcn_s_setprio(1);
#pragma unroll
          for (int d0 = 0; d0 < 8; ++d0) p = __builtin_amdgcn_mfma_f32_32x32x16_bf16(F[d0], qr[d0], p, 0, 0, 0);
          __builtin_amdgcn_s_setprio(0); }
        LDS_WAIT(); asm volatile("" ::: "memory");
        if (more) KDMA(hh + 1);
        if (hh == hlast || hh * 32 < qlo + 31 - 128) { const int dq = qm - hh * 32;
#pragma unroll
            for (int r = 0; r < 16; ++r) { const int c = (r & 3) + 8 * (r >> 2); if ((unsigned)(dq - c) >= 129u) p[r] = NEG; } }
        { float pmax = p[0];
#pragma unroll
          for (int r = 1; r < 16; ++r) pmax = fmaxf(pmax, p[r]);
          { auto rr = __builtin_amdgcn_permlane32_swap(__float_as_uint(pmax), __float_as_uint(pmax), false, false); pmax = fmaxf(__uint_as_float(rr[0]), __uint_as_float(rr[1])); }
          float mn, alpha;
          if (__all((pmax - m_reg) <= THR2)) { mn = m_reg; alpha = 1.f; }
          else { mn = fmaxf(m_reg, pmax); alpha = __builtin_amdgcn_exp2f(m_reg - mn); m_reg = mn; }
#pragma unroll
          for (int r = 0; r < 16; ++r) p[r] = __builtin_amdgcn_exp2f(p[r] - mn);
          float ps = 0.f;
#pragma unroll
          for (int r = 0; r < 16; ++r) ps += p[r];
          { auto rr = __builtin_amdgcn_permlane32_swap(__float_as_uint(ps), __float_as_uint(ps), false, false); ps = __uint_as_float(rr[0]) + __uint_as_float(rr[1]); }
          l_reg = l_reg * alpha + ps;
          if (__any(alpha < 1.f)) { if (hi == 0) al_l[r32] = alpha; LDS_WAIT();
#pragma unroll
              for (int d_ = 0; d_ < 4; ++d_)
#pragma unroll
                  for (int r = 0; r < 16; ++r) o[d_][r] *= al_l[crow(r, hi)];
              LDS_WAIT(); } }
        if (more) asm volatile("s_waitcnt vmcnt(8)" ::: "memory"); else asm volatile("s_waitcnt vmcnt(0)" ::: "memory");
        pv_tile(o, vb0, p, p, true, false);
        LDS_WAIT(); asm volatile("" ::: "memory");
        if (more) VDMA(hh + 1);
    }
#undef KDMA
#undef VDMA
    if (hi == 0) li_l[r32] = l_reg;
    LDS_WAIT();
    if (hi == 0) b.LSE[(size_t)r32 * ls] = m_reg + __builtin_amdgcn_logf(l_reg);
#pragma unroll
    for (int r = 0; r < 16; ++r) { const float rl = __builtin_amdgcn_rcpf(li_l[crow(r, hi)]);
#pragma unroll
        for (int d = 0; d < 4; ++d) o[d][r] *= rl; }
    LAS unsigned char* ost = kbuf;
#pragma unroll
    for (int r = 0; r < 16; ++r) { const int orow = crow(r, hi);
#pragma unroll
        for (int d = 0; d < 4; d += 2) {
            const float x = o[d][r], y = o[d + 1][r]; const bool odd = (r32 & 1) != 0;
            const float got = dpp_xor1(odd ? x : y);
            const unsigned w = odd ? cvtpk(got, y) : cvtpk(x, got);
            *(LAS unsigned*)(ost + orow * 256 + ((odd ? d + 1 : d) * 32 + (r32 & ~1)) * 2) = w; } }
    LDS_WAIT();
#pragma unroll 2
    for (int i = 0; i < 8; ++i) { const int id = lane + 64 * i, row = id >> 4, c = id & 15;
        const u32x4 w = *(const LAS u32x4*)(ost + row * 256 + c * 16);
        *(u32x4*)(b.O + (size_t)row * os + c * 8) = w; }
    LDS_WAIT(); asm volatile("" ::: "memory");
}
}

struct Args { const void* in[18]; float* out; unsigned char* ws; int ph_lo, ph_hi; };
typedef const __attribute__((address_space(4))) Args CArgs;
__device__ __forceinline__ CArgs* kargs() { CArgs* p = (CArgs*)__builtin_amdgcn_kernarg_segment_ptr(); asm volatile("" : "+s"(p)); return p; }
enum { IN_X = 0, IN_C, IN_POS, IN_ADAW, IN_ADAB, IN_NORMW, IN_EVWIN, IN_EVQN, IN_EVKN, IN_EVWOUT, IN_ODWIN, IN_ODQLN, IN_ODKVLN, IN_ODWUQ, IN_ODWUKV, IN_ODQN, IN_ODKN, IN_ODWOUT };

struct Frame {
    LAS unsigned char* lds;
    int tid, lane, wave, vcu, G, wv;
    unsigned char* ws;
    __device__ __forceinline__ void refresh() { tid = opaque_tid(wv); lane = tid & 63; wave = __builtin_amdgcn_readfirstlane(tid >> 6); }
};

__device__ __forceinline__ void transpose_item(const float* W, int N, const float* kscale, bf16_t* Bt, int ldb, int k0, int n0, int brow0, LAS unsigned char* scr, int lane, int dl_perm = -1) {
    const int kq = lane >> 4, nq = lane & 15;
    f32x4 v[16];
#pragma unroll
    for (int i = 0; i < 16; ++i) { const int k = 8 * (i >> 1) + 2 * kq + (i & 1); v[i] = __builtin_nontemporal_load((const f32x4*)(W + (size_t)(k0 + k) * N + n0 + 4 * nq)); }
#pragma unroll
    for (int i = 0; i < 8; ++i) { const int k = 8 * i + 2 * kq; f32x4 a = v[2 * i], c = v[2 * i + 1];
        if (kscale) { const float s0 = kscale[k0 + k], s1 = kscale[k0 + k + 1]; a = a * s0; c = c * s1; }
#pragma unroll
        for (int j = 0; j < 4; ++j) *(LAS unsigned*)(scr + (4 * nq + j) * 144 + k * 2) = cvtpk(a[j], c[j]); }
    LDS_WAIT(); asm volatile("" ::: "memory");
#pragma unroll
    for (int jj = 0; jj < 8; ++jj) { const int n = (lane >> 3) + 8 * jj, c = lane & 7;
        const u32x4 w = *(const LAS u32x4*)(scr + n * 144 + c * 16);
        const int drow = dl_perm < 0 ? brow0 + n : (dl_perm == 2 ? brow0 + 8 * ((n & 31) >> 2) + (n & 3) + 4 * (n >> 5) : brow0 + 8 * (n >> 2) + (n & 3) + 4 * dl_perm);
        *(u32x4*)(Bt + (size_t)drow * ldb + k0 + 8 * c) = w; }
    LDS_WAIT(); asm volatile("" ::: "memory");
}

__device__ __forceinline__ void phase_prologue(Frame& F, CArgs& a) {
    F.refresh();
    const float* cvec = (const float*)a.in[IN_C];
    const float* adaw = (const float*)a.in[IN_ADAW]; const float* adab = (const float*)a.in[IN_ADAB];
    LAS float* sl = (LAS float*)F.lds;
    LAS float* red = (LAS float*)(F.lds + 32768);
    for (int i = F.tid; i < 2 * DM; i += NTHR) sl[i] = silu_f(cvec[i]);
    __syncthreads();
    float* MOD = (float*)(F.ws + WS_MOD);
    for (int item = F.vcu; item < DEPTH * 192; item += F.G) {
        const int l = item / 192, ct = item % 192, cq = F.tid & 15, ir = F.tid >> 4;
        const float* wp = adaw + ((size_t)l * DM + ir) * 12288 + ct * 64 + cq * 4;
        f32x4 a0 = {0.f, 0.f, 0.f, 0.f}, a1 = {0.f, 0.f, 0.f, 0.f};
#pragma unroll 8
        for (int k = 0; k < 128; ++k) { const f32x4 w = __builtin_nontemporal_load((const f32x4*)(wp + (size_t)(32 * k) * 12288)); const float s0 = sl[ir + 32 * k], s1 = sl[DM + ir + 32 * k]; a0 += w * s0; a1 += w * s1; }
#pragma unroll
        for (int j = 0; j < 4; ++j) { red[(ir * 64 + cq * 4 + j) * 2 + 0] = a0[j]; red[(ir * 64 + cq * 4 + j) * 2 + 1] = a1[j]; }
        __syncthreads();
        if (F.tid < 128) { const int col = F.tid & 63, bb = F.tid >> 6; float s = 0.f;
#pragma unroll 8
            for (int r = 0; r < 32; ++r) s += red[(r * 64 + col) * 2 + bb];
            MOD[(size_t)(l * 2 + bb) * 12288 + ct * 64 + col] = s + adab[l * 12288 + ct * 64 + col]; }
        __syncthreads();
    }
    LAS unsigned char* scr = F.lds + F.wave * 9216;
    const int gw = F.vcu * NWAVES + F.wave, NGW = F.G * NWAVES;
    constexpr int I_EVIN = (DM / 64) * (EVEN_IN / 64), I_EVOUT = (DM / 64) * (DM / 64), I_ODIN = (DM / 64) * (ODD_IN / 64), I_UQ = (QLORA / 64) * (UQ_N / 64), I_UKV = (KVLORA / 64) * (UKV_N / 64), I_ODOUT = I_EVOUT;
    constexpr int I_PER = I_EVIN + I_EVOUT + I_ODIN + I_UQ + I_UKV + I_ODOUT;
    for (int it = gw; it < 2 * I_PER; it += NGW) {
        const int i = it / I_PER; int r = it % I_PER;
        if (r < I_EVIN) { const int nb = EVEN_IN / 64, kb = r / nb, nn = r % nb;
            const int n0 = nn * 64; const bool dl = n0 >= EC_QDL && n0 < EC_VDL;
            transpose_item((const float*)a.in[IN_EVWIN] + (size_t)i * DM * EVEN_IN, EVEN_IN, nullptr, (bf16_t*)(F.ws + WS_WEVIN) + (size_t)i * EVEN_IN * DM, DM, kb * 64, n0, dl ? (n0 & ~127) : n0, scr, F.lane, dl ? ((n0 >> 6) & 1) : -1); continue; } r -= I_EVIN;
        if (r < I_EVOUT) { const int nb = DM / 64, kb = r / nb, nn = r % nb;
            transpose_item((const float*)a.in[IN_EVWOUT] + (size_t)i * DM * DM, DM, nullptr, (bf16_t*)(F.ws + WS_WEVOUT) + (size_t)i * DM * DM, DM, kb * 64, nn * 64, nn * 64, scr, F.lane); continue; } r -= I_EVOUT;
        if (r < I_ODIN) { const int nb = ODD_IN / 64, kb = r / nb, nn = r % nb; const int n0 = nn * 64;
            const int brow = n0 < 1536 ? n0 : (n0 < 1600 ? OC_KPE + (n0 - 1536) : n0 - 64);
            transpose_item((const float*)a.in[IN_ODWIN] + (size_t)i * DM * ODD_IN, ODD_IN, nullptr, (bf16_t*)(F.ws + WS_WODIN) + (size_t)i * ODD_INP * DM, DM, kb * 64, n0, brow, scr, F.lane, n0 == 1536 ? 2 : -1); continue; } r -= I_ODIN;
        if (r < I_UQ) { const int nb = UQ_N / 64, kb = r / nb, nn = r % nb;
            transpose_item((const float*)a.in[IN_ODWUQ] + (size_t)i * QLORA * UQ_N, UQ_N, (const float*)a.in[IN_ODQLN] + i * QLORA, (bf16_t*)(F.ws + WS_WUQ) + (size_t)i * UQ_N * QLORA, QLORA, kb * 64, nn * 64, nn * 64, scr, F.lane); continue; } r -= I_UQ;
        if (r < I_UKV) { const int nb = UKV_N / 64, kb = r / nb, nn = r % nb;
            transpose_item((const float*)a.in[IN_ODWUKV] + (size_t)i * KVLORA * UKV_N, UKV_N, (const float*)a.in[IN_ODKVLN] + i * KVLORA, (bf16_t*)(F.ws + WS_WUKV) + (size_t)i * UKV_N * KVLORA, KVLORA, kb * 64, nn * 64, nn * 64, scr, F.lane); continue; } r -= I_UKV;
        { const int nb = DM / 64, kb = r / nb, nn = r % nb;
            transpose_item((const float*)a.in[IN_ODWOUT] + (size_t)i * DM * DM, DM, nullptr, (bf16_t*)(F.ws + WS_WODOUT) + (size_t)i * DM * DM, DM, kb * 64, nn * 64, nn * 64, scr, F.lane); }
    }
    const size_t gt = (size_t)F.vcu * NTHR + F.tid, NGT = (size_t)F.G * NTHR;
    for (size_t i = gt; i < (size_t)2 * 192 * DM / 8; i += NGT) { const size_t li = i / (192 * DM / 8), rem = i % (192 * DM / 8);
        *(u32x4*)((bf16_t*)(F.ws + WS_WODIN) + li * (size_t)ODD_INP * DM + (size_t)ODD_IN * DM + rem * 8) = (u32x4){0u, 0u, 0u, 0u}; }
    const int* pos = (const int*)a.in[IN_POS];
    for (size_t i = gt; i < (size_t)MTOK * 96; i += NGT) { const int tok = (int)(i / 96), j = (int)(i % 96);
        const float p = (float)pos[tok];
        if (j < 64) { const float inv = (float)pow(10000.0, -(double)j / 64.0); const float ang = p * inv;
            ((float*)(F.ws + WS_COSF))[tok * 64 + j] = (float)cos((double)ang); ((float*)(F.ws + WS_SINF))[tok * 64 + j] = (float)sin((double)ang); }
        else { const int jj = j - 64; const float inv = (float)pow(10000.0, -(double)jj / 32.0); const float ang = p * inv;
            ((float*)(F.ws + WS_COSM))[tok * 32 + jj] = (float)cos((double)ang); ((float*)(F.ws + WS_SINM))[tok * 32 + jj] = (float)sin((double)ang); } }
}

__device__ __forceinline__ void phase_h(Frame& F, CArgs& a, int layer, const float* xsrc) {
    F.refresh();
    const float* MOD = (const float*)(F.ws + WS_MOD); const float* nw = (const float*)a.in[IN_NORMW] + layer * DM;
    bf16_t* H = (bf16_t*)(F.ws + WS_H);
    LAS float* Acol = (LAS float*)F.lds; LAS float* Scol = Acol + DM;
    int cur_b = -1;
    for (int rb = F.vcu; rb < MTOK / 32; rb += F.G) {
        const int bb = rb / (SEQ / 32);
        if (bb != cur_b) { __syncthreads();
            const float* mp = MOD + (size_t)(layer * 2 + bb) * 12288;
            for (int i = F.tid; i < DM; i += NTHR) { Acol[i] = nw[i] * (1.0f + mp[DM + i]); Scol[i] = mp[i]; }
            __syncthreads(); cur_b = bb; }
#pragma unroll 1
        for (int rr = 0; rr < 4; ++rr) { const int row = rb * 32 + F.wave * 4 + rr;
            if (xsrc) {
            const f32x4* xr = (const f32x4*)(xsrc + (size_t)row * DM) + F.lane;
            f32x4 v[16]; float s = 0.f;
#pragma unroll
            for (int j = 0; j < 16; ++j) { v[j] = __builtin_nontemporal_load(xr + 64 * j); s += (v[j][0] * v[j][0] + v[j][1] * v[j][1]) + (v[j][2] * v[j][2] + v[j][3] * v[j][3]); }
            const float rinv = __builtin_amdgcn_rsqf(wave_sum(s) * (1.0f / DM) + EPS);
            u32x2* o8 = (u32x2*)(H + (size_t)row * DM) + F.lane;
#pragma unroll
            for (int j = 0; j < 16; ++j) { const int c = 4 * F.lane + 256 * j; const f32x4 A = *(const LAS f32x4*)(Acol + c), Sh = *(const LAS f32x4*)(Scol + c);
                const f32x4 h = v[j] * rinv * A + Sh; u32x2 w; w.x = cvtpk(h[0], h[1]); w.y = cvtpk(h[2], h[3]); o8[64 * j] = w; }
            } else {
            const u32x4* xr = (const u32x4*)((const unsigned short*)(F.ws + WS_XH) + (size_t)row * DM) + F.lane;
            u32x4 r[8]; float s = 0.f;
#pragma unroll
            for (int j = 0; j < 8; ++j) r[j] = __builtin_nontemporal_load(xr + 64 * j);
#pragma unroll
            for (int j = 0; j < 8; ++j) { const float a0 = h_lo(r[j].x), a1 = h_hi(r[j].x), a2 = h_lo(r[j].y), a3 = h_hi(r[j].y), a4 = h_lo(r[j].z), a5 = h_hi(r[j].z), a6 = h_lo(r[j].w), a7 = h_hi(r[j].w);
                s += ((a0 * a0 + a1 * a1) + (a2 * a2 + a3 * a3)) + ((a4 * a4 + a5 * a5) + (a6 * a6 + a7 * a7)); }
            const float rinv = __builtin_amdgcn_rsqf(wave_sum(s) * (1.0f / DM) + EPS);
            u32x4* o16 = (u32x4*)(H + (size_t)row * DM) + F.lane;
#pragma unroll
            for (int j = 0; j < 8; ++j) { const int c = 8 * F.lane + 512 * j;
                const f32x4 A0 = *(const LAS f32x4*)(Acol + c), A1 = *(const LAS f32x4*)(Acol + c + 4), S0 = *(const LAS f32x4*)(Scol + c), S1 = *(const LAS f32x4*)(Scol + c + 4);
                const f32x4 x0 = {h_lo(r[j].x), h_hi(r[j].x), h_lo(r[j].y), h_hi(r[j].y)}, x1 = {h_lo(r[j].z), h_hi(r[j].z), h_lo(r[j].w), h_hi(r[j].w)};
                const f32x4 h0 = x0 * rinv * A0 + S0, h1 = x1 * rinv * A1 + S1; u32x4 w; w.x = cvtpk(h0[0], h0[1]); w.y = cvtpk(h0[2], h0[3]); w.z = cvtpk(h1[0], h1[1]); w.w = cvtpk(h1[2], h1[3]); o16[64 * j] = w; }
            }
        }
    }
    __syncthreads();
}

__device__ __forceinline__ void phase_attn_even(Frame& F) {
    asm volatile("" : "+s"(F.ws), "+s"(F.vcu));
    bf16_t* P = (bf16_t*)(F.ws + WS_PROJ); bf16_t* MX = (bf16_t*)(F.ws + WS_MIXED); bf16_t* ODL = (bf16_t*)(F.ws + WS_ODL); float* LSE = (float*)(F.ws + WS_LSE);
    for (int it = F.vcu; it < 256; it += F.G) { const int bh = it >> 3, x = it & 7, bb = bh >> 4, h = bh & 15;
        for (int pass = 0; pass < 2; ++pass) { const int qb = pass ? x : 15 - x;
            att::Blk k; const size_t t0 = (size_t)bb * SEQ + (size_t)qb * 256;
            k.Q = P + t0 * EVEN_LD + EC_QSB + h * 128;
            k.K = P + (size_t)bb * SEQ * EVEN_LD + EC_KSB + h * 128;
            k.V = P + (size_t)bb * SEQ * EVEN_LD + EC_VSB + h * 128;
            k.O = MX + t0 * DM + h * 128;
            k.G = P + t0 * EVEN_LD + EC_GSB + h * 128;
            k.LSE = nullptr; k.P0 = qb * 256; k.dil = 1; k.ssq = nullptr; k.qw = nullptr; k.cs = nullptr; k.sn = nullptr;
            att::attn_block<2>(k, F.lds, F.wv); } }
    for (int it = F.vcu; it < 256; it += F.G) { const int bh = it >> 3, kr = it & 7, bb = bh >> 4, h = bh & 15;
#pragma unroll 1
        for (int i = 0; i < 6; ++i) { const int sg = F.wv + 8 * i, pat = sg >> 4, j = sg & 15;
            const int dil = pat == 0 ? 1 : (pat == 1 ? 4 : 16); const int r = pat == 0 ? 0 : (pat == 1 ? (j >> 2) : j);
            const int P0 = pat == 0 ? 512 * kr + 32 * j : (pat == 1 ? 128 * kr + 32 * (j & 3) : 32 * kr);
            att::Blk k; const size_t tb = (size_t)bb * SEQ + r, t0 = tb + (size_t)P0 * dil;
            k.Q = P + t0 * EVEN_LD + EC_QDL + h * 128;
            k.K = P + tb * EVEN_LD + EC_KDL + h * 128;
            k.V = P + tb * EVEN_LD + EC_VDL + h * 128;
            k.O = ODL + (size_t)pat * MTOK * 2048 + t0 * 2048 + h * 128;
            k.G = nullptr;
            k.LSE = LSE + (size_t)pat * MTOK * 16 + t0 * 16 + h;  k.P0 = P0; k.dil = dil; k.ssq = nullptr; k.qw = nullptr; k.cs = nullptr; k.sn = nullptr;
            att::attn_dil_wave(k, F.lds, F.lds + XCH_OFF, F.wv); }
        asm volatile("s_waitcnt vmcnt(0)" ::: "memory");
        __syncthreads();
        F.refresh();
        const size_t tokb = (size_t)bb * SEQ + (size_t)kr * 512;
#pragma unroll 1
        for (int u0 = 0; u0 < 16; u0 += 2) {
            u32x4 r0[2], r1[2], r2[2], rg[2]; float l0[2], l1[2], l2[2]; size_t oo[2];
#pragma unroll
            for (int u = 0; u < 2; ++u) { const int idx = F.tid + NTHR * (u0 + u), c = idx & 15; const size_t tok = tokb + (idx >> 4);
                l0[u] = LSE[tok * 16 + h]; l1[u] = LSE[(size_t)MTOK * 16 + tok * 16 + h]; l2[u] = LSE[(size_t)2 * MTOK * 16 + tok * 16 + h];
                r0[u] = *(const u32x4*)(ODL + tok * 2048 + h * 128 + c * 8);
                r1[u] = *(const u32x4*)(ODL + (size_t)MTOK * 2048 + tok * 2048 + h * 128 + c * 8);
                r2[u] = *(const u32x4*)(ODL + (size_t)2 * MTOK * 2048 + tok * 2048 + h * 128 + c * 8);
                rg[u] = __builtin_nontemporal_load((const u32x4*)(P + tok * EVEN_LD + EC_GDL + h * 128 + c * 8));
                oo[u] = tok * DM + 2048 + h * 128 + c * 8; }
#pragma unroll
            for (int u = 0; u < 2; ++u) {
                const float mx = fmaxf(l0[u], fmaxf(l1[u], l2[u]));
                float w0 = __builtin_amdgcn_exp2f(l0[u] - mx), w1 = __builtin_amdgcn_exp2f(l1[u] - mx), w2 = __builtin_amdgcn_exp2f(l2[u] - mx);
                const float inv = 1.0f / (w0 + w1 + w2); w0 *= inv; w1 *= inv; w2 *= inv;
                float x0[8], x1[8], x2[8], g[8], o[8];
                unpack8(r0[u], x0); unpack8(r1[u], x1); unpack8(r2[u], x2); unpack8(rg[u], g);
#pragma unroll
                for (int e = 0; e < 8; ++e) o[e] = (w0 * x0[e] + w1 * x1[e] + w2 * x2[e]) * g[e];
                *(u32x4*)(MX + oo[u]) = pack8u(o);
            }
        }
        __syncthreads();
    }
}
__device__ __forceinline__ void phase_attn_mla(Frame& F, CArgs& a, int lp) {
    asm volatile("" : "+s"(F.ws), "+s"(F.vcu));
    const bf16_t* QR = (const bf16_t*)(F.ws + WS_QRAW); const bf16_t* KF = (const bf16_t*)(F.ws + WS_KF); const bf16_t* VF = (const bf16_t*)(F.ws + WS_VF);
    const bf16_t* P2 = (const bf16_t*)(F.ws + WS_PROJ); bf16_t* MX = (bf16_t*)(F.ws + WS_MIXED);
    const float* ssq = (const float*)(F.ws + WS_CTL + CTL_SSQCQ) + (size_t)lp * MTOK;
    for (int it = F.vcu; it < 512; it += F.G) { const int bh = it >> 3, x = it & 7, bb = bh >> 5, h = bh & 31;
        for (int pass = 0; pass < 2; ++pass) { const int qb = pass ? x : 15 - x;
            att::Blk k; const size_t t0 = (size_t)bb * SEQ + (size_t)qb * 256;
            k.Q = QR + t0 * UQ_N + h * 192;
            k.K = KF + (size_t)bh * SEQ * 192;
            k.V = VF + (size_t)bh * SEQ * 128;
            k.O = MX + t0 * DM + h * 128;
            k.G = P2 + t0 * ODD_INP + OC_G + h * 128;
            k.LSE = nullptr; k.P0 = qb * 256; k.dil = 1;
            k.ssq = ssq + t0; k.qw = (const float*)a.in[IN_ODQN] + lp * 192; k.cs = (const float*)(F.ws + WS_COSM) + t0 * 32; k.sn = (const float*)(F.ws + WS_SINM) + t0 * 32;
            att::attn_block<0>(k, F.lds, F.wv); } }
}

__device__ __forceinline__ void gemm_even_in(Frame& F, CArgs& a, int lp) {
    pg8::Gemm g{(const bf16_t*)(F.ws + WS_H), (const bf16_t*)(F.ws + WS_WEVIN) + (size_t)lp * EVEN_IN * DM, MTOK, EVEN_IN, DM, DM, DM};
    pg8::StaticOrder S; S.init(MTOK, EVEN_IN, F.G, (int)blockIdx.x);
    pg8::EpiEvenIn E{(bf16_t*)(F.ws + WS_PROJ), (const float*)a.in[IN_EVQN] + lp * 128, (const float*)a.in[IN_EVKN] + lp * 128,
                     (const float*)(F.ws + WS_COSF), (const float*)(F.ws + WS_SINF), F.lds + XCH_OFF};
    pg8::gemm_phase<pg8::EpiEvenIn, pg8::StaticOrder>(F.lds, g, S, E, F.wv);
}
__device__ __forceinline__ void gemm_odd_in(Frame& F, CArgs& a, int lp) {
    pg8::Gemm g{(const bf16_t*)(F.ws + WS_H), (const bf16_t*)(F.ws + WS_WODIN) + (size_t)lp * ODD_INP * DM, MTOK, ODD_INP, DM, DM, DM};
    pg8::StaticOrder S; S.init(MTOK, ODD_INP, F.G, (int)blockIdx.x);
    pg8::EpiBf16Op E{(bf16_t*)(F.ws + WS_PROJ), ODD_INP, 2, (const float*)a.in[IN_ODKN] + lp * 192, (const float*)(F.ws + WS_COSM), (const float*)(F.ws + WS_SINM), (float*)(F.ws + WS_CTL + CTL_SSQCQ) + (size_t)lp * MTOK, (float*)(F.ws + WS_CTL + CTL_SSQKV) + (size_t)lp * 2 * MTOK, (float*)(F.ws + WS_CTL + CTL_SSQKV) + (size_t)lp * 2 * MTOK + 1};
    pg8::gemm_phase<pg8::EpiBf16Op, pg8::StaticOrder>(F.lds, g, S, E, F.wv);
}
__device__ __forceinline__ void gemm_odd_up(Frame& F, CArgs& a, int lp) {
    { pg8::Gemm g{(const bf16_t*)(F.ws + WS_PROJ) + OC_CQ, (const bf16_t*)(F.ws + WS_WUQ) + (size_t)lp * UQ_N * QLORA, MTOK, UQ_N, QLORA, ODD_INP, QLORA};
      pg8::StaticOrder S; S.init(MTOK, UQ_N, F.G, (int)blockIdx.x);
      pg8::EpiBf16Op E{(bf16_t*)(F.ws + WS_QRAW), UQ_N, 0, nullptr, nullptr, nullptr, nullptr, nullptr, nullptr};
      pg8::gemm_phase<pg8::EpiBf16Op, pg8::StaticOrder>(F.lds, g, S, E, F.wv); }
    { pg8::Gemm g{(const bf16_t*)(F.ws + WS_PROJ) + OC_CKV, (const bf16_t*)(F.ws + WS_WUKV) + (size_t)lp * UKV_N * KVLORA, MTOK, UKV_N, KVLORA, ODD_INP, KVLORA};
      pg8::StaticOrder S; S.init(MTOK, UKV_N, F.G, (int)blockIdx.x);
      pg8::EpiKV E{(bf16_t*)(F.ws + WS_KF), (bf16_t*)(F.ws + WS_VF), (const bf16_t*)(F.ws + WS_PROJ), (const float*)(F.ws + WS_CTL + CTL_SSQKV) + (size_t)lp * 2 * MTOK, nullptr,
                   (const float*)a.in[IN_ODKN] + lp * 192, (const float*)(F.ws + WS_COSM), (const float*)(F.ws + WS_SINM), F.lds + XCH_OFF};
      pg8::gemm_phase<pg8::EpiKV, pg8::StaticOrder>(F.lds, g, S, E, F.wv); }
}
__device__ __forceinline__ void gemm_out(Frame& F, const bf16_t* Wt, const float* xs32, float* xo32, const float* gate) {
    unsigned short* XH = (unsigned short*)(F.ws + WS_XH);
    pg8::Gemm g{(const bf16_t*)(F.ws + WS_MIXED), Wt, MTOK, DM, DM, DM, DM};
    pg8::StaticOrder S; S.init(MTOK, DM, F.G, (int)blockIdx.x);
    pg8::EpiResid E{xs32, xs32 ? nullptr : XH, xo32, xo32 ? nullptr : XH, gate};
    pg8::gemm_phase<pg8::EpiResid, pg8::StaticOrder>(F.lds, g, S, E, F.wv);
}

constexpr int N_PHASES = 25;
#ifndef REPEAT_MASK
#define REPEAT_MASK 0
#endif
#define REP(idx) ((REPEAT_MASK >> (idx)) & 1)
__global__ void __launch_bounds__(NTHR, 2) mega_fwd(Args args) {
    extern __shared__ __attribute__((aligned(16))) unsigned char lds_raw[];
    Frame F;
    F.lds = (LAS unsigned char*)lds_raw;
    F.tid = threadIdx.x; F.lane = F.tid & 63; F.wave = __builtin_amdgcn_readfirstlane(F.tid >> 6); F.wv = F.wave;
    F.G = gridDim.x; { const int bx = blockIdx.x; F.vcu = (F.G % 8 == 0) ? (bx % 8) * (F.G / 8) + bx / 8 : bx; }
    F.ws = args.ws;
    for (int u = F.tid; u < (LDS_BYTES - LDSCTL_OFF) / 4; u += NTHR) ((LAS unsigned*)(F.lds + LDSCTL_OFF))[u] = 0u;
    __syncthreads();
    const int lo = args.ph_lo, hi = args.ph_hi;
    XcdBarrier bar; bar.bar = (unsigned*)(F.ws + WS_CTL) + CW_BAR; bar.x = 0; bar.st = nullptr; bar.wv = F.wv;
    if (hi - lo > 1) bar = xcd_barrier_post((unsigned*)(F.ws + WS_CTL) + CW_BAR, (volatile LAS unsigned*)(F.lds + MISC_OFF) + 8, F.wv);
#define IN(k) (lo <= (k) && (k) < hi)
#define SEAM(k) do { if (IN(k) && IN((k) + 1)) xcd_barrier(bar); } while (0)
    const float* xin = (const float*)args.in[IN_X];
    float* xout = args.out;
    const float* MOD = (const float*)(F.ws + WS_MOD);

#define KA (*kargs())
#define RUN(k, idx, BODY) do { if (IN(k)) { BODY; if (REP(idx)) { xcd_barrier(bar); BODY; } } SEAM(k); } while (0)
    RUN(0, 0, phase_prologue(F, KA));

    for (int lp = 0; lp < 2; ++lp) {
        const int base = 1 + 12 * lp;
        { const int layer = 2 * lp; const float* xs = (layer == 0) ? xin : nullptr;
        RUN(base + 0, 1, phase_h(F, KA, layer, xs));
        RUN(base + 1, 2, gemm_even_in(F, KA, lp));
        RUN(base + 3, 4, phase_attn_even(F));
        RUN(base + 5, 6, gemm_out(F, (const bf16_t*)(F.ws + WS_WEVOUT) + (size_t)lp * DM * DM, xs, nullptr, MOD + (size_t)(layer * 2) * 12288 + 2 * DM));
        }
        { const int layer = 2 * lp + 1;
        RUN(base + 6, 7, phase_h(F, KA, layer, nullptr));
        RUN(base + 7, 8, gemm_odd_in(F, KA, lp));
        RUN(base + 8, 9, gemm_odd_up(F, KA, lp));
        RUN(base + 10, 11, phase_attn_mla(F, KA, lp));
        RUN(base + 11, 12, gemm_out(F, (const bf16_t*)(F.ws + WS_WODOUT) + (size_t)lp * DM * DM, nullptr, (lp == 1) ? xout : nullptr, MOD + (size_t)(layer * 2) * 12288 + 2 * DM));
        }
    }
#undef RUN
#undef KA
#undef IN
#undef SEAM
}

extern "C" void kernel_launch(void* const* d_in, const int* in_sizes, int n_in, void* d_out, int out_size, void* d_ws, size_t ws_size, hipStream_t stream) {
    static int grid = 0;
    if (grid == 0) {
        if (n_in != 18 || out_size != MTOK * DM || ws_size < WS_END) { fprintf(stderr, "kernel_launch: unexpected shapes (n_in %d, out %d, ws %zu); nothing launched\n", n_in, out_size, ws_size); grid = -1; return; }
        int dev = 0, cus = 0, per_cu = 0;
        if (hipGetDevice(&dev) != hipSuccess || hipDeviceGetAttribute(&cus, hipDeviceAttributeMultiprocessorCount, dev) != hipSuccess) { grid = -1; return; }
        if (hipFuncSetAttribute((const void*)mega_fwd, hipFuncAttributeMaxDynamicSharedMemorySize, LDS_BYTES) != hipSuccess) { fprintf(stderr, "kernel_launch: hipFuncSetAttribute failed\n"); grid = -1; return; }
        if (hipOccupancyMaxActiveBlocksPerMultiprocessor(&per_cu, (const void*)mega_fwd, NTHR, LDS_BYTES) != hipSuccess || per_cu < 1)
            fprintf(stderr, "kernel_launch: note: occupancy query reports %d workgroups per CU\n", per_cu);
        (void)hipGetLastError();
        grid = cus;
    }
    if (grid < 0) return;
    if (hipMemsetAsync((char*)d_ws + WS_CTL, 0, CTL_ZERO_BYTES, stream) != hipSuccess) { fprintf(stderr, "kernel_launch: memset failed\n"); return; }
    Args a{};
    for (int i = 0; i < 18; ++i) a.in[i] = d_in[i];
    a.out = (float*)d_out; a.ws = (unsigned char*)d_ws;
#if MK_N_LAUNCHES == 1
    a.ph_lo = 0; a.ph_hi = N_PHASES;
    hipLaunchKernelGGL(mega_fwd, dim3(grid), dim3(NTHR), LDS_BYTES, stream, a);
#else
    for (int k = 0; k < N_PHASES; ++k) { a.ph_lo = k; a.ph_hi = k + 1; hipLaunchKernelGGL(mega_fwd, dim3(grid), dim3(NTHR), LDS_BYTES, stream, a); }
#endif
}
```

```cpp
#include <hip/hip_runtime.h>
#include <cstdio>
#include <cstdint>

#ifndef MK_N_LAUNCHES
#define MK_N_LAUNCHES 1
#endif

#define LAS __attribute__((address_space(3)))
#define GAS __attribute__((address_space(1)))
typedef unsigned short bf16_t;
typedef short bf16x8 __attribute__((ext_vector_type(8)));
typedef short s16x4 __attribute__((ext_vector_type(4)));
typedef float f32x2 __attribute__((ext_vector_type(2)));
typedef float f32x4 __attribute__((ext_vector_type(4)));
typedef float f32x16 __attribute__((ext_vector_type(16)));
typedef unsigned u32x2 __attribute__((ext_vector_type(2)));
typedef unsigned u32x4 __attribute__((ext_vector_type(4)));
typedef __bf16 hbf16x2 __attribute__((ext_vector_type(2)));

constexpr int NB = 2, SEQ = 4096, DM = 4096, MTOK = NB * SEQ, DEPTH = 4;
constexpr int EVEN_IN = 16384, ODD_IN = 5696, ODD_INP = 5888;
constexpr int EVEN_LD = EVEN_IN + 2176;
constexpr int QLORA = 1024, KVLORA = 512, NH_MLA = 32, NH_SB = 16, NH_DL = 16;
constexpr int UQ_N = 6144, UKV_N = 8192;
constexpr float EPS = 1e-6f;
constexpr float LOG2E = 1.4426950408889634f;
constexpr float QS128 = 1.4426950408889634f * 0.08838834764831845f;
constexpr float QS192 = 1.4426950408889634f * 0.07216878364870322f;
constexpr int EC_QSB = 0, EC_KSB = 2048, EC_VSB = 4096, EC_GSB = 6144, EC_QDL = 8192, EC_KDL = 10240, EC_VDL = 12288, EC_GDL = 14336;
constexpr int OC_CQ = 0, OC_CKV = 1024, OC_G = 1536, OC_KPE = 5632;

constexpr int RING_BYTES_C = 131072;
constexpr size_t MiB = 1u << 20;
constexpr size_t WS_CTL = 0, CTL_ZERO_BYTES = 1 * MiB;
constexpr size_t WS_MOD = 1 * MiB;
constexpr size_t WS_COSF = 2 * MiB, WS_SINF = 4 * MiB;
constexpr size_t WS_COSM = 6 * MiB, WS_SINM = 7 * MiB;
constexpr size_t WS_DIAG = 8 * MiB;
constexpr size_t WS_WEVIN = 16 * MiB;
constexpr size_t WS_WEVOUT = 272 * MiB;
constexpr size_t WS_WODIN = 336 * MiB;
constexpr size_t WS_WUQ = 428 * MiB;
constexpr size_t WS_WUKV = 452 * MiB;
constexpr size_t WS_WODOUT = 468 * MiB;
constexpr size_t WS_H = 544 * MiB;
constexpr size_t WS_PROJ = 1506 * MiB;
constexpr size_t WS_MIXED = 864 * MiB;
constexpr size_t WS_ODL = 928 * MiB;
constexpr size_t WS_LSE = 1024 * MiB;
constexpr size_t WS_QRAW = 1026 * MiB;
constexpr size_t WS_KVRAW = 1122 * MiB;
constexpr size_t WS_XH = 1122 * MiB;
constexpr size_t WS_QF = 1250 * MiB;
constexpr size_t WS_KF = 1346 * MiB;
constexpr size_t WS_VF = 1442 * MiB;
constexpr size_t WS_END = 1800 * MiB;
constexpr int CW_BAR = 4096;
constexpr size_t CTL_SSQCQ = 524288, CTL_SSQKV = CTL_SSQCQ + 2 * MTOK * 4;
static_assert(CTL_SSQKV + 4 * MTOK * 4 <= CTL_ZERO_BYTES, "CTL map");
constexpr int XCH_OFF = RING_BYTES_C + 1024;

constexpr int RING_BYTES = 131072;
constexpr int LDSCTL_OFF = RING_BYTES, MISC_OFF = LDSCTL_OFF + 320;
constexpr int LDS_BYTES = 147456;
constexpr int NWAVES = 8, NTHR = 512;

__device__ __forceinline__ unsigned cvtpk(float lo, float hi) { f32x2 v = {lo, hi}; hbf16x2 b = __builtin_convertvector(v, hbf16x2); return __builtin_bit_cast(unsigned, b); }
typedef _Float16 hf16x2 __attribute__((ext_vector_type(2)));
__device__ __forceinline__ unsigned pkh(float lo, float hi) { hf16x2 h; h.x = (_Float16)lo; h.y = (_Float16)hi; return __builtin_bit_cast(unsigned, h); }
__device__ __forceinline__ float h_lo(unsigned w) { return (float)__builtin_bit_cast(hf16x2, w).x; }
__device__ __forceinline__ float h_hi(unsigned w) { return (float)__builtin_bit_cast(hf16x2, w).y; }
__device__ __forceinline__ float bf_lo(unsigned w) { return __uint_as_float(w << 16); }
__device__ __forceinline__ float bf_hi(unsigned w) { return __uint_as_float(w & 0xffff0000u); }
__device__ __forceinline__ float bf2f(bf16_t b) { return __uint_as_float(((unsigned)b) << 16); }
__device__ __forceinline__ void unpack8(u32x4 w, float (&x)[8]) { x[0] = bf_lo(w.x); x[1] = bf_hi(w.x); x[2] = bf_lo(w.y); x[3] = bf_hi(w.y); x[4] = bf_lo(w.z); x[5] = bf_hi(w.z); x[6] = bf_lo(w.w); x[7] = bf_hi(w.w); }
__device__ __forceinline__ u32x4 pack8u(const float (&x)[8]) { u32x4 w; w.x = cvtpk(x[0], x[1]); w.y = cvtpk(x[2], x[3]); w.z = cvtpk(x[4], x[5]); w.w = cvtpk(x[6], x[7]); return w; }
__device__ __forceinline__ int lane_fresh() { int l; asm volatile("v_mbcnt_lo_u32_b32 %0, -1, 0\n\tv_mbcnt_hi_u32_b32 %0, -1, %0" : "=v"(l)); return l; }
__device__ __forceinline__ float sum16(float v) { auto r = __builtin_amdgcn_permlane16_swap(__float_as_uint(v), __float_as_uint(v), false, false); return __uint_as_float(r[0]) + __uint_as_float(r[1]); }
__device__ __forceinline__ float sum32(float v) { auto r = __builtin_amdgcn_permlane32_swap(__float_as_uint(v), __float_as_uint(v), false, false); return __uint_as_float(r[0]) + __uint_as_float(r[1]); }
__device__ __forceinline__ float dpp_xor1(float v) { return __int_as_float(__builtin_amdgcn_update_dpp(0, __float_as_int(v), 0xB1  , 0xF, 0xF, true)); }
__device__ __forceinline__ float wave_sum(float v) {
    v += __int_as_float(__builtin_amdgcn_update_dpp(0, __float_as_int(v), 0xB1, 0xF, 0xF, true));
    v += __int_as_float(__builtin_amdgcn_update_dpp(0, __float_as_int(v), 0x4E, 0xF, 0xF, true));
    v += __int_as_float(__builtin_amdgcn_update_dpp(0, __float_as_int(v), 0x124, 0xF, 0xF, true));
    v += __int_as_float(__builtin_amdgcn_update_dpp(0, __float_as_int(v), 0x128, 0xF, 0xF, true));
    v = sum16(v); v = sum32(v);
    return v;
}
__device__ __forceinline__ float silu_f(float v) { return v * __builtin_amdgcn_rcpf(1.0f + __builtin_amdgcn_exp2f(-v * LOG2E)); }
__device__ __forceinline__ int opaque_tid(int wv) { int t = wv * 64 + lane_fresh(); asm volatile("" : "+v"(t)); return t; }
#define LDS_WAIT() asm volatile("s_waitcnt lgkmcnt(0)" ::: "memory")
#define VM_WAIT() asm volatile("s_waitcnt vmcnt(0)" ::: "memory")
#define SBAR() __builtin_amdgcn_sched_barrier(0)

namespace pg8 {
constexpr int BM = 256, BK = 64, HALF = 128, HTB = HALF * BK * 2, STAGE_BYTES = 8 * HTB, NXCD = 8, WGM = 8;
__host__ __device__ __forceinline__ int lds_byte(int r, int c) { const int st = (r >> 4) * 2 + (c >> 5), rr = r & 15, cc = c & 31, ob = rr * 64 + cc * 2; return st * 1024 + (ob ^ (((ob >> 9) & 1) << 5)); }
__host__ __device__ __forceinline__ void stage_rc(int b, int& R, int& C) { const int st = b / 1024, sb = b % 1024, swz = sb ^ (((sb >> 9) & 1) << 5); R = (st >> 1) * 16 + swz / 64; C = (st & 1) * 32 + (swz % 64) / 2; }
__host__ __device__ __forceinline__ int perm32(int rho) { const int n = rho >> 4, i = rho & 15; return 8 * (i >> 2) + 4 * n + (i & 3); }
struct Unit { int pm, pn; };
struct Gemm { const bf16_t* A; const bf16_t* Bt; int M, N, K, lda, ldb; };
struct StaticOrder {
    int nM, nN, nwg, G, c;
    __host__ __device__ void init(int M, int N, int G_, int c_) { nM = M / BM; nN = N / BM; nwg = nM * nN; G = G_; c = c_; }
    __host__ __device__ bool next(int i, Unit& u) const {
        const int L = i * G + c; if (L >= nwg) return false;
        int wgid = L; { const int q = nwg / NXCD, r = nwg % NXCD, xcd = wgid % NXCD, off = wgid / NXCD; wgid = (xcd < r ? xcd * (q + 1) : r * (q + 1) + (xcd - r) * q) + off; }
        const int nig = WGM * nN, gid = wgid / nig, fm = gid * WGM, gsz = (nM - fm) < WGM ? (nM - fm) : WGM;
        u.pm = fm + ((wgid % nig) % gsz); u.pn = (wgid % nig) / gsz; return true;
    }
    __device__ __forceinline__ void a_ready(const Unit&) const {}
    __device__ __forceinline__ void done(const Unit&) const {}
};
struct EpiBf16Op {
    static constexpr bool PERM = true;
    bf16_t* O; int ldc;
    int kind;
    const float* knw; const float* cosM; const float* sinM;
    float* ssq_q; float* ssq_kv; float* ssq_pe;
    __device__ __forceinline__ void operator()(const f32x4 (&acc)[2][2][4][2], const Unit& u, int wr, int wc, int fr, int fq) const {
        const int row0 = u.pm * BM + wr * 64 + fr, col0 = u.pn * BM + wc * 32 + 8 * fq;
        float sc = 1.f; bool act = false;
        if (kind == 1) { const int seg = u.pn >> 3; if (seg == 0) sc = QS128; act = (seg == 3) || (seg == 7); }
        else if (kind == 2) { act = (u.pn >= 6) && (u.pn < 22); }
#pragma unroll
        for (int ai = 0; ai < 2; ++ai)
#pragma unroll
            for (int m = 0; m < 4; ++m) { bf16_t* rowp = O + (size_t)(row0 + ai * HALF + m * 16) * ldc + col0;
#pragma unroll
                for (int bj = 0; bj < 2; ++bj) { f32x4 v0 = acc[ai][bj][m][0] * sc, v1 = acc[ai][bj][m][1] * sc;
                    if (kind == 2 && u.pn == 22 && bj == 0 && wc < 2) { const int i4 = 4 * (4 * wc + fq); const size_t row = (size_t)(row0 + ai * HALF + m * 16);
                        const f32x4 w1 = *(const f32x4*)(knw + 128 + i4), w2 = *(const f32x4*)(knw + 160 + i4);
                        const f32x4 c = *(const f32x4*)(cosM + row * 32 + i4), sn = *(const f32x4*)(sinM + row * 32 + i4);
                        const f32x4 x1 = v0 * w1, x2 = v1 * w2; v0 = x1 * c - x2 * sn; v1 = x2 * c + x1 * sn; }
                    if (act) {
#pragma unroll
                        for (int j = 0; j < 4; ++j) { v0[j] = silu_f(v0[j]); v1[j] = silu_f(v1[j]); } }
                    u32x4 w; w.x = cvtpk(v0[0], v0[1]); w.y = cvtpk(v0[2], v0[3]); w.z = cvtpk(v1[0], v1[1]); w.w = cvtpk(v1[2], v1[3]);
                    *(u32x4*)(rowp + bj * HALF) = w; }
                if (kind == 2 && u.pn < 6) { float sq = 0.f;
#pragma unroll
                    for (int bj = 0; bj < 2; ++bj)
#pragma unroll
                        for (int n = 0; n < 2; ++n) { const f32x4 x = acc[ai][bj][m][n]; sq += (x[0] * x[0] + x[1] * x[1]) + (x[2] * x[2] + x[3] * x[3]); }
                    sq = sum16(sq); sq = sum32(sq);
                    if (fq == 0) { if (u.pn < 4) atomicAdd(ssq_q + row0 + ai * HALF + m * 16, sq); else atomicAdd(ssq_kv + 2 * (row0 + ai * HALF + m * 16), sq); } }
                if (kind == 2 && u.pn == 22 && wc < 2) { float sq = 0.f;
#pragma unroll
                    for (int n = 0; n < 2; ++n) { const f32x4 x = acc[ai][0][m][n]; sq += (x[0] * x[0] + x[1] * x[1]) + (x[2] * x[2] + x[3] * x[3]); }
                    sq = sum16(sq); sq = sum32(sq);
                    if (fq == 0) atomicAdd(ssq_pe + 2 * (row0 + ai * HALF + m * 16), sq); } }
    }
};
struct EpiKV {
    static constexpr bool PERM = true;
    bf16_t* KF; bf16_t* VF;
    const bf16_t* P2;
    const float* ssqkv;
    const float* ssqpe;
    const float* knw;
    const float* cosM; const float* sinM;
    LAS unsigned char* xl;
    __device__ __forceinline__ void operator()(const f32x4 (&acc)[2][2][4][2], const Unit& u, int wr, int wc, int fr, int fq) const {
        asm volatile("" : "+v"(fr), "+v"(fq));
        const int rl0 = wr * 64 + fr, q4 = 4 * (4 * wc + fq); const bool ropel = wc < 2;
        LAS f32x2* X = (LAS f32x2*)xl;
        float sq8[8], pe8[8];
#pragma unroll
        for (int rr = 0; rr < 8; ++rr) { const size_t row = (size_t)u.pm * BM + rl0 + (rr >> 2) * HALF + (rr & 3) * 16; const f32x2 t2 = *(const f32x2*)(ssqkv + 2 * row); sq8[rr] = t2[0]; pe8[rr] = t2[1]; }
#pragma unroll
        for (int ai = 0; ai < 2; ++ai)
#pragma unroll
            for (int m = 0; m < 4; ++m) { const int rloc = rl0 + ai * HALF + m * 16;
                float pn = 0.f;
#pragma unroll
                for (int n = 0; n < 2; ++n) { const f32x4 x = acc[ai][0][m][n]; pn += (x[0] * x[0] + x[1] * x[1]) + (x[2] * x[2] + x[3] * x[3]); }
                pn = sum16(pn); pn = sum32(pn);
                if (fq == 0) X[rloc * 4 + wc] = (f32x2){pn, 0.f}; }
        asm volatile("s_waitcnt lgkmcnt(0)" ::: "memory"); __builtin_amdgcn_s_barrier(); asm volatile("" ::: "memory");
        const int bh = (u.pm >> 4) * NH_MLA + u.pn;
        const f32x4 wka = *(const f32x4*)(knw + wc * 32 + fq * 8), wkb = *(const f32x4*)(knw + wc * 32 + fq * 8 + 4);
        float rk8[8];
        u32x4 R8[8];
#pragma unroll
        for (int ai = 0; ai < 2; ++ai)
#pragma unroll
            for (int m = 0; m < 4; ++m) { const int rloc = rl0 + ai * HALF + m * 16; const size_t row = (size_t)u.pm * BM + rloc; const int srow = (int)(row & (SEQ - 1));
                const f32x4 xa = *(const LAS f32x4*)(X + rloc * 4), xb = *(const LAS f32x4*)(X + rloc * 4 + 2);
                const float ssn = (xa[0] + xa[2]) + (xb[0] + xb[2]), spe = pe8[ai * 4 + m];
                const float rkv = __builtin_amdgcn_rsqf(sq8[ai * 4 + m] * (1.0f / KVLORA) + EPS);
                const float rk = __builtin_amdgcn_rsqf((rkv * rkv * ssn + spe) * (1.0f / 192.0f) + EPS), sk = rkv * rk;
                rk8[ai * 4 + m] = rk;
                const size_t trow = (size_t)bh * SEQ + srow;
                { const f32x4 b0 = acc[ai][0][m][0] * wka * sk, b1 = acc[ai][0][m][1] * wkb * sk; u32x4 w;
                  w.x = cvtpk(b0[0], b0[1]); w.y = cvtpk(b0[2], b0[3]); w.z = cvtpk(b1[0], b1[1]); w.w = cvtpk(b1[2], b1[3]);
                  *(u32x4*)(KF + trow * 192 + wc * 32 + fq * 8) = w; }
                { const f32x4 a0 = acc[ai][1][m][0] * rkv, a1 = acc[ai][1][m][1] * rkv; u32x4 w;
                  w.x = cvtpk(a0[0], a0[1]); w.y = cvtpk(a0[2], a0[3]); w.z = cvtpk(a1[0], a1[1]); w.w = cvtpk(a1[2], a1[3]);
                  *(u32x4*)(VF + trow * 128 + wc * 32 + fq * 8) = w; }
                if (ropel) R8[ai * 4 + m] = *(const u32x4*)(P2 + row * ODD_INP + OC_KPE + wc * 32 + fq * 8); }
        asm volatile("" ::: "memory");
        if (ropel) {
#pragma unroll
            for (int rr = 0; rr < 8; ++rr) { const size_t row = (size_t)u.pm * BM + rl0 + (rr >> 2) * HALF + (rr & 3) * 16; const int srow = (int)(row & (SEQ - 1));
                const float rk = rk8[rr]; const size_t trow = (size_t)bh * SEQ + srow;
                float x[8]; unpack8(R8[rr], x);
                u32x2 o1, o2;
                o1.x = cvtpk(x[0] * rk, x[1] * rk); o1.y = cvtpk(x[2] * rk, x[3] * rk); o2.x = cvtpk(x[4] * rk, x[5] * rk); o2.y = cvtpk(x[6] * rk, x[7] * rk);
                *(u32x2*)(KF + trow * 192 + 128 + q4) = o1; *(u32x2*)(KF + trow * 192 + 160 + q4) = o2; }
        }
    }
};
struct EpiEvenIn {
    static constexpr bool PERM = true;
    bf16_t* O;
    const float* qn; const float* kn;
    const float* cosF; const float* sinF;
    LAS unsigned char* xl;
    __device__ __forceinline__ void operator()(const f32x4 (&acc)[2][2][4][2], const Unit& u, int wr, int wc, int fr, int fq) const {
        asm volatile("" : "+v"(fr), "+v"(fq));
        const int row0 = u.pm * BM + wr * 64 + fr, col0 = u.pn * BM + wc * 32 + 8 * fq;
        const int seg = u.pn >> 3;
        if (seg == 4 || seg == 5) {
            const int rl0 = wr * 64 + fr, i4 = 4 * (4 * wc + fq);
            LAS float* X = (LAS float*)xl;
#pragma unroll
            for (int ai = 0; ai < 2; ++ai)
#pragma unroll
                for (int m = 0; m < 4; ++m) { const int rloc = rl0 + ai * HALF + m * 16;
#pragma unroll
                    for (int bj = 0; bj < 2; ++bj) { const f32x4 x = acc[ai][bj][m][0], y = acc[ai][bj][m][1];
                        float s = ((x[0] * x[0] + x[1] * x[1]) + (x[2] * x[2] + x[3] * x[3])) + ((y[0] * y[0] + y[1] * y[1]) + (y[2] * y[2] + y[3] * y[3]));
                        s = sum16(s); s = sum32(s);
                        if (fq == 0) X[(rloc * 2 + bj) * 4 + wc] = s; } }
            asm volatile("s_waitcnt lgkmcnt(0)" ::: "memory"); __builtin_amdgcn_s_barrier(); asm volatile("" ::: "memory");
            const float* wv = (seg == 4) ? qn : kn; const float osc = (seg == 4) ? QS128 : 1.0f;
            const f32x4 w1 = *(const f32x4*)(wv + i4), w2 = *(const f32x4*)(wv + 64 + i4);
#pragma unroll
            for (int ai = 0; ai < 2; ++ai)
#pragma unroll
                for (int m = 0; m < 4; ++m) { const int rloc = rl0 + ai * HALF + m * 16; const size_t row = (size_t)u.pm * BM + rloc;
                    const f32x4 c = *(const f32x4*)(cosF + row * 64 + i4), sn = *(const f32x4*)(sinF + row * 64 + i4);
                    const f32x4 xs0 = *(const LAS f32x4*)(X + (rloc * 2 + 0) * 4), xs1 = *(const LAS f32x4*)(X + (rloc * 2 + 1) * 4);
#pragma unroll
                    for (int bj = 0; bj < 2; ++bj) { const f32x4 xs = bj ? xs1 : xs0;
                        const float rinv = __builtin_amdgcn_rsqf(((xs[0] + xs[1]) + (xs[2] + xs[3])) * (1.0f / 128.0f) + EPS);
                        const f32x4 y1 = acc[ai][bj][m][0] * w1 * rinv, y2 = acc[ai][bj][m][1] * w2 * rinv;
                        const f32x4 o1 = (y1 * c - y2 * sn) * osc, o2 = (y2 * c + y1 * sn) * osc;
                        u32x4 w; w.x = cvtpk(o1[0], o1[1]); w.y = cvtpk(o1[2], o1[3]); w.z = cvtpk(o2[0], o2[1]); w.w = cvtpk(o2[2], o2[3]);
                        *(u32x4*)(O + row * EVEN_LD + col0 + bj * HALF) = w; } }
            return;
        }
        const float sc = (seg == 0) ? QS128 : 1.f; const bool act = (seg == 3) || (seg == 7);
#pragma unroll
        for (int ai = 0; ai < 2; ++ai)
#pragma unroll
            for (int m = 0; m < 4; ++m) { bf16_t* rowp = O + (size_t)(row0 + ai * HALF + m * 16) * EVEN_LD + col0;
#pragma unroll
                for (int bj = 0; bj < 2; ++bj) { f32x4 v0 = acc[ai][bj][m][0] * sc, v1 = acc[ai][bj][m][1] * sc;
                    if (act) {
#pragma unroll
                        for (int j = 0; j < 4; ++j) { v0[j] = silu_f(v0[j]); v1[j] = silu_f(v1[j]); } }
                    u32x4 w; w.x = cvtpk(v0[0], v0[1]); w.y = cvtpk(v0[2], v0[3]); w.z = cvtpk(v1[0], v1[1]); w.w = cvtpk(v1[2], v1[3]);
                    *(u32x4*)(rowp + bj * HALF) = w; } }
    }
};
struct EpiResid {
    static constexpr bool PERM = true;
    const float* xin32; const unsigned short* xin16; float* xout32; unsigned short* xout16; const float* gate;
    __device__ __forceinline__ void operator()(const f32x4 (&acc)[2][2][4][2], const Unit& u, int wr, int wc, int fr, int fq) const {
        const int row0 = u.pm * BM + wr * 64 + fr, col0 = u.pn * BM + wc * 32 + 8 * fq;
        const float* gp = gate + (u.pm >= 16 ? 12288 : 0) + col0;
        f32x4 gv[2][2];
#pragma unroll
        for (int bj = 0; bj < 2; ++bj)
#pragma unroll
            for (int n = 0; n < 2; ++n) gv[bj][n] = *(const f32x4*)(gp + bj * HALF + n * 4);
        const bool in16 = xin16 != nullptr, out16 = xout16 != nullptr;
        if (in16) {
#pragma unroll
            for (int ai = 0; ai < 2; ++ai) {
                u32x4 raw[4][2];
#pragma unroll
                for (int m = 0; m < 4; ++m)
#pragma unroll
                    for (int bj = 0; bj < 2; ++bj) raw[m][bj] = *(const u32x4*)(xin16 + (size_t)(row0 + ai * HALF + m * 16) * DM + col0 + bj * HALF);
#pragma unroll
                for (int m = 0; m < 4; ++m) { const size_t off = (size_t)(row0 + ai * HALF + m * 16) * DM + col0;
#pragma unroll
                    for (int bj = 0; bj < 2; ++bj) { const u32x4 r = raw[m][bj];
                        const f32x4 x0 = {h_lo(r.x), h_hi(r.x), h_lo(r.y), h_hi(r.y)}, x1 = {h_lo(r.z), h_hi(r.z), h_lo(r.w), h_hi(r.w)};
                        const f32x4 y0 = x0 + gv[bj][0] * acc[ai][bj][m][0], y1 = x1 + gv[bj][1] * acc[ai][bj][m][1];
                        if (out16) { u32x4 w; w.x = pkh(y0[0], y0[1]); w.y = pkh(y0[2], y0[3]); w.z = pkh(y1[0], y1[1]); w.w = pkh(y1[2], y1[3]); *(u32x4*)(xout16 + off + bj * HALF) = w; }
                        else { *(f32x4*)(xout32 + off + bj * HALF) = y0; *(f32x4*)(xout32 + off + bj * HALF + 4) = y1; } } }
                asm volatile("" ::: "memory");
            }
            return;
        }
#pragma unroll
        for (int g2 = 0; g2 < 4; ++g2) { const int ai = g2 >> 1, mb = (g2 & 1) * 2;
            f32x4 xo[2][2][2];
#pragma unroll
            for (int m = 0; m < 2; ++m)
#pragma unroll
                for (int bj = 0; bj < 2; ++bj)
#pragma unroll
                    for (int n = 0; n < 2; ++n) xo[m][bj][n] = *(const f32x4*)(xin32 + (size_t)(row0 + ai * HALF + (mb + m) * 16) * DM + col0 + bj * HALF + n * 4);
#pragma unroll
            for (int m = 0; m < 2; ++m) { const size_t off = (size_t)(row0 + ai * HALF + (mb + m) * 16) * DM + col0;
#pragma unroll
                for (int bj = 0; bj < 2; ++bj) { const f32x4 y0 = xo[m][bj][0] + gv[bj][0] * acc[ai][bj][m == 0 ? mb : mb + 1][0], y1 = xo[m][bj][1] + gv[bj][1] * acc[ai][bj][m == 0 ? mb : mb + 1][1];
                    if (out16) { u32x4 w; w.x = pkh(y0[0], y0[1]); w.y = pkh(y0[2], y0[3]); w.z = pkh(y1[0], y1[1]); w.w = pkh(y1[2], y1[3]); *(u32x4*)(xout16 + off + bj * HALF) = w; }
                    else { *(f32x4*)(xout32 + off + bj * HALF) = y0; *(f32x4*)(xout32 + off + bj * HALF + 4) = y1; } } }
            asm volatile("" ::: "memory");
        }
    }
};

template <class Epi, class Sched, bool ALIGN_EPI = true, bool SP2 = true>
__device__ __forceinline__ void gemm_phase(LAS unsigned char* lds, const Gemm g, const Sched& S, const Epi& E, int wv) {
    const int tid = opaque_tid(wv), wid = __builtin_amdgcn_readfirstlane(tid >> 6), lane = tid & 63, wr = wid >> 2, wc = wid & 3, fr = lane & 15, fq = lane >> 4;
    const int K = g.K, nt = K / BK;
    unsigned voffA[2], voffB[2];
#pragma unroll
    for (int i = 0; i < 2; ++i) { int R, C; stage_rc(tid * 16 + i * 8192, R, C); const int Rb = Epi::PERM ? ((R & ~31) + perm32(R & 31)) : R;
        voffA[i] = (unsigned)(R * g.lda + C) * 2u; voffB[i] = (unsigned)(Rb * g.ldb + C) * 2u; }
    const size_t kstep = (size_t)(BK * 2);
    const size_t hstepA = (size_t)HALF * g.lda * 2, hstepB = (size_t)HALF * g.ldb * 2;
    const size_t tstepA = 2 * hstepA, tstepB = 2 * hstepB;
    const unsigned ldsw = (unsigned)wid * 1024u;
    const int aoff = lds_byte(wr * 64 + fr, fq * 8), boff = lds_byte(wc * 32 + fr, fq * 8);
#define PG8_SA(b, h) (((b) * 2 + (h)) * HTB)
#define PG8_SB(b, h) ((4 + (b) * 2 + (h)) * HTB)
#define PG8_STAGE(bufoff, gbase, voff) do { _Pragma("unroll") for (int _i = 0; _i < 2; ++_i) \
        __builtin_amdgcn_global_load_lds((const unsigned*)((const char*)(gbase) + (voff)[_i]), (LAS unsigned*)(lds + (bufoff) + ldsw + _i * 8192), 16, 0, 0); } while (0)
#define PG8_LDA(dst, b, h) do { _Pragma("unroll") for (int m = 0; m < 4; ++m) _Pragma("unroll") for (int k = 0; k < 2; ++k) dst[m][k] = *(const LAS bf16x8*)(lds + PG8_SA(b, h) + aoff + m * 2048 + k * 1024); } while (0)
#define PG8_LDB(dst, b, h) do { _Pragma("unroll") for (int n = 0; n < 2; ++n) _Pragma("unroll") for (int k = 0; k < 2; ++k) dst[n][k] = *(const LAS bf16x8*)(lds + PG8_SB(b, h) + boff + n * 2048 + k * 1024); } while (0)
#define PG8_MMA(ai, bj, At, Bt) do { __builtin_amdgcn_s_setprio(1); _Pragma("unroll") for (int m = 0; m < 4; ++m) _Pragma("unroll") for (int n = 0; n < 2; ++n) _Pragma("unroll") for (int k = 0; k < 2; ++k) \
        acc[ai][bj][m][n] = __builtin_amdgcn_mfma_f32_16x16x32_bf16(Bt[n][k], At[m][k], acc[ai][bj][m][n], 0, 0, 0); __builtin_amdgcn_s_setprio(0); } while (0)
#define PG8_WAIT_V(n) asm volatile("s_waitcnt vmcnt(" #n ")" ::: "memory")
#define PG8_WAIT_L(n) asm volatile("s_waitcnt lgkmcnt(" #n ")" ::: "memory")
#define PG8_BAR __builtin_amdgcn_s_barrier()
#define PG8_SCHED __builtin_amdgcn_sched_barrier(0)
    Unit cur, nxt; int ui = 0;
    if (!S.next(0, cur)) return;
    f32x4 acc[2][2][4][2];
#pragma unroll
    for (int a = 0; a < 2; ++a)
#pragma unroll
        for (int b = 0; b < 2; ++b)
#pragma unroll
            for (int m = 0; m < 4; ++m)
#pragma unroll
                for (int n = 0; n < 2; ++n) acc[a][b][m][n] = (f32x4){0.f, 0.f, 0.f, 0.f};
    bf16x8 At[4][2], B0[2][2], B1[2][2];
    const char* cA = (const char*)g.A + (size_t)cur.pm * tstepA; const char* cB = (const char*)g.Bt + (size_t)cur.pn * tstepB;
    S.a_ready(cur);
    if constexpr (SP2) {
        PG8_STAGE(PG8_SB(0, 0), cB, voffB); PG8_STAGE(PG8_SB(0, 1), cB + hstepB, voffB); PG8_STAGE(PG8_SA(0, 0), cA, voffA); PG8_STAGE(PG8_SA(0, 1), cA + hstepA, voffA);
        if (wr == 1) PG8_BAR;
        PG8_WAIT_V(2); PG8_BAR;
        PG8_STAGE(PG8_SB(1, 0), cB + kstep, voffB); PG8_STAGE(PG8_SA(1, 0), cA + kstep, voffA); PG8_STAGE(PG8_SB(1, 1), cB + hstepB + kstep, voffB);
        PG8_WAIT_V(6); PG8_BAR;
    } else {
        PG8_STAGE(PG8_SB(0, 0), cB, voffB); PG8_STAGE(PG8_SA(0, 0), cA, voffA); PG8_STAGE(PG8_SB(0, 1), cB + hstepB, voffB); PG8_STAGE(PG8_SA(0, 1), cA + hstepA, voffA);
        if (wr == 1) PG8_BAR;
        PG8_WAIT_V(4); PG8_BAR;
        PG8_STAGE(PG8_SB(1, 0), cB + kstep, voffB); PG8_STAGE(PG8_SA(1, 0), cA + kstep, voffA); PG8_STAGE(PG8_SB(1, 1), cB + hstepB + kstep, voffB);
        PG8_WAIT_V(6); PG8_BAR;
    }
    for (;;) {
        const bool has_next = S.next(ui + 1, nxt);
        const char* nA = has_next ? (const char*)g.A + (size_t)nxt.pm * tstepA : cA; const char* nB = has_next ? (const char*)g.Bt + (size_t)nxt.pn * tstepB : cB;
        for (int t = 0; t < nt; t += 2) {
            const bool last = (t == nt - 2);
            const char* a1 = cA + (size_t)(t + 1) * kstep;
            const char* a2 = last ? nA : cA + (size_t)(t + 2) * kstep; const char* b2 = last ? nB : cB + (size_t)(t + 2) * kstep;
            const char* a3 = a2 + kstep; const char* b3 = b2 + kstep;
            if (last && has_next) S.a_ready(nxt);
            if constexpr (SP2) {
            PG8_LDB(B0, 0, 0); PG8_LDB(B1, 0, 1); PG8_SCHED; PG8_LDA(At, 0, 0); PG8_STAGE(PG8_SA(1, 1), a1 + hstepA, voffA);
            PG8_WAIT_V(8); PG8_WAIT_L(0); PG8_BAR; PG8_MMA(0, 0, At, B0); PG8_MMA(0, 1, At, B1); PG8_BAR; PG8_SCHED;
            PG8_LDA(At, 0, 1); PG8_STAGE(PG8_SB(0, 0), b2, voffB); PG8_STAGE(PG8_SB(0, 1), b2 + hstepB, voffB); PG8_STAGE(PG8_SA(0, 0), a2, voffA);
            PG8_WAIT_V(8); PG8_WAIT_L(0); PG8_BAR; PG8_MMA(1, 0, At, B0); PG8_MMA(1, 1, At, B1); PG8_BAR; PG8_SCHED;
            PG8_LDB(B0, 1, 0); PG8_LDB(B1, 1, 1); PG8_SCHED; PG8_LDA(At, 1, 0); PG8_STAGE(PG8_SA(0, 1), a2 + hstepA, voffA);
            PG8_WAIT_V(8); PG8_WAIT_L(0); PG8_BAR; PG8_MMA(0, 0, At, B0); PG8_MMA(0, 1, At, B1); PG8_BAR; PG8_SCHED;
            PG8_LDA(At, 1, 1); PG8_STAGE(PG8_SB(1, 0), b3, voffB); PG8_STAGE(PG8_SB(1, 1), b3 + hstepB, voffB); PG8_STAGE(PG8_SA(1, 0), a3, voffA);
            PG8_WAIT_V(8); PG8_WAIT_L(0); PG8_BAR; PG8_MMA(1, 0, At, B0); PG8_MMA(1, 1, At, B1); PG8_BAR; PG8_SCHED;
            } else {
            PG8_LDB(B0, 0, 0); PG8_SCHED; PG8_LDA(At, 0, 0); PG8_STAGE(PG8_SA(1, 1), a1 + hstepA, voffA);
            PG8_WAIT_L(8); PG8_BAR; PG8_WAIT_L(0); PG8_MMA(0, 0, At, B0); PG8_BAR; PG8_SCHED;
            PG8_LDB(B1, 0, 1); PG8_STAGE(PG8_SB(0, 0), b2, voffB);
            PG8_BAR; PG8_WAIT_L(0); PG8_MMA(0, 1, At, B1); PG8_BAR;
            PG8_LDA(At, 0, 1); PG8_STAGE(PG8_SA(0, 0), a2, voffA);
            PG8_BAR; PG8_WAIT_L(0); PG8_MMA(1, 0, At, B0); PG8_BAR; PG8_SCHED;
            PG8_STAGE(PG8_SB(0, 1), b2 + hstepB, voffB);
            PG8_WAIT_V(6); PG8_BAR; PG8_MMA(1, 1, At, B1); PG8_BAR;
            PG8_LDB(B0, 1, 0); PG8_SCHED; PG8_LDA(At, 1, 0); PG8_STAGE(PG8_SA(0, 1), a2 + hstepA, voffA);
            PG8_WAIT_L(8); PG8_BAR; PG8_WAIT_L(0); PG8_MMA(0, 0, At, B0); PG8_BAR; PG8_SCHED;
            PG8_LDB(B1, 1, 1); PG8_STAGE(PG8_SB(1, 0), b3, voffB);
            PG8_BAR; PG8_WAIT_L(0); PG8_MMA(0, 1, At, B1); PG8_BAR;
            PG8_LDA(At, 1, 1); PG8_STAGE(PG8_SA(1, 0), a3, voffA);
            PG8_BAR; PG8_WAIT_L(0); PG8_MMA(1, 0, At, B0); PG8_BAR; PG8_SCHED;
            PG8_STAGE(PG8_SB(1, 1), b3 + hstepB, voffB);
            PG8_WAIT_V(6); PG8_BAR; PG8_MMA(1, 1, At, B1); PG8_BAR;
            }
        }
        if constexpr (ALIGN_EPI) { if (wr == 0) PG8_BAR; }
        E(acc, cur, wr, wc, fr, fq); S.done(cur);
        if (!has_next) break;
#pragma unroll
        for (int a = 0; a < 2; ++a)
#pragma unroll
            for (int b = 0; b < 2; ++b)
#pragma unroll
                for (int m = 0; m < 4; ++m)
#pragma unroll
                    for (int n = 0; n < 2; ++n) acc[a][b][m][n] = (f32x4){0.f, 0.f, 0.f, 0.f};
        cur = nxt; cA = nA; cB = nB; ++ui;
        if constexpr (ALIGN_EPI) { if (wr == 1) PG8_BAR; }
    }
    PG8_WAIT_V(0);
    if constexpr (!ALIGN_EPI) { if (wr == 0) PG8_BAR; }
    PG8_BAR;
#undef PG8_SA
#undef PG8_SB
#undef PG8_STAGE
#undef PG8_LDA
#undef PG8_LDB
#undef PG8_MMA
#undef PG8_WAIT_V
#undef PG8_WAIT_L
#undef PG8_BAR
#undef PG8_SCHED
}
}

#define XB_TMO      128
#define XB_XCNT(j)  (256  + 64 * (j))
#define XB_XSUB(j)  (1280 + 64 * (j))
#define XB_XGEN(j)  (2304 + 64 * (j))
#define XB_TOP      3328
#define XB_TOPGEN   3392
#define XCD_BAR_WORDS 3456
#define XB_SPIN_CAP (1u << 18)
__device__ __forceinline__ unsigned xb_ld(unsigned* p)              { return __hip_atomic_load(p, __ATOMIC_RELAXED, __HIP_MEMORY_SCOPE_AGENT); }
__device__ __forceinline__ unsigned xb_add(unsigned* p, unsigned v) { return __hip_atomic_fetch_add(p, v, __ATOMIC_RELAXED, __HIP_MEMORY_SCOPE_AGENT); }
__device__ __forceinline__ unsigned xb_xcc_id() { return (unsigned)__builtin_amdgcn_s_getreg((3 << 11) | 20) & 0xFu; }
#define XB_SPIN(cond, bar) do { unsigned _sp = 0; while (cond) { __builtin_amdgcn_s_sleep(1); \
    if ((++_sp & 255u) == 0u) { if (xb_ld(&(bar)[XB_TMO])) break; if (_sp > XB_SPIN_CAP) { atomicAdd(&(bar)[XB_TMO], 1u); break; } } } } while (0)
struct XcdBarrier { unsigned* bar; unsigned x; volatile LAS unsigned* st; int wv; };
__device__ __forceinline__ bool xb_thread0(int wv) { return wv == 0 && lane_fresh() == 0; }
__device__ __forceinline__ XcdBarrier xcd_barrier_post(unsigned* bar, volatile LAS unsigned* st, int wv) {
    XcdBarrier b; b.bar = bar; b.x = xb_xcc_id(); b.st = st; b.wv = wv;
    if (xb_thread0(wv)) (void)xb_add(&bar[XB_XCNT(b.x)], 1u);
    return b;
}
__device__ __forceinline__ void xcd_barrier_complete(unsigned* bar, unsigned x, unsigned& nloc, unsigned& nx) {
    const unsigned G = gridDim.x * gridDim.y * gridDim.z;
    unsigned sum, cnt, mine, sp = 0u;
    for (;;) {
        sum = 0u; cnt = 0u;
#pragma unroll
        for (unsigned j = 0; j < 16; ++j) { const unsigned c = xb_ld(&bar[XB_XCNT(j)]); sum += c; cnt += (c > 0u) ? 1u : 0u; }
        mine = xb_ld(&bar[XB_XCNT(x)]);
        if (sum == G) break;
        __builtin_amdgcn_s_sleep(1);
        if ((++sp & 255u) == 0u) { if (xb_ld(&bar[XB_TMO])) break; if (sp > XB_SPIN_CAP) { atomicAdd(&bar[XB_TMO], 1u); break; } }
    }
    nloc = mine > 0u ? mine : 1u; nx = cnt > 0u ? cnt : 1u;
}
__device__ __forceinline__ void xcd_barrier(const XcdBarrier& b) {
    asm volatile("s_waitcnt vmcnt(0)" ::: "memory");
    __syncthreads();
    if (xb_thread0(b.wv)) {
        unsigned* bar = b.bar; asm volatile("" : "+s"(bar));
        __builtin_amdgcn_s_waitcnt(0);
        unsigned nloc = b.st[0], nx = b.st[1];
        if (nloc == 0u) { xcd_barrier_complete(bar, b.x, nloc, nx); b.st[0] = nloc; b.st[1] = nx; }
        const unsigned old = xb_add(&bar[XB_XSUB(b.x)], 1u);
        const unsigned gen = old / nloc;
        if (old + 1u == (gen + 1u) * nloc) {
            __builtin_amdgcn_fence(__ATOMIC_RELEASE, "agent");
            asm volatile("s_waitcnt vmcnt(0)" ::: "memory");
            const unsigned og = xb_add(&bar[XB_TOP], 1u);
            const unsigned tg = og / nx;
            if (og + 1u == (tg + 1u) * nx) xb_add(&bar[XB_TOPGEN], 1u);
            else XB_SPIN(xb_ld(&bar[XB_TOPGEN]) == tg, bar);
            __builtin_amdgcn_fence(__ATOMIC_ACQUIRE, "agent");
            xb_add(&bar[XB_XGEN(b.x)], 1u);
            asm volatile("s_waitcnt vmcnt(0)" ::: "memory");
        } else {
            XB_SPIN(xb_ld(&bar[XB_XGEN(b.x)]) == gen, bar);
            __builtin_amdgcn_fence(__ATOMIC_ACQUIRE, "agent");
            asm volatile("s_waitcnt vmcnt(0)" ::: "memory");
        }
    }
    __syncthreads();
}

namespace att {
constexpr int KVBLK = 64, QBLK = 32, QB = 256;
constexpr int SHM_V = 16384, SHM_K = 16384, SHM_KR = 8192;
constexpr int V_OFF = 0, K_OFF = 2 * SHM_V, KR_OFF = K_OFF + 2 * SHM_K, WS_OFF = KR_OFF + 2 * SHM_KR, FLG_OFF = WS_OFF + 8 * 256, QR_OFF = FLG_OFF + 64 + 384, ATT_LDS = QR_OFF + 8 * 4096;
constexpr float SB_DONE = 0.f;
constexpr float THR2 = 11.5f;
#define KSWZ(row, colB) ((row) * 256 + ((colB) ^ ((((row) & 7) | ((((row) >> 4) & 1) << 3)) << 4)))
#define KRSWZ(row, colB) ((row) * 128 + ((colB) ^ ((((row) >> 1) & 7) << 4)))
__device__ __forceinline__ int v_st(int k, int c) { const int kk = (k & ~0xC) | ((k & 4) << 1) | ((k & 8) >> 1); return ((kk >> 3) * 4 + (c >> 5)) * 512 + ((kk & 7) * 32 + (c & 31)) * 2; }
__device__ __forceinline__ int v_rd_base(int lane) { return ((lane & 3) << 3) | (((lane >> 2) & 3) << 6) | (((lane >> 4) & 1) << 5) | (((lane >> 5) & 1) << 8); }
constexpr int v_rd_off(int d0, int ks, int half) { return d0 * 512 + ks * 4096 + half * 2048; }
__device__ __forceinline__ int crow(int r, int hi) { return (r & 3) + 8 * (r >> 2) + 4 * hi; }
__device__ __forceinline__ float xhalf(float v, int hi) {
    auto rr = __builtin_amdgcn_permlane32_swap(__float_as_uint(v), __float_as_uint(v), false, false);
    return __uint_as_float(hi ? rr[0] : rr[1]);
}
__device__ __forceinline__ void mask_tile(f32x16& p0, f32x16& p1, int dq, unsigned W) {
    const float NEG = -__builtin_inff();
#pragma unroll
    for (int r = 0; r < 16; ++r) {
        const int c = (r & 3) + 8 * (r >> 2);
        if ((unsigned)(dq - c) >= W) p0[r] = NEG;
        if ((unsigned)(dq - c - 32) >= W) p1[r] = NEG;
    }
}
#define PK4(P, B_, OUT) do { unsigned a0 = cvtpk(P[B_+0], P[B_+1]), a1 = cvtpk(P[B_+2], P[B_+3]);                          \
        unsigned b0 = cvtpk(P[B_+4], P[B_+5]), b1 = cvtpk(P[B_+6], P[B_+7]);                                             \
        auto r0 = __builtin_amdgcn_permlane32_swap(a0, b0, false, false); auto r1 = __builtin_amdgcn_permlane32_swap(a1, b1, false, false); \
        u32x4 w = {r0[0], r1[0], r0[1], r1[1]}; OUT = __builtin_bit_cast(bf16x8, w); } while (0)
__device__ __forceinline__ void softmax_tile(f32x16& p0, f32x16& p1, float& m_reg, float& l_reg, float& alpha) {
    float pmax = p0[0];
#pragma unroll
    for (int r = 1; r < 16; ++r) pmax = fmaxf(pmax, p0[r]);
#pragma unroll
    for (int r = 0; r < 16; ++r) pmax = fmaxf(pmax, p1[r]);
    { auto rr = __builtin_amdgcn_permlane32_swap(__float_as_uint(pmax), __float_as_uint(pmax), false, false);
      pmax = fmaxf(__uint_as_float(rr[0]), __uint_as_float(rr[1])); }
    float mn;
    if (__all((pmax - m_reg) <= THR2)) { mn = m_reg; alpha = 1.f; }
    else { mn = fmaxf(m_reg, pmax); alpha = __builtin_amdgcn_exp2f(m_reg - mn); m_reg = mn; }
#pragma unroll
    for (int r = 0; r < 16; ++r) p0[r] = __builtin_amdgcn_exp2f(p0[r] - mn);
#pragma unroll
    for (int r = 0; r < 16; ++r) p1[r] = __builtin_amdgcn_exp2f(p1[r] - mn);
    float ps = 0.f;
#pragma unroll
    for (int r = 0; r < 16; ++r) ps += p0[r];
#pragma unroll
    for (int r = 0; r < 16; ++r) ps += p1[r];
    { auto rr = __builtin_amdgcn_permlane32_swap(__float_as_uint(ps), __float_as_uint(ps), false, false);
      ps = __uint_as_float(rr[0]) + __uint_as_float(rr[1]); }
    l_reg = l_reg * alpha + ps;
}
__device__ __forceinline__ void sb_half(f32x16& p, float rin, float& rout, int hi) {
#pragma unroll
    for (int r = 0; r < 16; ++r) p[r] = __builtin_amdgcn_rcpf(1.f + __builtin_amdgcn_exp2f(p[r]));
    float s[4], q[4], R[4];
#pragma unroll
    for (int g = 0; g < 4; ++g) s[g] = (p[4 * g] * p[4 * g + 1]) * (p[4 * g + 2] * p[4 * g + 3]);
#pragma unroll
    for (int g = 0; g < 4; ++g) q[g] = xhalf(s[g], hi);
    R[3] = rin; R[2] = R[3] * (s[3] * q[3]); R[1] = R[2] * (s[2] * q[2]); R[0] = R[1] * (s[1] * q[1]);
    rout = R[0] * (s[0] * q[0]);
#pragma unroll
    for (int g = 0; g < 4; ++g) {
        float run = hi ? R[g] : R[g] * q[g];
#pragma unroll
        for (int i = 3; i >= 0; --i) { const float ui = p[4 * g + i]; p[4 * g + i] = (1.f - ui) * run; run *= ui; }
    }
}
__device__ __forceinline__ void sb_tile(f32x16& p0, f32x16& p1, float& carry, int hi) {
    float mid, nc;
    sb_half(p1, carry, mid, hi);
    sb_half(p0, mid, nc, hi);
    carry = nc;
}
template <bool MLA>
__device__ __forceinline__ void qkt(f32x16& p0, f32x16& p1, LAS unsigned char* lds, int KB, int r32, int hi, const bf16x8* qr, const bf16x8* qrr, bool a0, bool a1) {
    constexpr int NF = MLA ? 12 : 8, D = 8;
    const float NEG = -__builtin_inff();
    unsigned kb[4];
#pragma unroll
    for (int dd = 0; dd < 4; ++dd) kb[dd] = (unsigned)(K_OFF + KB * SHM_K + KSWZ(r32, (dd * 16 + hi * 8) * 2));
    const unsigned krb = (unsigned)(KR_OFF + KB * SHM_KR);
#define KADDR(i) ((i) < 8 ? (kb[(i) & 3] ^ ((unsigned)(((i) & 7) >> 2) << 7)) : krb + (unsigned)KRSWZ(r32, ((((i) < 8 ? 8 : (i)) - 8) * 16 + hi * 8) * 2))
#define KHOFF(i) ((i) < 8 ? 32u * 256u : 32u * 128u)
#define QFRAG(i) ((i) < 8 ? qr[(i) < 8 ? (i) : 0] : qrr[(i) < 8 ? 0 : (i) - 8])
    bf16x8 F[D];
    if (a0 && a1) {
#pragma unroll
        for (int s_ = 0; s_ < D; ++s_) F[s_] = *(const LAS bf16x8*)(lds + KADDR(s_ % NF) + (s_ / NF) * KHOFF(s_ % NF));
        SBAR();
#pragma unroll
        for (int r = 0; r < 16; ++r) { p0[r] = 0.f; p1[r] = 0.f; }
        __builtin_amdgcn_s_setprio(1);
#pragma unroll
        for (int s_ = 0; s_ < 2 * NF; ++s_) { const int i = s_ % NF;
            if (s_ < NF) p0 = __builtin_amdgcn_mfma_f32_32x32x16_bf16(F[s_ % D], QFRAG(i), p0, 0, 0, 0);
            else p1 = __builtin_amdgcn_mfma_f32_32x32x16_bf16(F[s_ % D], QFRAG(i), p1, 0, 0, 0);
            if (s_ + D < 2 * NF) F[s_ % D] = *(const LAS bf16x8*)(lds + KADDR((s_ + D) % NF) + ((s_ + D) / NF) * KHOFF((s_ + D) % NF));
            SBAR(); }
    } else if (a0) {
#pragma unroll
        for (int s_ = 0; s_ < D; ++s_) F[s_] = *(const LAS bf16x8*)(lds + KADDR(s_));
        SBAR();
#pragma unroll
        for (int r = 0; r < 16; ++r) { p0[r] = 0.f; p1[r] = NEG; }
        __builtin_amdgcn_s_setprio(1);
#pragma unroll
        for (int s_ = 0; s_ < NF; ++s_) { p0 = __builtin_amdgcn_mfma_f32_32x32x16_bf16(F[s_ % D], QFRAG(s_), p0, 0, 0, 0);
            if (s_ + D < NF) F[s_ % D] = *(const LAS bf16x8*)(lds + KADDR(s_ + D));
            SBAR(); }
    } else {
#pragma unroll
        for (int s_ = 0; s_ < D; ++s_) F[s_] = *(const LAS bf16x8*)(lds + KADDR(s_) + KHOFF(s_));
        SBAR();
#pragma unroll
        for (int r = 0; r < 16; ++r) { p1[r] = 0.f; p0[r] = NEG; }
        __builtin_amdgcn_s_setprio(1);
#pragma unroll
        for (int s_ = 0; s_ < NF; ++s_) { p1 = __builtin_amdgcn_mfma_f32_32x32x16_bf16(F[s_ % D], QFRAG(s_), p1, 0, 0, 0);
            if (s_ + D < NF) F[s_ % D] = *(const LAS bf16x8*)(lds + KADDR(s_ + D) + KHOFF(s_ + D));
            SBAR(); }
    }
    __builtin_amdgcn_s_setprio(0);
#undef KADDR
#undef KHOFF
#undef QFRAG
}
__device__ __forceinline__ void pv_tile(f32x16* o, unsigned vb0, const f32x16& p0, const f32x16& p1, bool a0, bool a1) {
#define TRRD(dst, off) asm volatile("ds_read_b64_tr_b16 %0, %1 offset:%2" : "=&v"(dst) : "v"(vb0), "i"(off) : "memory")
#define PV_RD(ks, S) do { constexpr int b_ = V_OFF + v_rd_off(0, ks, 0); \
        TRRD(S##l0, b_); TRRD(S##h0, b_ + 2048); TRRD(S##l1, b_ + 512); TRRD(S##h1, b_ + 512 + 2048); TRRD(S##l2, b_ + 1024); TRRD(S##h2, b_ + 1024 + 2048); TRRD(S##l3, b_ + 1536); TRRD(S##h3, b_ + 1536 + 2048); } while (0)
#define PV_MM(S, P, B_) do { bf16x8 pa; PK4(P, B_, pa); __builtin_amdgcn_s_setprio(1); \
        o[0] = __builtin_amdgcn_mfma_f32_32x32x16_bf16(pa, (bf16x8){S##l0[0], S##l0[1], S##l0[2], S##l0[3], S##h0[0], S##h0[1], S##h0[2], S##h0[3]}, o[0], 0, 0, 0);   \
        o[1] = __builtin_amdgcn_mfma_f32_32x32x16_bf16(pa, (bf16x8){S##l1[0], S##l1[1], S##l1[2], S##l1[3], S##h1[0], S##h1[1], S##h1[2], S##h1[3]}, o[1], 0, 0, 0);   \
        o[2] = __builtin_amdgcn_mfma_f32_32x32x16_bf16(pa, (bf16x8){S##l2[0], S##l2[1], S##l2[2], S##l2[3], S##h2[0], S##h2[1], S##h2[2], S##h2[3]}, o[2], 0, 0, 0);   \
        o[3] = __builtin_amdgcn_mfma_f32_32x32x16_bf16(pa, (bf16x8){S##l3[0], S##l3[1], S##l3[2], S##l3[3], S##h3[0], S##h3[1], S##h3[2], S##h3[3]}, o[3], 0, 0, 0); __builtin_amdgcn_s_setprio(0); } while (0)
    s16x4 Al0, Al1, Al2, Al3, Ah0, Ah1, Ah2, Ah3, Bl0, Bl1, Bl2, Bl3, Bh0, Bh1, Bh2, Bh3;
    if (a0) {
        PV_RD(0, A); PV_RD(1, B);
        asm volatile("s_waitcnt lgkmcnt(8)" ::: "memory"); SBAR(); PV_MM(A, p0, 0); SBAR();
        asm volatile("s_waitcnt lgkmcnt(0)" ::: "memory"); SBAR(); PV_MM(B, p0, 8); SBAR();
    }
    if (a1) {
        PV_RD(2, A); PV_RD(3, B);
        asm volatile("s_waitcnt lgkmcnt(8)" ::: "memory"); SBAR(); PV_MM(A, p1, 0); SBAR();
        asm volatile("s_waitcnt lgkmcnt(0)" ::: "memory"); SBAR(); PV_MM(B, p1, 8);
    }
#undef PV_MM
#undef PV_RD
#undef TRRD
}

struct Blk {
    const bf16_t* Q;
    const bf16_t* K;
    const bf16_t* V;
    bf16_t* O;
    const bf16_t* G;
    float* LSE;
    int P0;
    int dil;
    const float* ssq;
    const float* qw;
    const float* cs; const float* sn;
};
template <int MODE>
__device__ __forceinline__ void attn_block(const Blk& b, LAS unsigned char* lds, int wv) {
    constexpr bool MLA = MODE == 0, DIL = MODE == 1, SB = MODE == 2;
    constexpr int NQR = 8;
    const int qs = MLA ? UQ_N : (DIL ? b.dil * EVEN_LD : EVEN_LD), ks = MLA ? 192 : qs, vs = MLA ? 128 : qs;
    const int os = DIL ? b.dil * 2048 : DM, gs = MLA ? ODD_INP : EVEN_LD, ls = DIL ? b.dil * 16 : 0;
    const int tid = opaque_tid(wv), wid = __builtin_amdgcn_readfirstlane(tid >> 6), lane = tid & 63, r32 = lane & 31, hi = lane >> 5;
    int j_lo = 0; const int j_hi = b.P0 / KVBLK + 4;
    if (DIL) j_lo = b.P0 >= 256 ? b.P0 / KVBLK - 2 : 0;
    int NT = j_hi - j_lo;
    const int qlo = b.P0 + wid * QBLK, qm = qlo + r32 - 4 * hi;
    LAS float* wsf = (LAS float*)(lds + WS_OFF) + wid * 64; LAS float* li_l = wsf; LAS float* al_l = wsf + 32;
    const unsigned vb0 = (unsigned)(size_t)(lds + V_OFF) + (unsigned)v_rd_base(lane);
    unsigned kdo[2], vdo[2], krdo = 0u;
#pragma unroll
    for (int i = 0; i < 2; ++i) { const int row = 4 * (2 * wid + i) + (lane >> 4);
        kdo[i] = (unsigned)row * (unsigned)(ks * 2) + ((((unsigned)lane & 15u) << 4) ^ ((unsigned)((row & 7) | (((row >> 4) & 1) << 3)) << 4));
        const int key = (((lane >> 2) & 3) | (((lane >> 4) & 1) << 3)) + (((wid & 1) << 2) | ((wid >> 1) << 4));
        vdo[i] = (unsigned)key * (unsigned)(vs * 2) + (unsigned)(((2 * i + (lane >> 5)) * 32 + (lane & 3) * 8) * 2); }
    if constexpr (MLA) { const int row = 8 * wid + (lane >> 3); krdo = (unsigned)row * (unsigned)(ks * 2) + 256u + ((((unsigned)lane & 7u) << 4) ^ ((unsigned)((row >> 1) & 7) << 4)); }
#define TILE_J(t) (SB ? (j_hi - 1 - (t)) : (j_lo + (t)))
#define TDMA(j, bf) do { const char* kt_ = (const char*)b.K + (size_t)(j) * KVBLK * ks * 2; const char* vt_ = (const char*)b.V + (size_t)(j) * KVBLK * vs * 2; \
        _Pragma("unroll") for (int i_ = 0; i_ < 2; ++i_) __builtin_amdgcn_global_load_lds((const unsigned*)(kt_ + kdo[i_]), (LAS unsigned*)(lds + K_OFF + (bf) * SHM_K + (2 * wid + i_) * 1024), 16, 0, 0); \
        _Pragma("unroll") for (int i_ = 0; i_ < 2; ++i_) __builtin_amdgcn_global_load_lds((const unsigned*)(vt_ + vdo[i_]), (LAS unsigned*)(lds + V_OFF + (bf) * SHM_V + (2 * wid + i_) * 1024), 16, 0, 0); \
        if constexpr (MLA) __builtin_amdgcn_global_load_lds((const unsigned*)(kt_ + krdo), (LAS unsigned*)(lds + KR_OFF + (bf) * SHM_KR + wid * 1024), 16, 0, 0); } while (0)
    TDMA(TILE_J(0), 0);
    bf16x8 qr[NQR]; bf16x8 qrr[4];
    if constexpr (!MLA) { const bf16_t* qp = b.Q + (size_t)(wid * QBLK + r32) * qs + hi * 8;
#pragma unroll
      for (int d0 = 0; d0 < NQR; ++d0) qr[d0] = *(const bf16x8*)(qp + d0 * 16); }
    else {
      const int row = wid * QBLK + r32;
      const bf16_t* qp = b.Q + (size_t)row * qs + hi * 8;
      u32x4 raw[12];
#pragma unroll
      for (int d0 = 0; d0 < 12; ++d0) raw[d0] = *(const u32x4*)(qp + d0 * 16);
      f32x4 wq[16], w1r[2][2], w2r[2][2], csr[2][2], snr[2][2];
#pragma unroll
      for (int d0 = 0; d0 < 8; ++d0) { wq[2 * d0] = *(const f32x4*)(b.qw + d0 * 16 + hi * 8); wq[2 * d0 + 1] = *(const f32x4*)(b.qw + d0 * 16 + hi * 8 + 4); }
#pragma unroll
      for (int d1 = 0; d1 < 2; ++d1)
#pragma unroll
          for (int h4 = 0; h4 < 2; ++h4) { const int i0 = d1 * 16 + hi * 8 + 4 * h4;
              w1r[d1][h4] = *(const f32x4*)(b.qw + 128 + i0); w2r[d1][h4] = *(const f32x4*)(b.qw + 160 + i0);
              csr[d1][h4] = *(const f32x4*)(b.cs + row * 32 + i0); snr[d1][h4] = *(const f32x4*)(b.sn + row * 32 + i0); }
      const float rq = __builtin_amdgcn_rsqf(b.ssq[row] * (1.0f / QLORA) + EPS);
      float ss = 0.f;
#pragma unroll
      for (int d0 = 0; d0 < 12; ++d0) { float x[8]; unpack8(raw[d0], x);
#pragma unroll
          for (int e = 0; e < 8; ++e) ss += x[e] * x[e]; }
      ss += xhalf(ss, hi);
      const float sc = rq * __builtin_amdgcn_rsqf(rq * rq * ss * (1.0f / 192.0f) + EPS) * QS192;
#pragma unroll
      for (int d0 = 0; d0 < 8; ++d0) { float x[8]; unpack8(raw[d0], x); const f32x4 wa = wq[2 * d0], wb = wq[2 * d0 + 1];
#pragma unroll
          for (int e = 0; e < 4; ++e) { x[e] *= sc * wa[e]; x[4 + e] *= sc * wb[e]; }
          qr[d0] = __builtin_bit_cast(bf16x8, pack8u(x)); }
#pragma unroll
      for (int d1 = 0; d1 < 2; ++d1) { float x1[8], x2[8], o1[8], o2[8]; unpack8(raw[8 + d1], x1); unpack8(raw[10 + d1], x2);
          const int i0 = d1 * 16 + hi * 8;
#pragma unroll
          for (int e = 0; e < 8; ++e) { const float y1 = x1[e] * sc * w1r[d1][e >> 2][e & 3], y2 = x2[e] * sc * w2r[d1][e >> 2][e & 3]; const float c = csr[d1][e >> 2][e & 3], s = snr[d1][e >> 2][e & 3];
              o1[e] = y1 * c - y2 * s; o2[e] = y2 * c + y1 * s; }
          qrr[d1] = __builtin_bit_cast(bf16x8, pack8u(o1)); qrr[d1 + 2] = __builtin_bit_cast(bf16x8, pack8u(o2)); }
    }
    f32x16 o[4];
#pragma unroll
    for (int d = 0; d < 4; ++d)
#pragma unroll
        for (int r = 0; r < 16; ++r) o[d][r] = 0.f;
    float m_reg = -1e30f, l_reg = 0.f, carry = SB ? 1.f : 0.f;
#define TILE_FLAGS(t, act_, needm_, kb_) const int kb_ = TILE_J(t) * KVBLK; bool act_, needm_, a0_, a1_; \
        if (MLA) { a0_ = kb_ <= qlo + QBLK - 1; a1_ = kb_ + 32 <= qlo + QBLK - 1; needm_ = kb_ + KVBLK - 1 > qlo; } \
        else if (DIL) { a0_ = (kb_ <= qlo + QBLK - 1) && (kb_ + 31 >= qlo - 128); a1_ = (kb_ + 32 <= qlo + QBLK - 1) && (kb_ + KVBLK - 1 >= qlo - 128); \
                        needm_ = (kb_ + KVBLK - 1 > qlo) || (kb_ <= qlo + QBLK - 1 - 129); } \
        else { a0_ = kb_ <= qlo + QBLK - 2; a1_ = kb_ + 32 <= qlo + QBLK - 2; needm_ = kb_ + KVBLK - 1 > qlo - 1; } \
        act_ = a0_ || a1_;
    LAS unsigned* flg = (LAS unsigned*)(lds + FLG_OFF);
    constexpr bool NOPP = true;
    const bool h0 = NOPP ? true : (wid < 4);
#define SBDONE(td) ({ bool r_ = false; if constexpr (SB) { const u32x4 f0_ = *(const LAS u32x4*)(flg + ((td) & 1) * 8), f1_ = *(const LAS u32x4*)(flg + ((td) & 1) * 8 + 4); \
            r_ = (f0_.x & f0_.y & f0_.z & f0_.w & f1_.x & f1_.y & f1_.z & f1_.w) != 0u; } r_; })
    VM_WAIT();
    __syncthreads();
    bool stopped = false;
    for (int t = 0; t < NT; ++t) {
        if (SB && (NOPP || !h0) && t >= 1) { if (SBDONE(t - 1)) break; }
        if (t + 1 < NT) TDMA(TILE_J(t + 1), (t + 1) & 1);
        TILE_FLAGS(t, act_, needm_, kb_)
        f32x16 p0, p1;
        if (act_) qkt<MLA>(p0, p1, lds, t & 1, r32, hi, qr, qrr, a0_, a1_);
        if constexpr (!NOPP) __syncthreads();
        if (SB && !NOPP && h0 && t >= 1) { if (SBDONE(t - 1)) { stopped = true; break; } }
        if (act_) {
            if (needm_) { if (SB) mask_tile(p0, p1, qm - kb_ - 1, 0x7fffffffu); else mask_tile(p0, p1, qm - kb_, DIL ? 129u : 0x7fffffffu); }
            if constexpr (SB) { sb_tile(p0, p1, carry, hi); }
            else { float alpha_; softmax_tile(p0, p1, m_reg, l_reg, alpha_);
                if (__any(alpha_ < 1.f)) { if (hi == 0) al_l[r32] = alpha_; LDS_WAIT();
#pragma unroll
                    for (int d_ = 0; d_ < 4; ++d_)
#pragma unroll
                        for (int r = 0; r < 16; ++r) o[d_][r] *= al_l[crow(r, hi)]; } }
            pv_tile(o, vb0 + (unsigned)((t & 1) * SHM_V), p0, p1, a0_, a1_); }
        if constexpr (SB) { const bool dn_ = __all(carry <= SB_DONE); if (lane == 0) flg[(t & 1) * 8 + wid] = dn_ ? 1u : 0u; }
        VM_WAIT();
        __syncthreads();
    }
    if (!NOPP && h0 && !stopped) __syncthreads();
#undef SBDONE
#undef TILE_FLAGS
#undef TDMA
#undef TILE_J
    u32x4 gpre[8];
    if (b.G) {
#pragma unroll
        for (int i = 0; i < 8; ++i) { const int id = lane + 64 * i, row = id >> 4, c = id & 15; gpre[i] = *(const u32x4*)(b.G + (size_t)(wid * QBLK + row) * gs + c * 8); } }
    if constexpr (!SB) {
        if (hi == 0) li_l[r32] = l_reg;
        LDS_WAIT();
        if constexpr (DIL) { if (hi == 0) b.LSE[(size_t)(wid * QBLK + r32) * ls] = m_reg + __builtin_amdgcn_logf(l_reg); }
#pragma unroll
        for (int r = 0; r < 16; ++r) { const float rl = __builtin_amdgcn_rcpf(li_l[crow(r, hi)]);
#pragma unroll
            for (int d = 0; d < 4; ++d) o[d][r] *= rl; }
    }
    LAS unsigned char* ost = lds + wid * 8192;
#pragma unroll
    for (int r = 0; r < 16; ++r) { const int orow = crow(r, hi);
#pragma unroll
        for (int d = 0; d < 4; d += 2) {
            const float x = o[d][r], y = o[d + 1][r]; const bool odd = (r32 & 1) != 0;
            const float got = dpp_xor1(odd ? x : y);
            const unsigned w = odd ? cvtpk(got, y) : cvtpk(x, got);
            *(LAS unsigned*)(ost + orow * 256 + ((odd ? d + 1 : d) * 32 + (r32 & ~1)) * 2) = w; } }
    LDS_WAIT();
#pragma unroll
    for (int i = 0; i < 8; ++i) { const int id = lane + 64 * i, row = id >> 4, c = id & 15;
        u32x4 w = *(const LAS u32x4*)(ost + row * 256 + c * 16);
        if (b.G) { const u32x4 g = gpre[i]; float x[8], y[8]; unpack8(w, x); unpack8(g, y);
#pragma unroll
            for (int e = 0; e < 8; ++e) x[e] *= y[e];
            w = pack8u(x); }
        *(u32x4*)(b.O + (size_t)(wid * QBLK + row) * os + c * 8) = w; }
    __syncthreads();
}
__device__ __forceinline__ void attn_dil_wave(const Blk& b, LAS unsigned char* lds, LAS unsigned char* scratch, int wv) {
    const int qs = b.dil * EVEN_LD, os = b.dil * 2048, ls = b.dil * 16;
    const int tid = opaque_tid(wv), wid = __builtin_amdgcn_readfirstlane(tid >> 6), lane = tid & 63, r32 = lane & 31, hi = lane >> 5;
    const int qlo = b.P0, qm = qlo + r32 - 4 * hi;
    const int hlast = qlo >> 5, hfirst = qlo >= 128 ? hlast - 4 : 0, n = hlast - hfirst + 1;
    LAS unsigned char* kbuf = lds + wid * 16384; LAS unsigned char* vbuf = kbuf + 8192;
    LAS float* li_l = (LAS float*)(scratch + wid * 256); LAS float* al_l = li_l + 32;
    bf16x8 qr[8];
    { const bf16_t* qp = b.Q + (size_t)r32 * qs + hi * 8;
#pragma unroll
      for (int d0 = 0; d0 < 8; ++d0) qr[d0] = *(const bf16x8*)(qp + d0 * 16); }
    const unsigned rs2 = (unsigned)qs * 2u;
    const unsigned kl = (unsigned)(lane >> 4) * rs2 + ((((unsigned)lane & 15u) ^ ((unsigned)lane >> 4)) << 4);
    const unsigned vl = (unsigned)(((lane >> 2) & 3) | (((lane >> 4) & 1) << 3)) * rs2 + (unsigned)(((lane >> 5) * 32 + (lane & 3) * 8) * 2);
#define KDMA(hh) do { const char* kb_ = (const char*)b.K + (size_t)(hh) * 32 * rs2; _Pragma("unroll") for (int c_ = 0; c_ < 8; ++c_) \
        __builtin_amdgcn_global_load_lds((const unsigned*)(kb_ + (size_t)(4 * c_) * rs2 + (kl ^ (unsigned)(((c_ & 1) << 6) | ((c_ >> 2) << 7)))), (LAS unsigned*)(kbuf + c_ * 1024), 16, 0, 0); } while (0)
#define VDMA(hh) do { const char* vb_ = (const char*)b.V + (size_t)(hh) * 32 * rs2; _Pragma("unroll") for (int c_ = 0; c_ < 8; ++c_) \
        __builtin_amdgcn_global_load_lds((const unsigned*)(vb_ + (size_t)((((c_ >> 1) & 1) << 2) | ((c_ >> 2) << 4)) * rs2 + (c_ & 1) * 128 + vl), (LAS unsigned*)(vbuf + c_ * 1024), 16, 0, 0); } while (0)
    KDMA(hfirst); VDMA(hfirst);
    f32x16 o[4];
#pragma unroll
    for (int d = 0; d < 4; ++d)
#pragma unroll
        for (int r = 0; r < 16; ++r) o[d][r] = 0.f;
    float m_reg = -1e30f, l_reg = 0.f;
    const unsigned vb0 = (unsigned)(size_t)vbuf + (unsigned)v_rd_base(lane);
    unsigned kb[4];
#pragma unroll
    for (int dd = 0; dd < 4; ++dd) kb[dd] = (unsigned)(wid * 16384 + KSWZ(r32, (dd * 16 + hi * 8) * 2));
    const float NEG = -__builtin_inff();
    for (int i = 0; i < n; ++i) { const int hh = hfirst + i; const bool more = i + 1 < n;
        asm volatile("s_waitcnt vmcnt(8)" ::: "memory");
        f32x16 p;
#pragma unroll
        for (int r = 0; r < 16; ++r) p[r] = 0.f;
        { bf16x8 F[8];
#pragma unroll
          for (int d0 = 0; d0 < 8; ++d0) F[d0] = *(const LAS bf16x8*)(lds + (kb[d0 & 3] ^ ((unsigned)(d0 >> 2) << 7)));
          SBAR();
          __builtin_amdgcn_s_setprio(1);
#pragma unroll
          for (int d0 = 0; d0 < 8; ++d0) p = __builtin_amdgcn_mfma_f32_32x32x16_bf16(F[d0], qr[d0], p, 0, 0, 0);
          __builtin_amdgcn_s_setprio(0); }
        LDS_WAIT(); asm volatile("" ::: "memory");
        if (more) KDMA(hh + 1);
        if (hh == hlast || hh * 32 < qlo + 31 - 128) { const int dq = qm - hh * 32;
#pragma unroll
            for (int r = 0; r < 16; ++r) { const int c = (r & 3) + 8 * (r >> 2); if ((unsigned)(dq - c) >= 129u) p[r] = NEG; } }
        { float pmax = p[0];
#pragma unroll
          for (int r = 1; r < 16; ++r) pmax = fmaxf(pmax, p[r]);
          { auto rr = __builtin_amdgcn_permlane32_swap(__float_as_uint(pmax), __float_as_uint(pmax), false, false); pmax = fmaxf(__uint_as_float(rr[0]), __uint_as_float(rr[1])); }
          float mn, alpha;
          if (__all((pmax - m_reg) <= THR2)) { mn = m_reg; alpha = 1.f; }
          else { mn = fmaxf(m_reg, pmax); alpha = __builtin_amdgcn_exp2f(m_reg - mn); m_reg = mn; }
#pragma unroll
          for (int r = 0; r < 16; ++r) p[r] = __builtin_amdgcn_exp2f(p[r] - mn);
          float ps = 0.f;
#pragma unroll
          for (int r = 0; r < 16; ++r) ps += p[r];
          { auto rr = __builtin_amdgcn_permlane32_swap(__float_as_uint(ps), __float_as_uint(ps), false, false); ps = __uint_as_float(rr[0]) + __uint_as_float(rr[1]); }
          l_reg = l_reg * alpha + ps;
          if (__any(alpha < 1.f)) { if (hi == 0) al_l[r32] = alpha; LDS_WAIT();
#pragma unroll
              for (int d_ = 0; d_ < 4; ++d_)
#pragma unroll
                  for (int r = 0; r < 16; ++r) o[d_][r] *= al_l[crow(r, hi)];
              LDS_WAIT(); } }
        if (more) asm volatile("s_waitcnt vmcnt(8)" ::: "memory"); else asm volatile("s_waitcnt vmcnt(0)" ::: "memory");
        pv_tile(o, vb0, p, p, true, false);
        LDS_WAIT(); asm volatile("" ::: "memory");
        if (more) VDMA(hh + 1);
    }
#undef KDMA
#undef VDMA
    if (hi == 0) li_l[r32] = l_reg;
    LDS_WAIT();
    if (hi == 0) b.LSE[(size_t)r32 * ls] = m_reg + __builtin_amdgcn_logf(l_reg);
#pragma unroll
    for (int r = 0; r < 16; ++r) { const float rl = __builtin_amdgcn_rcpf(li_l[crow(r, hi)]);
#pragma unroll
        for (int d = 0; d < 4; ++d) o[d][r] *= rl; }
    LAS unsigned char* ost = kbuf;
#pragma unroll
    for (int r = 0; r < 16; ++r) { const int orow = crow(r, hi);
#pragma unroll
        for (int d = 0; d < 4; d += 2) {
            const float x = o[d][r], y = o[d + 1][r]; const bool odd = (r32 & 1) != 0;
            const float got = dpp_xor1(odd ? x : y);
            const unsigned w = odd ? cvtpk(got, y) : cvtpk(x, got);
            *(LAS unsigned*)(ost + orow * 256 + ((odd ? d + 1 : d) * 32 + (r32 & ~1)) * 2) = w; } }
    LDS_WAIT();
#pragma unroll 2
    for (int i = 0; i < 8; ++i) { const int id = lane + 64 * i, row = id >> 4, c = id & 15;
        const u32x4 w = *(const LAS u32x4*)(ost + row * 256 + c * 16);
        *(u32x4*)(b.O + (size_t)row * os + c * 8) = w; }
    LDS_WAIT(); asm volatile("" ::: "memory");
}
}

struct Args { const void* in[18]; float* out; unsigned char* ws; int ph_lo, ph_hi; };
typedef const __attribute__((address_space(4))) Args CArgs;
__device__ __forceinline__ CArgs* kargs() { CArgs* p = (CArgs*)__builtin_amdgcn_kernarg_segment_ptr(); asm volatile("" : "+s"(p)); return p; }
enum { IN_X = 0, IN_C, IN_POS, IN_ADAW, IN_ADAB, IN_NORMW, IN_EVWIN, IN_EVQN, IN_EVKN, IN_EVWOUT, IN_ODWIN, IN_ODQLN, IN_ODKVLN, IN_ODWUQ, IN_ODWUKV, IN_ODQN, IN_ODKN, IN_ODWOUT };

struct Frame {
    LAS unsigned char* lds;
    int tid, lane, wave, vcu, G, wv;
    unsigned char* ws;
    __device__ __forceinline__ void refresh() { tid = opaque_tid(wv); lane = tid & 63; wave = __builtin_amdgcn_readfirstlane(tid >> 6); }
};

__device__ __forceinline__ void transpose_item(const float* W, int N, const float* kscale, bf16_t* Bt, int ldb, int k0, int n0, int brow0, LAS unsigned char* scr, int lane, int dl_perm = -1) {
    const int kq = lane >> 4, nq = lane & 15;
    f32x4 v[16];
#pragma unroll
    for (int i = 0; i < 16; ++i) { const int k = 8 * (i >> 1) + 2 * kq + (i & 1); v[i] = __builtin_nontemporal_load((const f32x4*)(W + (size_t)(k0 + k) * N + n0 + 4 * nq)); }
#pragma unroll
    for (int i = 0; i < 8; ++i) { const int k = 8 * i + 2 * kq; f32x4 a = v[2 * i], c = v[2 * i + 1];
        if (kscale) { const float s0 = kscale[k0 + k], s1 = kscale[k0 + k + 1]; a = a * s0; c = c * s1; }
#pragma unroll
        for (int j = 0; j < 4; ++j) *(LAS unsigned*)(scr + (4 * nq + j) * 144 + k * 2) = cvtpk(a[j], c[j]); }
    LDS_WAIT(); asm volatile("" ::: "memory");
#pragma unroll
    for (int jj = 0; jj < 8; ++jj) { const int n = (lane >> 3) + 8 * jj, c = lane & 7;
        const u32x4 w = *(const LAS u32x4*)(scr + n * 144 + c * 16);
        const int drow = dl_perm < 0 ? brow0 + n : (dl_perm == 2 ? brow0 + 8 * ((n & 31) >> 2) + (n & 3) + 4 * (n >> 5) : brow0 + 8 * (n >> 2) + (n & 3) + 4 * dl_perm);
        __builtin_nontemporal_store(w, (u32x4*)(Bt + (size_t)drow * ldb + k0 + 8 * c)); }
    LDS_WAIT(); asm volatile("" ::: "memory");
}

__device__ __forceinline__ void phase_prologue(Frame& F, CArgs& a) {
    F.refresh();
    const float* cvec = (const float*)a.in[IN_C];
    const float* adaw = (const float*)a.in[IN_ADAW]; const float* adab = (const float*)a.in[IN_ADAB];
    LAS float* sl = (LAS float*)F.lds;
    LAS float* red = (LAS float*)(F.lds + 32768);
    for (int i = F.tid; i < 2 * DM; i += NTHR) sl[i] = silu_f(cvec[i]);
    __syncthreads();
    float* MOD = (float*)(F.ws + WS_MOD);
    for (int item = F.vcu; item < DEPTH * 192; item += F.G) {
        const int l = item / 192, ct = item % 192, cq = F.tid & 15, ir = F.tid >> 4;
        const float* wp = adaw + ((size_t)l * DM + ir) * 12288 + ct * 64 + cq * 4;
        f32x4 a0 = {0.f, 0.f, 0.f, 0.f}, a1 = {0.f, 0.f, 0.f, 0.f};
#pragma unroll 8
        for (int k = 0; k < 128; ++k) { const f32x4 w = __builtin_nontemporal_load((const f32x4*)(wp + (size_t)(32 * k) * 12288)); const float s0 = sl[ir + 32 * k], s1 = sl[DM + ir + 32 * k]; a0 += w * s0; a1 += w * s1; }
#pragma unroll
        for (int j = 0; j < 4; ++j) { red[(ir * 64 + cq * 4 + j) * 2 + 0] = a0[j]; red[(ir * 64 + cq * 4 + j) * 2 + 1] = a1[j]; }
        __syncthreads();
        if (F.tid < 128) { const int col = F.tid & 63, bb = F.tid >> 6; float s = 0.f;
#pragma unroll 8
            for (int r = 0; r < 32; ++r) s += red[(r * 64 + col) * 2 + bb];
            MOD[(size_t)(l * 2 + bb) * 12288 + ct * 64 + col] = s + adab[l * 12288 + ct * 64 + col]; }
        __syncthreads();
    }
    LAS unsigned char* scr = F.lds + F.wave * 9216;
    const int gw = F.vcu * NWAVES + F.wave, NGW = F.G * NWAVES;
    constexpr int I_EVIN = (DM / 64) * (EVEN_IN / 64), I_EVOUT = (DM / 64) * (DM / 64), I_ODIN = (DM / 64) * (ODD_IN / 64), I_UQ = (QLORA / 64) * (UQ_N / 64), I_UKV = (KVLORA / 64) * (UKV_N / 64), I_ODOUT = I_EVOUT;
    constexpr int I_PER = I_EVIN + I_EVOUT + I_ODIN + I_UQ + I_UKV + I_ODOUT;
    for (int it = gw; it < 2 * I_PER; it += NGW) {
        const int i = it / I_PER; int r = it % I_PER;
        if (r < I_EVIN) { const int nb = EVEN_IN / 64, kb = r / nb, nn = r % nb;
            const int n0 = nn * 64; const bool dl = n0 >= EC_QDL && n0 < EC_VDL;
            transpose_item((const float*)a.in[IN_EVWIN] + (size_t)i * DM * EVEN_IN, EVEN_IN, nullptr, (bf16_t*)(F.ws + WS_WEVIN) + (size_t)i * EVEN_IN * DM, DM, kb * 64, n0, dl ? (n0 & ~127) : n0, scr, F.lane, dl ? ((n0 >> 6) & 1) : -1); continue; } r -= I_EVIN;
        if (r < I_EVOUT) { const int nb = DM / 64, kb = r / nb, nn = r % nb;
            transpose_item((const float*)a.in[IN_EVWOUT] + (size_t)i * DM * DM, DM, nullptr, (bf16_t*)(F.ws + WS_WEVOUT) + (size_t)i * DM * DM, DM, kb * 64, nn * 64, nn * 64, scr, F.lane); continue; } r -= I_EVOUT;
        if (r < I_ODIN) { const int nb = ODD_IN / 64, kb = r / nb, nn = r % nb; const int n0 = nn * 64;
            const int brow = n0 < 1536 ? n0 : (n0 < 1600 ? OC_KPE + (n0 - 1536) : n0 - 64);
            transpose_item((const float*)a.in[IN_ODWIN] + (size_t)i * DM * ODD_IN, ODD_IN, nullptr, (bf16_t*)(F.ws + WS_WODIN) + (size_t)i * ODD_INP * DM, DM, kb * 64, n0, brow, scr, F.lane, n0 == 1536 ? 2 : -1); continue; } r -= I_ODIN;
        if (r < I_UQ) { const int nb = UQ_N / 64, kb = r / nb, nn = r % nb;
            transpose_item((const float*)a.in[IN_ODWUQ] + (size_t)i * QLORA * UQ_N, UQ_N, (const float*)a.in[IN_ODQLN] + i * QLORA, (bf16_t*)(F.ws + WS_WUQ) + (size_t)i * UQ_N * QLORA, QLORA, kb * 64, nn * 64, nn * 64, scr, F.lane); continue; } r -= I_UQ;
        if (r < I_UKV) { const int nb = UKV_N / 64, kb = r / nb, nn = r % nb;
            transpose_item((const float*)a.in[IN_ODWUKV] + (size_t)i * KVLORA * UKV_N, UKV_N, (const float*)a.in[IN_ODKVLN] + i * KVLORA, (bf16_t*)(F.ws + WS_WUKV) + (size_t)i * UKV_N * KVLORA, KVLORA, kb * 64, nn * 64, nn * 64, scr, F.lane); continue; } r -= I_UKV;
        { const int nb = DM / 64, kb = r / nb, nn = r % nb;
            transpose_item((const float*)a.in[IN_ODWOUT] + (size_t)i * DM * DM, DM, nullptr, (bf16_t*)(F.ws + WS_WODOUT) + (size_t)i * DM * DM, DM, kb * 64, nn * 64, nn * 64, scr, F.lane); }
    }
    const size_t gt = (size_t)F.vcu * NTHR + F.tid, NGT = (size_t)F.G * NTHR;
    for (size_t i = gt; i < (size_t)2 * 192 * DM / 8; i += NGT) { const size_t li = i / (192 * DM / 8), rem = i % (192 * DM / 8);
        *(u32x4*)((bf16_t*)(F.ws + WS_WODIN) + li * (size_t)ODD_INP * DM + (size_t)ODD_IN * DM + rem * 8) = (u32x4){0u, 0u, 0u, 0u}; }
    const int* pos = (const int*)a.in[IN_POS];
    for (size_t i = gt; i < (size_t)MTOK * 96; i += NGT) { const int tok = (int)(i / 96), j = (int)(i % 96);
        const float p = (float)pos[tok];
        if (j < 64) { const float inv = (float)pow(10000.0, -(double)j / 64.0); const float ang = p * inv;
            ((float*)(F.ws + WS_COSF))[tok * 64 + j] = (float)cos((double)ang); ((float*)(F.ws + WS_SINF))[tok * 64 + j] = (float)sin((double)ang); }
        else { const int jj = j - 64; const float inv = (float)pow(10000.0, -(double)jj / 32.0); const float ang = p * inv;
            ((float*)(F.ws + WS_COSM))[tok * 32 + jj] = (float)cos((double)ang); ((float*)(F.ws + WS_SINM))[tok * 32 + jj] = (float)sin((double)ang); } }
}

__device__ __forceinline__ void phase_h(Frame& F, CArgs& a, int layer, const float* xsrc) {
    F.refresh();
    const float* MOD = (const float*)(F.ws + WS_MOD); const float* nw = (const float*)a.in[IN_NORMW] + layer * DM;
    bf16_t* H = (bf16_t*)(F.ws + WS_H);
    LAS float* Acol = (LAS float*)F.lds; LAS float* Scol = Acol + DM;
    int cur_b = -1;
    for (int rb = F.vcu; rb < MTOK / 32; rb += F.G) {
        const int bb = rb / (SEQ / 32);
        if (bb != cur_b) { __syncthreads();
            const float* mp = MOD + (size_t)(layer * 2 + bb) * 12288;
            for (int i = F.tid; i < DM; i += NTHR) { Acol[i] = nw[i] * (1.0f + mp[DM + i]); Scol[i] = mp[i]; }
            __syncthreads(); cur_b = bb; }
#pragma unroll 1
        for (int rr = 0; rr < 4; ++rr) { const int row = rb * 32 + F.wave * 4 + rr;
            if (xsrc) {
            const f32x4* xr = (const f32x4*)(xsrc + (size_t)row * DM) + F.lane;
            f32x4 v[16]; float s = 0.f;
#pragma unroll
            for (int j = 0; j < 16; ++j) { v[j] = __builtin_nontemporal_load(xr + 64 * j); s += (v[j][0] * v[j][0] + v[j][1] * v[j][1]) + (v[j][2] * v[j][2] + v[j][3] * v[j][3]); }
            const float rinv = __builtin_amdgcn_rsqf(wave_sum(s) * (1.0f / DM) + EPS);
            u32x2* o8 = (u32x2*)(H + (size_t)row * DM) + F.lane;
#pragma unroll
            for (int j = 0; j < 16; ++j) { const int c = 4 * F.lane + 256 * j; const f32x4 A = *(const LAS f32x4*)(Acol + c), Sh = *(const LAS f32x4*)(Scol + c);
                const f32x4 h = v[j] * rinv * A + Sh; u32x2 w; w.x = cvtpk(h[0], h[1]); w.y = cvtpk(h[2], h[3]); o8[64 * j] = w; }
            } else {
            const u32x4* xr = (const u32x4*)((const unsigned short*)(F.ws + WS_XH) + (size_t)row * DM) + F.lane;
            u32x4 r[8]; float s = 0.f;
#pragma unroll
            for (int j = 0; j < 8; ++j) r[j] = __builtin_nontemporal_load(xr + 64 * j);
#pragma unroll
            for (int j = 0; j < 8; ++j) { const float a0 = h_lo(r[j].x), a1 = h_hi(r[j].x), a2 = h_lo(r[j].y), a3 = h_hi(r[j].y), a4 = h_lo(r[j].z), a5 = h_hi(r[j].z), a6 = h_lo(r[j].w), a7 = h_hi(r[j].w);
                s += ((a0 * a0 + a1 * a1) + (a2 * a2 + a3 * a3)) + ((a4 * a4 + a5 * a5) + (a6 * a6 + a7 * a7)); }
            const float rinv = __builtin_amdgcn_rsqf(wave_sum(s) * (1.0f / DM) + EPS);
            u32x4* o16 = (u32x4*)(H + (size_t)row * DM) + F.lane;
#pragma unroll
            for (int j = 0; j < 8; ++j) { const int c = 8 * F.lane + 512 * j;
                const f32x4 A0 = *(const LAS f32x4*)(Acol + c), A1 = *(const LAS f32x4*)(Acol + c + 4), S0 = *(const LAS f32x4*)(Scol + c), S1 = *(const LAS f32x4*)(Scol + c + 4);
                const f32x4 x0 = {h_lo(r[j].x), h_hi(r[j].x), h_lo(r[j].y), h_hi(r[j].y)}, x1 = {h_lo(r[j].z), h_hi(r[j].z), h_lo(r[j].w), h_hi(r[j].w)};
                const f32x4 h0 = x0 * rinv * A0 + S0, h1 = x1 * rinv * A1 + S1; u32x4 w; w.x = cvtpk(h0[0], h0[1]); w.y = cvtpk(h0[2], h0[3]); w.z = cvtpk(h1[0], h1[1]); w.w = cvtpk(h1[2], h1[3]); o16[64 * j] = w; }
            }
        }
    }
    __syncthreads();
}

__device__ __forceinline__ void phase_attn_even(Frame& F) {
    asm volatile("" : "+s"(F.ws), "+s"(F.vcu));
    bf16_t* P = (bf16_t*)(F.ws + WS_PROJ); bf16_t* MX = (bf16_t*)(F.ws + WS_MIXED); bf16_t* ODL = (bf16_t*)(F.ws + WS_ODL); float* LSE = (float*)(F.ws + WS_LSE);
    for (int it = F.vcu; it < 256; it += F.G) { const int bh = it >> 3, x = it & 7, bb = bh >> 4, h = bh & 15;
        for (int pass = 0; pass < 2; ++pass) { const int qb = pass ? x : 15 - x;
            att::Blk k; const size_t t0 = (size_t)bb * SEQ + (size_t)qb * 256;
            k.Q = P + t0 * EVEN_LD + EC_QSB + h * 128;
            k.K = P + (size_t)bb * SEQ * EVEN_LD + EC_KSB + h * 128;
            k.V = P + (size_t)bb * SEQ * EVEN_LD + EC_VSB + h * 128;
            k.O = MX + t0 * DM + h * 128;
            k.G = P + t0 * EVEN_LD + EC_GSB + h * 128;
            k.LSE = nullptr; k.P0 = qb * 256; k.dil = 1; k.ssq = nullptr; k.qw = nullptr; k.cs = nullptr; k.sn = nullptr;
            att::attn_block<2>(k, F.lds, F.wv); } }
    for (int it = F.vcu; it < 256; it += F.G) { const int bh = it >> 3, kr = it & 7, bb = bh >> 4, h = bh & 15;
#pragma unroll 1
        for (int i = 0; i < 6; ++i) { const int sg = F.wv + 8 * i, pat = sg >> 4, j = sg & 15;
            const int dil = pat == 0 ? 1 : (pat == 1 ? 4 : 16); const int r = pat == 0 ? 0 : (pat == 1 ? (j >> 2) : j);
            const int P0 = pat == 0 ? 512 * kr + 32 * j : (pat == 1 ? 128 * kr + 32 * (j & 3) : 32 * kr);
            att::Blk k; const size_t tb = (size_t)bb * SEQ + r, t0 = tb + (size_t)P0 * dil;
            k.Q = P + t0 * EVEN_LD + EC_QDL + h * 128;
            k.K = P + tb * EVEN_LD + EC_KDL + h * 128;
            k.V = P + tb * EVEN_LD + EC_VDL + h * 128;
            k.O = ODL + (size_t)pat * MTOK * 2048 + t0 * 2048 + h * 128;
            k.G = nullptr;
            k.LSE = LSE + (size_t)pat * MTOK * 16 + t0 * 16 + h;  k.P0 = P0; k.dil = dil; k.ssq = nullptr; k.qw = nullptr; k.cs = nullptr; k.sn = nullptr;
            att::attn_dil_wave(k, F.lds, F.lds + XCH_OFF, F.wv); }
        asm volatile("s_waitcnt vmcnt(0)" ::: "memory");
        __syncthreads();
        F.refresh();
        const size_t tokb = (size_t)bb * SEQ + (size_t)kr * 512;
#pragma unroll 1
        for (int u0 = 0; u0 < 16; u0 += 2) {
            u32x4 r0[2], r1[2], r2[2], rg[2]; float l0[2], l1[2], l2[2]; size_t oo[2];
#pragma unroll
            for (int u = 0; u < 2; ++u) { const int idx = F.tid + NTHR * (u0 + u), c = idx & 15; const size_t tok = tokb + (idx >> 4);
                l0[u] = LSE[tok * 16 + h]; l1[u] = LSE[(size_t)MTOK * 16 + tok * 16 + h]; l2[u] = LSE[(size_t)2 * MTOK * 16 + tok * 16 + h];
                r0[u] = *(const u32x4*)(ODL + tok * 2048 + h * 128 + c * 8);
                r1[u] = *(const u32x4*)(ODL + (size_t)MTOK * 2048 + tok * 2048 + h * 128 + c * 8);
                r2[u] = *(const u32x4*)(ODL + (size_t)2 * MTOK * 2048 + tok * 2048 + h * 128 + c * 8);
                rg[u] = __builtin_nontemporal_load((const u32x4*)(P + tok * EVEN_LD + EC_GDL + h * 128 + c * 8));
                oo[u] = tok * DM + 2048 + h * 128 + c * 8; }
#pragma unroll
            for (int u = 0; u < 2; ++u) {
                const float mx = fmaxf(l0[u], fmaxf(l1[u], l2[u]));
                float w0 = __builtin_amdgcn_exp2f(l0[u] - mx), w1 = __builtin_amdgcn_exp2f(l1[u] - mx), w2 = __builtin_amdgcn_exp2f(l2[u] - mx);
                const float inv = 1.0f / (w0 + w1 + w2); w0 *= inv; w1 *= inv; w2 *= inv;
                float x0[8], x1[8], x2[8], g[8], o[8];
                unpack8(r0[u], x0); unpack8(r1[u], x1); unpack8(r2[u], x2); unpack8(rg[u], g);
#pragma unroll
                for (int e = 0; e < 8; ++e) o[e] = (w0 * x0[e] + w1 * x1[e] + w2 * x2[e]) * g[e];
                *(u32x4*)(MX + oo[u]) = pack8u(o);
            }
        }
        __syncthreads();
    }
}
__device__ __forceinline__ void phase_attn_mla(Frame& F, CArgs& a, int lp) {
    asm volatile("" : "+s"(F.ws), "+s"(F.vcu));
    const bf16_t* QR = (const bf16_t*)(F.ws + WS_QRAW); const bf16_t* KF = (const bf16_t*)(F.ws + WS_KF); const bf16_t* VF = (const bf16_t*)(F.ws + WS_VF);
    const bf16_t* P2 = (const bf16_t*)(F.ws + WS_PROJ); bf16_t* MX = (bf16_t*)(F.ws + WS_MIXED);
    const float* ssq = (const float*)(F.ws + WS_CTL + CTL_SSQCQ) + (size_t)lp * MTOK;
    for (int it = F.vcu; it < 512; it += F.G) { const int bh = it >> 3, x = it & 7, bb = bh >> 5, h = bh & 31;
        for (int pass = 0; pass < 2; ++pass) { const int qb = pass ? x : 15 - x;
            att::Blk k; const size_t t0 = (size_t)bb * SEQ + (size_t)qb * 256;
            k.Q = QR + t0 * UQ_N + h * 192;
            k.K = KF + (size_t)bh * SEQ * 192;
            k.V = VF + (size_t)bh * SEQ * 128;
            k.O = MX + t0 * DM + h * 128;
            k.G = P2 + t0 * ODD_INP + OC_G + h * 128;
            k.LSE = nullptr; k.P0 = qb * 256; k.dil = 1;
            k.ssq = ssq + t0; k.qw = (const float*)a.in[IN_ODQN] + lp * 192; k.cs = (const float*)(F.ws + WS_COSM) + t0 * 32; k.sn = (const float*)(F.ws + WS_SINM) + t0 * 32;
            att::attn_block<0>(k, F.lds, F.wv); } }
}

__device__ __forceinline__ void gemm_even_in(Frame& F, CArgs& a, int lp) {
    pg8::Gemm g{(const bf16_t*)(F.ws + WS_H), (const bf16_t*)(F.ws + WS_WEVIN) + (size_t)lp * EVEN_IN * DM, MTOK, EVEN_IN, DM, DM, DM};
    pg8::StaticOrder S; S.init(MTOK, EVEN_IN, F.G, (int)blockIdx.x);
    pg8::EpiEvenIn E{(bf16_t*)(F.ws + WS_PROJ), (const float*)a.in[IN_EVQN] + lp * 128, (const float*)a.in[IN_EVKN] + lp * 128,
                     (const float*)(F.ws + WS_COSF), (const float*)(F.ws + WS_SINF), F.lds + XCH_OFF};
    pg8::gemm_phase<pg8::EpiEvenIn, pg8::StaticOrder>(F.lds, g, S, E, F.wv);
}
__device__ __forceinline__ void gemm_odd_in(Frame& F, CArgs& a, int lp) {
    pg8::Gemm g{(const bf16_t*)(F.ws + WS_H), (const bf16_t*)(F.ws + WS_WODIN) + (size_t)lp * ODD_INP * DM, MTOK, ODD_INP, DM, DM, DM};
    pg8::StaticOrder S; S.init(MTOK, ODD_INP, F.G, (int)blockIdx.x);
    pg8::EpiBf16Op E{(bf16_t*)(F.ws + WS_PROJ), ODD_INP, 2, (const float*)a.in[IN_ODKN] + lp * 192, (const float*)(F.ws + WS_COSM), (const float*)(F.ws + WS_SINM), (float*)(F.ws + WS_CTL + CTL_SSQCQ) + (size_t)lp * MTOK, (float*)(F.ws + WS_CTL + CTL_SSQKV) + (size_t)lp * 2 * MTOK, (float*)(F.ws + WS_CTL + CTL_SSQKV) + (size_t)lp * 2 * MTOK + 1};
    pg8::gemm_phase<pg8::EpiBf16Op, pg8::StaticOrder>(F.lds, g, S, E, F.wv);
}
__device__ __forceinline__ void gemm_odd_up(Frame& F, CArgs& a, int lp) {
    { pg8::Gemm g{(const bf16_t*)(F.ws + WS_PROJ) + OC_CQ, (const bf16_t*)(F.ws + WS_WUQ) + (size_t)lp * UQ_N * QLORA, MTOK, UQ_N, QLORA, ODD_INP, QLORA};
      pg8::StaticOrder S; S.init(MTOK, UQ_N, F.G, (int)blockIdx.x);
      pg8::EpiBf16Op E{(bf16_t*)(F.ws + WS_QRAW), UQ_N, 0, nullptr, nullptr, nullptr, nullptr, nullptr, nullptr};
      pg8::gemm_phase<pg8::EpiBf16Op, pg8::StaticOrder>(F.lds, g, S, E, F.wv); }
    { pg8::Gemm g{(const bf16_t*)(F.ws + WS_PROJ) + OC_CKV, (const bf16_t*)(F.ws + WS_WUKV) + (size_t)lp * UKV_N * KVLORA, MTOK, UKV_N, KVLORA, ODD_INP, KVLORA};
      pg8::StaticOrder S; S.init(MTOK, UKV_N, F.G, (int)blockIdx.x);
      pg8::EpiKV E{(bf16_t*)(F.ws + WS_KF), (bf16_t*)(F.ws + WS_VF), (const bf16_t*)(F.ws + WS_PROJ), (const float*)(F.ws + WS_CTL + CTL_SSQKV) + (size_t)lp * 2 * MTOK, nullptr,
                   (const float*)a.in[IN_ODKN] + lp * 192, (const float*)(F.ws + WS_COSM), (const float*)(F.ws + WS_SINM), F.lds + XCH_OFF};
      pg8::gemm_phase<pg8::EpiKV, pg8::StaticOrder>(F.lds, g, S, E, F.wv); }
}
__device__ __forceinline__ void gemm_out(Frame& F, const bf16_t* Wt, const float* xs32, float* xo32, const float* gate) {
    unsigned short* XH = (unsigned short*)(F.ws + WS_XH);
    pg8::Gemm g{(const bf16_t*)(F.ws + WS_MIXED), Wt, MTOK, DM, DM, DM, DM};
    pg8::StaticOrder S; S.init(MTOK, DM, F.G, (int)blockIdx.x);
    pg8::EpiResid E{xs32, xs32 ? nullptr : XH, xo32, xo32 ? nullptr : XH, gate};
    pg8::gemm_phase<pg8::EpiResid, pg8::StaticOrder>(F.lds, g, S, E, F.wv);
}

constexpr int N_PHASES = 25;
#ifndef REPEAT_MASK
#define REPEAT_MASK 0
#endif
#define REP(idx) ((REPEAT_MASK >> (idx)) & 1)
__global__ void __launch_bounds__(NTHR, 2) mega_fwd(Args args) {
    extern __shared__ __attribute__((aligned(16))) unsigned char lds_raw[];
    Frame F;
    F.lds = (LAS unsigned char*)lds_raw;
    F.tid = threadIdx.x; F.lane = F.tid & 63; F.wave = __builtin_amdgcn_readfirstlane(F.tid >> 6); F.wv = F.wave;
    F.G = gridDim.x; { const int bx = blockIdx.x; F.vcu = (F.G % 8 == 0) ? (bx % 8) * (F.G / 8) + bx / 8 : bx; }
    F.ws = args.ws;
    for (int u = F.tid; u < (LDS_BYTES - LDSCTL_OFF) / 4; u += NTHR) ((LAS unsigned*)(F.lds + LDSCTL_OFF))[u] = 0u;
    __syncthreads();
    const int lo = args.ph_lo, hi = args.ph_hi;
    XcdBarrier bar; bar.bar = (unsigned*)(F.ws + WS_CTL) + CW_BAR; bar.x = 0; bar.st = nullptr; bar.wv = F.wv;
    if (hi - lo > 1) bar = xcd_barrier_post((unsigned*)(F.ws + WS_CTL) + CW_BAR, (volatile LAS unsigned*)(F.lds + MISC_OFF) + 8, F.wv);
#define IN(k) (lo <= (k) && (k) < hi)
#define SEAM(k) do { if (IN(k) && IN((k) + 1)) xcd_barrier(bar); } while (0)
    const float* xin = (const float*)args.in[IN_X];
    float* xout = args.out;
    const float* MOD = (const float*)(F.ws + WS_MOD);

#define KA (*kargs())
#define RUN(k, idx, BODY) do { if (IN(k)) { BODY; if (REP(idx)) { xcd_barrier(bar); BODY; } } SEAM(k); } while (0)
    RUN(0, 0, phase_prologue(F, KA));

    for (int lp = 0; lp < 2; ++lp) {
        const int base = 1 + 12 * lp;
        { const int layer = 2 * lp; const float* xs = (layer == 0) ? xin : nullptr;
        RUN(base + 0, 1, phase_h(F, KA, layer, xs));
        RUN(base + 1, 2, gemm_even_in(F, KA, lp));
        RUN(base + 3, 4, phase_attn_even(F));
        RUN(base + 5, 6, gemm_out(F, (const bf16_t*)(F.ws + WS_WEVOUT) + (size_t)lp * DM * DM, xs, nullptr, MOD + (size_t)(layer * 2) * 12288 + 2 * DM));
        }
        { const int layer = 2 * lp + 1;
        RUN(base + 6, 7, phase_h(F, KA, layer, nullptr));
        RUN(base + 7, 8, gemm_odd_in(F, KA, lp));
        RUN(base + 8, 9, gemm_odd_up(F, KA, lp));
        RUN(base + 10, 11, phase_attn_mla(F, KA, lp));
        RUN(base + 11, 12, gemm_out(F, (const bf16_t*)(F.ws + WS_WODOUT) + (size_t)lp * DM * DM, nullptr, (lp == 1) ? xout : nullptr, MOD + (size_t)(layer * 2) * 12288 + 2 * DM));
        }
    }
#undef RUN
#undef KA
#undef IN
#undef SEAM
}

extern "C" void kernel_launch(void* const* d_in, const int* in_sizes, int n_in, void* d_out, int out_size, void* d_ws, size_t ws_size, hipStream_t stream) {
    static int grid = 0;
    if (grid == 0) {
        if (n_in != 18 || out_size != MTOK * DM || ws_size < WS_END) { fprintf(stderr, "kernel_launch: unexpected shapes (n_in %d, out %d, ws %zu); nothing launched\n", n_in, out_size, ws_size); grid = -1; return; }
        int dev = 0, cus = 0, per_cu = 0;
        if (hipGetDevice(&dev) != hipSuccess || hipDeviceGetAttribute(&cus, hipDeviceAttributeMultiprocessorCount, dev) != hipSuccess) { grid = -1; return; }
        if (hipFuncSetAttribute((const void*)mega_fwd, hipFuncAttributeMaxDynamicSharedMemorySize, LDS_BYTES) != hipSuccess) { fprintf(stderr, "kernel_launch: hipFuncSetAttribute failed\n"); grid = -1; return; }
        if (hipOccupancyMaxActiveBlocksPerMultiprocessor(&per_cu, (const void*)mega_fwd, NTHR, LDS_BYTES) != hipSuccess || per_cu < 1)
            fprintf(stderr, "kernel_launch: note: occupancy query reports %d workgroups per CU\n", per_cu);
        (void)hipGetLastError();
        grid = cus;
    }
    if (grid < 0) return;
    if (hipMemsetAsync((char*)d_ws + WS_CTL, 0, CTL_ZERO_BYTES, stream) != hipSuccess) { fprintf(stderr, "kernel_launch: memset failed\n"); return; }
    Args a{};
    for (int i = 0; i < 18; ++i) a.in[i] = d_in[i];
    a.out = (float*)d_out; a.ws = (unsigned char*)d_ws;
#if MK_N_LAUNCHES == 1
    a.ph_lo = 0; a.ph_hi = N_PHASES;
    hipLaunchKernelGGL(mega_fwd, dim3(grid), dim3(NTHR), LDS_BYTES, stream, a);
#else
    for (int k = 0; k < N_PHASES; ++k) { a.ph_lo = k; a.ph_hi = k + 1; hipLaunchKernelGGL(mega_fwd, dim3(grid), dim3(NTHR), LDS_BYTES, stream, a); }
#endif
}
```

```cpp
#include <hip/hip_runtime.h>
#include <cstdio>
#include <cstdint>

#ifndef MK_N_LAUNCHES
#define MK_N_LAUNCHES 1
#endif

#define LAS __attribute__((address_space(3)))
#define GAS __attribute__((address_space(1)))
typedef unsigned short bf16_t;
typedef short bf16x8 __attribute__((ext_vector_type(8)));
typedef short s16x4 __attribute__((ext_vector_type(4)));
typedef float f32x2 __attribute__((ext_vector_type(2)));
typedef float f32x4 __attribute__((ext_vector_type(4)));
typedef float f32x16 __attribute__((ext_vector_type(16)));
typedef unsigned u32x2 __attribute__((ext_vector_type(2)));
typedef unsigned u32x4 __attribute__((ext_vector_type(4)));
typedef __bf16 hbf16x2 __attribute__((ext_vector_type(2)));

constexpr int NB = 2, SEQ = 4096, DM = 4096, MTOK = NB * SEQ, DEPTH = 4;
constexpr int EVEN_IN = 16384, ODD_IN = 5696, ODD_INP = 5888;
constexpr int EVEN_LD = EVEN_IN + 2176;
constexpr int QLORA = 1024, KVLORA = 512, NH_MLA = 32, NH_SB = 16, NH_DL = 16;
constexpr int UQ_N = 6144, UKV_N = 8192;
constexpr float EPS = 1e-6f;
constexpr float LOG2E = 1.4426950408889634f;
constexpr float QS128 = 1.4426950408889634f * 0.08838834764831845f;
constexpr float QS192 = 1.4426950408889634f * 0.07216878364870322f;
constexpr int EC_QSB = 0, EC_KSB = 2048, EC_VSB = 4096, EC_GSB = 6144, EC_QDL = 8192, EC_KDL = 10240, EC_VDL = 12288, EC_GDL = 14336;
constexpr int OC_CQ = 0, OC_CKV = 1024, OC_G = 1536, OC_KPE = 5632;

constexpr int RING_BYTES_C = 131072;
constexpr size_t MiB = 1u << 20;
constexpr size_t WS_CTL = 0, CTL_ZERO_BYTES = 1 * MiB;
constexpr size_t WS_MOD = 1 * MiB;
constexpr size_t WS_COSF = 2 * MiB, WS_SINF = 4 * MiB;
constexpr size_t WS_COSM = 6 * MiB, WS_SINM = 7 * MiB;
constexpr size_t WS_DIAG = 8 * MiB;
constexpr size_t WS_WEVIN = 16 * MiB;
constexpr size_t WS_WEVOUT = 272 * MiB;
constexpr size_t WS_WODIN = 336 * MiB;
constexpr size_t WS_WUQ = 428 * MiB;
constexpr size_t WS_WUKV = 452 * MiB;
constexpr size_t WS_WODOUT = 468 * MiB;
constexpr size_t WS_H = 544 * MiB;
constexpr size_t WS_PROJ = 1506 * MiB;
constexpr size_t WS_MIXED = 864 * MiB;
constexpr size_t WS_ODL = 928 * MiB;
constexpr size_t WS_LSE = 1024 * MiB;
constexpr size_t WS_QRAW = 1026 * MiB;
constexpr size_t WS_KVRAW = 1122 * MiB;
constexpr size_t WS_XH = 1122 * MiB;
constexpr size_t WS_QF = 1250 * MiB;
constexpr size_t WS_KF = 1346 * MiB;
constexpr size_t WS_VF = 1442 * MiB;
constexpr size_t WS_END = 1800 * MiB;
constexpr int CW_BAR = 4096;
constexpr size_t CTL_SSQCQ = 524288, CTL_SSQKV = CTL_SSQCQ + 2 * MTOK * 4;
static_assert(CTL_SSQKV + 4 * MTOK * 4 <= CTL_ZERO_BYTES, "CTL map");
constexpr int XCH_OFF = RING_BYTES_C + 1024;

constexpr int RING_BYTES = 131072;
constexpr int LDSCTL_OFF = RING_BYTES, MISC_OFF = LDSCTL_OFF + 320;
constexpr int LDS_BYTES = 147456;
constexpr int NWAVES = 8, NTHR = 512;

__device__ __forceinline__ unsigned cvtpk(float lo, float hi) { f32x2 v = {lo, hi}; hbf16x2 b = __builtin_convertvector(v, hbf16x2); return __builtin_bit_cast(unsigned, b); }
typedef _Float16 hf16x2 __attribute__((ext_vector_type(2)));
__device__ __forceinline__ unsigned pkh(float lo, float hi) { hf16x2 h; h.x = (_Float16)lo; h.y = (_Float16)hi; return __builtin_bit_cast(unsigned, h); }
__device__ __forceinline__ float h_lo(unsigned w) { return (float)__builtin_bit_cast(hf16x2, w).x; }
__device__ __forceinline__ float h_hi(unsigned w) { return (float)__builtin_bit_cast(hf16x2, w).y; }
__device__ __forceinline__ float bf_lo(unsigned w) { return __uint_as_float(w << 16); }
__device__ __forceinline__ float bf_hi(unsigned w) { return __uint_as_float(w & 0xffff0000u); }
__device__ __forceinline__ float bf2f(bf16_t b) { return __uint_as_float(((unsigned)b) << 16); }
__device__ __forceinline__ void unpack8(u32x4 w, float (&x)[8]) { x[0] = bf_lo(w.x); x[1] = bf_hi(w.x); x[2] = bf_lo(w.y); x[3] = bf_hi(w.y); x[4] = bf_lo(w.z); x[5] = bf_hi(w.z); x[6] = bf_lo(w.w); x[7] = bf_hi(w.w); }
__device__ __forceinline__ u32x4 pack8u(const float (&x)[8]) { u32x4 w; w.x = cvtpk(x[0], x[1]); w.y = cvtpk(x[2], x[3]); w.z = cvtpk(x[4], x[5]); w.w = cvtpk(x[6], x[7]); return w; }
__device__ __forceinline__ int lane_fresh() { int l; asm volatile("v_mbcnt_lo_u32_b32 %0, -1, 0\n\tv_mbcnt_hi_u32_b32 %0, -1, %0" : "=v"(l)); return l; }
__device__ __forceinline__ float sum16(float v) { auto r = __builtin_amdgcn_permlane16_swap(__float_as_uint(v), __float_as_uint(v), false, false); return __uint_as_float(r[0]) + __uint_as_float(r[1]); }
__device__ __forceinline__ float sum32(float v) { auto r = __builtin_amdgcn_permlane32_swap(__float_as_uint(v), __float_as_uint(v), false, false); return __uint_as_float(r[0]) + __uint_as_float(r[1]); }
__device__ __forceinline__ float dpp_xor1(float v) { return __int_as_float(__builtin_amdgcn_update_dpp(0, __float_as_int(v), 0xB1  , 0xF, 0xF, true)); }
__device__ __forceinline__ float wave_sum(float v) {
    v += __int_as_float(__builtin_amdgcn_update_dpp(0, __float_as_int(v), 0xB1, 0xF, 0xF, true));
    v += __int_as_float(__builtin_amdgcn_update_dpp(0, __float_as_int(v), 0x4E, 0xF, 0xF, true));
    v += __int_as_float(__builtin_amdgcn_update_dpp(0, __float_as_int(v), 0x124, 0xF, 0xF, true));
    v += __int_as_float(__builtin_amdgcn_update_dpp(0, __float_as_int(v), 0x128, 0xF, 0xF, true));
    v = sum16(v); v = sum32(v);
    return v;
}
__device__ __forceinline__ float silu_f(float v) { return v * __builtin_amdgcn_rcpf(1.0f + __builtin_amdgcn_exp2f(-v * LOG2E)); }
__device__ __forceinline__ int opaque_tid(int wv) { int t = wv * 64 + lane_fresh(); asm volatile("" : "+v"(t)); return t; }
#define GP(T, p) ((__attribute__((address_space(1))) T*)(p))
#define LDS_WAIT() asm volatile("s_waitcnt lgkmcnt(0)" ::: "memory")
#define VM_WAIT() asm volatile("s_waitcnt vmcnt(0)" ::: "memory")
#define SBAR() __builtin_amdgcn_sched_barrier(0)

namespace pg8 {
constexpr int BM = 256, BK = 64, HALF = 128, HTB = HALF * BK * 2, STAGE_BYTES = 8 * HTB, NXCD = 8, WGM = 8;
__host__ __device__ __forceinline__ int lds_byte(int r, int c) { const int st = (r >> 4) * 2 + (c >> 5), rr = r & 15, cc = c & 31, ob = rr * 64 + cc * 2; return st * 1024 + (ob ^ (((ob >> 9) & 1) << 5)); }
__host__ __device__ __forceinline__ void stage_rc(int b, int& R, int& C) { const int st = b / 1024, sb = b % 1024, swz = sb ^ (((sb >> 9) & 1) << 5); R = (st >> 1) * 16 + swz / 64; C = (st & 1) * 32 + (swz % 64) / 2; }
__host__ __device__ __forceinline__ int perm32(int rho) { const int n = rho >> 4, i = rho & 15; return 8 * (i >> 2) + 4 * n + (i & 3); }
struct Unit { int pm, pn; };
struct Gemm { const bf16_t* A; const bf16_t* Bt; int M, N, K, lda, ldb; };
struct StaticOrder {
    int nM, nN, nwg, G, c;
    __host__ __device__ void init(int M, int N, int G_, int c_) { nM = M / BM; nN = N / BM; nwg = nM * nN; G = G_; c = c_; }
    __host__ __device__ bool next(int i, Unit& u) const {
        const int L = i * G + c; if (L >= nwg) return false;
        int wgid = L; { const int q = nwg / NXCD, r = nwg % NXCD, xcd = wgid % NXCD, off = wgid / NXCD; wgid = (xcd < r ? xcd * (q + 1) : r * (q + 1) + (xcd - r) * q) + off; }
        const int nig = WGM * nN, gid = wgid / nig, fm = gid * WGM, gsz = (nM - fm) < WGM ? (nM - fm) : WGM;
        u.pm = fm + ((wgid % nig) % gsz); u.pn = (wgid % nig) / gsz; return true;
    }
    __device__ __forceinline__ void a_ready(const Unit&) const {}
    __device__ __forceinline__ void done(const Unit&) const {}
};
struct EpiBf16Op {
    static constexpr bool PERM = true;
    bf16_t* O; int ldc;
    int kind;
    const float* knw; const float* cosM; const float* sinM;
    float* ssq_q; float* ssq_kv; float* ssq_pe;
    __device__ __forceinline__ void operator()(const f32x4 (&acc)[2][2][4][2], const Unit& u, int wr, int wc, int fr, int fq) const {
        const int row0 = u.pm * BM + wr * 64 + fr, col0 = u.pn * BM + wc * 32 + 8 * fq;
        float sc = 1.f; bool act = false;
        if (kind == 1) { const int seg = u.pn >> 3; if (seg == 0) sc = QS128; act = (seg == 3) || (seg == 7); }
        else if (kind == 2) { act = (u.pn >= 6) && (u.pn < 22); }
#pragma unroll
        for (int ai = 0; ai < 2; ++ai)
#pragma unroll
            for (int m = 0; m < 4; ++m) { bf16_t* rowp = O + (size_t)(row0 + ai * HALF + m * 16) * ldc + col0;
#pragma unroll
                for (int bj = 0; bj < 2; ++bj) { f32x4 v0 = acc[ai][bj][m][0] * sc, v1 = acc[ai][bj][m][1] * sc;
                    if (kind == 2 && u.pn == 22 && bj == 0 && wc < 2) { const int i4 = 4 * (4 * wc + fq); const size_t row = (size_t)(row0 + ai * HALF + m * 16);
                        const f32x4 w1 = *(const f32x4*)(knw + 128 + i4), w2 = *(const f32x4*)(knw + 160 + i4);
                        const f32x4 c = *(const f32x4*)(cosM + row * 32 + i4), sn = *(const f32x4*)(sinM + row * 32 + i4);
                        const f32x4 x1 = v0 * w1, x2 = v1 * w2; v0 = x1 * c - x2 * sn; v1 = x2 * c + x1 * sn; }
                    if (act) {
#pragma unroll
                        for (int j = 0; j < 4; ++j) { v0[j] = silu_f(v0[j]); v1[j] = silu_f(v1[j]); } }
                    u32x4 w; w.x = cvtpk(v0[0], v0[1]); w.y = cvtpk(v0[2], v0[3]); w.z = cvtpk(v1[0], v1[1]); w.w = cvtpk(v1[2], v1[3]);
                    *(u32x4*)(rowp + bj * HALF) = w; }
                if (kind == 2 && u.pn < 6) { float sq = 0.f;
#pragma unroll
                    for (int bj = 0; bj < 2; ++bj)
#pragma unroll
                        for (int n = 0; n < 2; ++n) { const f32x4 x = acc[ai][bj][m][n]; sq += (x[0] * x[0] + x[1] * x[1]) + (x[2] * x[2] + x[3] * x[3]); }
                    sq = sum16(sq); sq = sum32(sq);
                    if (fq == 0) { if (u.pn < 4) atomicAdd(ssq_q + row0 + ai * HALF + m * 16, sq); else atomicAdd(ssq_kv + 2 * (row0 + ai * HALF + m * 16), sq); } }
                if (kind == 2 && u.pn == 22 && wc < 2) { float sq = 0.f;
#pragma unroll
                    for (int n = 0; n < 2; ++n) { const f32x4 x = acc[ai][0][m][n]; sq += (x[0] * x[0] + x[1] * x[1]) + (x[2] * x[2] + x[3] * x[3]); }
                    sq = sum16(sq); sq = sum32(sq);
                    if (fq == 0) atomicAdd(ssq_pe + 2 * (row0 + ai * HALF + m * 16), sq); } }
    }
};
struct EpiKV {
    static constexpr bool PERM = true;
    bf16_t* KF; bf16_t* VF;
    const bf16_t* P2;
    const float* ssqkv;
    const float* ssqpe;
    const float* knw;
    const float* cosM; const float* sinM;
    LAS unsigned char* xl;
    __device__ __forceinline__ void operator()(const f32x4 (&acc)[2][2][4][2], const Unit& u, int wr, int wc, int fr, int fq) const {
        asm volatile("" : "+v"(fr), "+v"(fq));
        const int rl0 = wr * 64 + fr, q4 = 4 * (4 * wc + fq); const bool ropel = wc < 2;
        LAS f32x2* X = (LAS f32x2*)xl;
        float sq8[8], pe8[8];
#pragma unroll
        for (int rr = 0; rr < 8; ++rr) { const size_t row = (size_t)u.pm * BM + rl0 + (rr >> 2) * HALF + (rr & 3) * 16; const f32x2 t2 = *(const f32x2*)(ssqkv + 2 * row); sq8[rr] = t2[0]; pe8[rr] = t2[1]; }
#pragma unroll
        for (int ai = 0; ai < 2; ++ai)
#pragma unroll
            for (int m = 0; m < 4; ++m) { const int rloc = rl0 + ai * HALF + m * 16;
                float pn = 0.f;
#pragma unroll
                for (int n = 0; n < 2; ++n) { const f32x4 x = acc[ai][0][m][n]; pn += (x[0] * x[0] + x[1] * x[1]) + (x[2] * x[2] + x[3] * x[3]); }
                pn = sum16(pn); pn = sum32(pn);
                if (fq == 0) X[rloc * 4 + wc] = (f32x2){pn, 0.f}; }
        asm volatile("s_waitcnt lgkmcnt(0)" ::: "memory"); __builtin_amdgcn_s_barrier(); asm volatile("" ::: "memory");
        const int bh = (u.pm >> 4) * NH_MLA + u.pn;
        const f32x4 wka = *(const f32x4*)(knw + wc * 32 + fq * 8), wkb = *(const f32x4*)(knw + wc * 32 + fq * 8 + 4);
        float rk8[8];
        u32x4 R8[8];
#pragma unroll
        for (int ai = 0; ai < 2; ++ai)
#pragma unroll
            for (int m = 0; m < 4; ++m) { const int rloc = rl0 + ai * HALF + m * 16; const size_t row = (size_t)u.pm * BM + rloc; const int srow = (int)(row & (SEQ - 1));
                const f32x4 xa = *(const LAS f32x4*)(X + rloc * 4), xb = *(const LAS f32x4*)(X + rloc * 4 + 2);
                const float ssn = (xa[0] + xa[2]) + (xb[0] + xb[2]), spe = pe8[ai * 4 + m];
                const float rkv = __builtin_amdgcn_rsqf(sq8[ai * 4 + m] * (1.0f / KVLORA) + EPS);
                const float rk = __builtin_amdgcn_rsqf((rkv * rkv * ssn + spe) * (1.0f / 192.0f) + EPS), sk = rkv * rk;
                rk8[ai * 4 + m] = rk;
                const size_t trow = (size_t)bh * SEQ + srow;
                { const f32x4 b0 = acc[ai][0][m][0] * wka * sk, b1 = acc[ai][0][m][1] * wkb * sk; u32x4 w;
                  w.x = cvtpk(b0[0], b0[1]); w.y = cvtpk(b0[2], b0[3]); w.z = cvtpk(b1[0], b1[1]); w.w = cvtpk(b1[2], b1[3]);
                  *(u32x4*)(KF + trow * 192 + wc * 32 + fq * 8) = w; }
                { const f32x4 a0 = acc[ai][1][m][0] * rkv, a1 = acc[ai][1][m][1] * rkv; u32x4 w;
                  w.x = cvtpk(a0[0], a0[1]); w.y = cvtpk(a0[2], a0[3]); w.z = cvtpk(a1[0], a1[1]); w.w = cvtpk(a1[2], a1[3]);
                  *(u32x4*)(VF + trow * 128 + wc * 32 + fq * 8) = w; }
                if (ropel) R8[ai * 4 + m] = *(const u32x4*)(P2 + row * ODD_INP + OC_KPE + wc * 32 + fq * 8); }
        asm volatile("" ::: "memory");
        if (ropel) {
#pragma unroll
            for (int rr = 0; rr < 8; ++rr) { const size_t row = (size_t)u.pm * BM + rl0 + (rr >> 2) * HALF + (rr & 3) * 16; const int srow = (int)(row & (SEQ - 1));
                const float rk = rk8[rr]; const size_t trow = (size_t)bh * SEQ + srow;
                float x[8]; unpack8(R8[rr], x);
                u32x2 o1, o2;
                o1.x = cvtpk(x[0] * rk, x[1] * rk); o1.y = cvtpk(x[2] * rk, x[3] * rk); o2.x = cvtpk(x[4] * rk, x[5] * rk); o2.y = cvtpk(x[6] * rk, x[7] * rk);
                *(u32x2*)(KF + trow * 192 + 128 + q4) = o1; *(u32x2*)(KF + trow * 192 + 160 + q4) = o2; }
        }
    }
};
struct EpiEvenIn {
    static constexpr bool PERM = true;
    bf16_t* O;
    const float* qn; const float* kn;
    const float* cosF; const float* sinF;
    LAS unsigned char* xl;
    __device__ __forceinline__ void operator()(const f32x4 (&acc)[2][2][4][2], const Unit& u, int wr, int wc, int fr, int fq) const {
        asm volatile("" : "+v"(fr), "+v"(fq));
        const int row0 = u.pm * BM + wr * 64 + fr, col0 = u.pn * BM + wc * 32 + 8 * fq;
        const int seg = u.pn >> 3;
        if (seg == 4 || seg == 5) {
            const int rl0 = wr * 64 + fr, i4 = 4 * (4 * wc + fq);
            LAS float* X = (LAS float*)xl;
#pragma unroll
            for (int ai = 0; ai < 2; ++ai)
#pragma unroll
                for (int m = 0; m < 4; ++m) { const int rloc = rl0 + ai * HALF + m * 16;
#pragma unroll
                    for (int bj = 0; bj < 2; ++bj) { const f32x4 x = acc[ai][bj][m][0], y = acc[ai][bj][m][1];
                        float s = ((x[0] * x[0] + x[1] * x[1]) + (x[2] * x[2] + x[3] * x[3])) + ((y[0] * y[0] + y[1] * y[1]) + (y[2] * y[2] + y[3] * y[3]));
                        s = sum16(s); s = sum32(s);
                        if (fq == 0) X[(rloc * 2 + bj) * 4 + wc] = s; } }
            asm volatile("s_waitcnt lgkmcnt(0)" ::: "memory"); __builtin_amdgcn_s_barrier(); asm volatile("" ::: "memory");
            const float* wv = (seg == 4) ? qn : kn; const float osc = (seg == 4) ? QS128 : 1.0f;
            const f32x4 w1 = *(const f32x4*)(wv + i4), w2 = *(const f32x4*)(wv + 64 + i4);
#pragma unroll
            for (int ai = 0; ai < 2; ++ai)
#pragma unroll
                for (int m = 0; m < 4; ++m) { const int rloc = rl0 + ai * HALF + m * 16; const size_t row = (size_t)u.pm * BM + rloc;
                    const f32x4 c = *(const f32x4*)(cosF + row * 64 + i4), sn = *(const f32x4*)(sinF + row * 64 + i4);
                    const f32x4 xs0 = *(const LAS f32x4*)(X + (rloc * 2 + 0) * 4), xs1 = *(const LAS f32x4*)(X + (rloc * 2 + 1) * 4);
#pragma unroll
                    for (int bj = 0; bj < 2; ++bj) { const f32x4 xs = bj ? xs1 : xs0;
                        const float rinv = __builtin_amdgcn_rsqf(((xs[0] + xs[1]) + (xs[2] + xs[3])) * (1.0f / 128.0f) + EPS);
                        const f32x4 y1 = acc[ai][bj][m][0] * w1 * rinv, y2 = acc[ai][bj][m][1] * w2 * rinv;
                        const f32x4 o1 = (y1 * c - y2 * sn) * osc, o2 = (y2 * c + y1 * sn) * osc;
                        u32x4 w; w.x = cvtpk(o1[0], o1[1]); w.y = cvtpk(o1[2], o1[3]); w.z = cvtpk(o2[0], o2[1]); w.w = cvtpk(o2[2], o2[3]);
                        *(u32x4*)(O + row * EVEN_LD + col0 + bj * HALF) = w; } }
            return;
        }
        const float sc = (seg == 0) ? QS128 : 1.f; const bool act = (seg == 3) || (seg == 7);
#pragma unroll
        for (int ai = 0; ai < 2; ++ai)
#pragma unroll
            for (int m = 0; m < 4; ++m) { bf16_t* rowp = O + (size_t)(row0 + ai * HALF + m * 16) * EVEN_LD + col0;
#pragma unroll
                for (int bj = 0; bj < 2; ++bj) { f32x4 v0 = acc[ai][bj][m][0] * sc, v1 = acc[ai][bj][m][1] * sc;
                    if (act) {
#pragma unroll
                        for (int j = 0; j < 4; ++j) { v0[j] = silu_f(v0[j]); v1[j] = silu_f(v1[j]); } }
                    u32x4 w; w.x = cvtpk(v0[0], v0[1]); w.y = cvtpk(v0[2], v0[3]); w.z = cvtpk(v1[0], v1[1]); w.w = cvtpk(v1[2], v1[3]);
                    *(u32x4*)(rowp + bj * HALF) = w; } }
    }
};
struct EpiResid {
    static constexpr bool PERM = true;
    const float* xin32; const unsigned short* xin16; float* xout32; unsigned short* xout16; const float* gate;
    __device__ __forceinline__ void operator()(const f32x4 (&acc)[2][2][4][2], const Unit& u, int wr, int wc, int fr, int fq) const {
        const int row0 = u.pm * BM + wr * 64 + fr, col0 = u.pn * BM + wc * 32 + 8 * fq;
        const float* gp = gate + (u.pm >= 16 ? 12288 : 0) + col0;
        f32x4 gv[2][2];
#pragma unroll
        for (int bj = 0; bj < 2; ++bj)
#pragma unroll
            for (int n = 0; n < 2; ++n) gv[bj][n] = *(const f32x4*)(gp + bj * HALF + n * 4);
        const bool in16 = xin16 != nullptr, out16 = xout16 != nullptr;
        if (in16) {
#pragma unroll
            for (int ai = 0; ai < 2; ++ai) {
                u32x4 raw[4][2];
#pragma unroll
                for (int m = 0; m < 4; ++m)
#pragma unroll
                    for (int bj = 0; bj < 2; ++bj) raw[m][bj] = *(const u32x4*)(xin16 + (size_t)(row0 + ai * HALF + m * 16) * DM + col0 + bj * HALF);
#pragma unroll
                for (int m = 0; m < 4; ++m) { const size_t off = (size_t)(row0 + ai * HALF + m * 16) * DM + col0;
#pragma unroll
                    for (int bj = 0; bj < 2; ++bj) { const u32x4 r = raw[m][bj];
                        const f32x4 x0 = {h_lo(r.x), h_hi(r.x), h_lo(r.y), h_hi(r.y)}, x1 = {h_lo(r.z), h_hi(r.z), h_lo(r.w), h_hi(r.w)};
                        const f32x4 y0 = x0 + gv[bj][0] * acc[ai][bj][m][0], y1 = x1 + gv[bj][1] * acc[ai][bj][m][1];
                        if (out16) { u32x4 w; w.x = pkh(y0[0], y0[1]); w.y = pkh(y0[2], y0[3]); w.z = pkh(y1[0], y1[1]); w.w = pkh(y1[2], y1[3]); *(u32x4*)(xout16 + off + bj * HALF) = w; }
                        else { *(f32x4*)(xout32 + off + bj * HALF) = y0; *(f32x4*)(xout32 + off + bj * HALF + 4) = y1; } } }
                asm volatile("" ::: "memory");
            }
            return;
        }
#pragma unroll
        for (int g2 = 0; g2 < 4; ++g2) { const int ai = g2 >> 1, mb = (g2 & 1) * 2;
            f32x4 xo[2][2][2];
#pragma unroll
            for (int m = 0; m < 2; ++m)
#pragma unroll
                for (int bj = 0; bj < 2; ++bj)
#pragma unroll
                    for (int n = 0; n < 2; ++n) xo[m][bj][n] = *(const f32x4*)(xin32 + (size_t)(row0 + ai * HALF + (mb + m) * 16) * DM + col0 + bj * HALF + n * 4);
#pragma unroll
            for (int m = 0; m < 2; ++m) { const size_t off = (size_t)(row0 + ai * HALF + (mb + m) * 16) * DM + col0;
#pragma unroll
                for (int bj = 0; bj < 2; ++bj) { const f32x4 y0 = xo[m][bj][0] + gv[bj][0] * acc[ai][bj][m == 0 ? mb : mb + 1][0], y1 = xo[m][bj][1] + gv[bj][1] * acc[ai][bj][m == 0 ? mb : mb + 1][1];
                    if (out16) { u32x4 w; w.x = pkh(y0[0], y0[1]); w.y = pkh(y0[2], y0[3]); w.z = pkh(y1[0], y1[1]); w.w = pkh(y1[2], y1[3]); *(u32x4*)(xout16 + off + bj * HALF) = w; }
                    else { *(f32x4*)(xout32 + off + bj * HALF) = y0; *(f32x4*)(xout32 + off + bj * HALF + 4) = y1; } } }
            asm volatile("" ::: "memory");
        }
    }
};

template <class Epi, class Sched, bool ALIGN_EPI = true, bool SP2 = true>
__device__ __forceinline__ void gemm_phase(LAS unsigned char* lds, const Gemm g, const Sched& S, const Epi& E, int wv) {
    const int tid = opaque_tid(wv), wid = __builtin_amdgcn_readfirstlane(tid >> 6), lane = tid & 63, wr = wid >> 2, wc = wid & 3, fr = lane & 15, fq = lane >> 4;
    const int K = g.K, nt = K / BK;
    unsigned voffA[2], voffB[2];
#pragma unroll
    for (int i = 0; i < 2; ++i) { int R, C; stage_rc(tid * 16 + i * 8192, R, C); const int Rb = Epi::PERM ? ((R & ~31) + perm32(R & 31)) : R;
        voffA[i] = (unsigned)(R * g.lda + C) * 2u; voffB[i] = (unsigned)(Rb * g.ldb + C) * 2u; }
    const size_t kstep = (size_t)(BK * 2);
    const size_t hstepA = (size_t)HALF * g.lda * 2, hstepB = (size_t)HALF * g.ldb * 2;
    const size_t tstepA = 2 * hstepA, tstepB = 2 * hstepB;
    const unsigned ldsw = (unsigned)wid * 1024u;
    const int aoff = lds_byte(wr * 64 + fr, fq * 8), boff = lds_byte(wc * 32 + fr, fq * 8);
#define PG8_SA(b, h) (((b) * 2 + (h)) * HTB)
#define PG8_SB(b, h) ((4 + (b) * 2 + (h)) * HTB)
#define PG8_STAGE(bufoff, gbase, voff) do { _Pragma("unroll") for (int _i = 0; _i < 2; ++_i) \
        __builtin_amdgcn_global_load_lds((const unsigned*)((const char*)(gbase) + (voff)[_i]), (LAS unsigned*)(lds + (bufoff) + ldsw + _i * 8192), 16, 0, 0); } while (0)
#define PG8_LDA(dst, b, h) do { _Pragma("unroll") for (int m = 0; m < 4; ++m) _Pragma("unroll") for (int k = 0; k < 2; ++k) dst[m][k] = *(const LAS bf16x8*)(lds + PG8_SA(b, h) + aoff + m * 2048 + k * 1024); } while (0)
#define PG8_LDB(dst, b, h) do { _Pragma("unroll") for (int n = 0; n < 2; ++n) _Pragma("unroll") for (int k = 0; k < 2; ++k) dst[n][k] = *(const LAS bf16x8*)(lds + PG8_SB(b, h) + boff + n * 2048 + k * 1024); } while (0)
#define PG8_MMA(ai, bj, At, Bt) do { __builtin_amdgcn_s_setprio(1); _Pragma("unroll") for (int m = 0; m < 4; ++m) _Pragma("unroll") for (int n = 0; n < 2; ++n) _Pragma("unroll") for (int k = 0; k < 2; ++k) \
        acc[ai][bj][m][n] = __builtin_amdgcn_mfma_f32_16x16x32_bf16(Bt[n][k], At[m][k], acc[ai][bj][m][n], 0, 0, 0); __builtin_amdgcn_s_setprio(0); } while (0)
#define PG8_WAIT_V(n) asm volatile("s_waitcnt vmcnt(" #n ")" ::: "memory")
#define PG8_WAIT_L(n) asm volatile("s_waitcnt lgkmcnt(" #n ")" ::: "memory")
#define PG8_BAR __builtin_amdgcn_s_barrier()
#define PG8_SCHED __builtin_amdgcn_sched_barrier(0)
    Unit cur, nxt; int ui = 0;
    if (!S.next(0, cur)) return;
    f32x4 acc[2][2][4][2];
#pragma unroll
    for (int a = 0; a < 2; ++a)
#pragma unroll
        for (int b = 0; b < 2; ++b)
#pragma unroll
            for (int m = 0; m < 4; ++m)
#pragma unroll
                for (int n = 0; n < 2; ++n) acc[a][b][m][n] = (f32x4){0.f, 0.f, 0.f, 0.f};
    bf16x8 At[4][2], B0[2][2], B1[2][2];
    const char* cA = (const char*)g.A + (size_t)cur.pm * tstepA; const char* cB = (const char*)g.Bt + (size_t)cur.pn * tstepB;
    S.a_ready(cur);
    if constexpr (SP2) {
        PG8_STAGE(PG8_SB(0, 0), cB, voffB); PG8_STAGE(PG8_SB(0, 1), cB + hstepB, voffB); PG8_STAGE(PG8_SA(0, 0), cA, voffA); PG8_STAGE(PG8_SA(0, 1), cA + hstepA, voffA);
        if (wr == 1) PG8_BAR;
        PG8_WAIT_V(2); PG8_BAR;
        PG8_STAGE(PG8_SB(1, 0), cB + kstep, voffB); PG8_STAGE(PG8_SA(1, 0), cA + kstep, voffA); PG8_STAGE(PG8_SB(1, 1), cB + hstepB + kstep, voffB);
        PG8_WAIT_V(6); PG8_BAR;
    } else {
        PG8_STAGE(PG8_SB(0, 0), cB, voffB); PG8_STAGE(PG8_SA(0, 0), cA, voffA); PG8_STAGE(PG8_SB(0, 1), cB + hstepB, voffB); PG8_STAGE(PG8_SA(0, 1), cA + hstepA, voffA);
        if (wr == 1) PG8_BAR;
        PG8_WAIT_V(4); PG8_BAR;
        PG8_STAGE(PG8_SB(1, 0), cB + kstep, voffB); PG8_STAGE(PG8_SA(1, 0), cA + kstep, voffA); PG8_STAGE(PG8_SB(1, 1), cB + hstepB + kstep, voffB);
        PG8_WAIT_V(6); PG8_BAR;
    }
    for (;;) {
        const bool has_next = S.next(ui + 1, nxt);
        const char* nA = has_next ? (const char*)g.A + (size_t)nxt.pm * tstepA : cA; const char* nB = has_next ? (const char*)g.Bt + (size_t)nxt.pn * tstepB : cB;
        for (int t = 0; t < nt; t += 2) {
            const bool last = (t == nt - 2);
            const char* a1 = cA + (size_t)(t + 1) * kstep;
            const char* a2 = last ? nA : cA + (size_t)(t + 2) * kstep; const char* b2 = last ? nB : cB + (size_t)(t + 2) * kstep;
            const char* a3 = a2 + kstep; const char* b3 = b2 + kstep;
            if (last && has_next) S.a_ready(nxt);
            if constexpr (SP2) {
            PG8_LDB(B0, 0, 0); PG8_LDB(B1, 0, 1); PG8_SCHED; PG8_LDA(At, 0, 0); PG8_STAGE(PG8_SA(1, 1), a1 + hstepA, voffA);
            PG8_WAIT_V(8); PG8_WAIT_L(0); PG8_BAR; PG8_MMA(0, 0, At, B0); PG8_MMA(0, 1, At, B1); PG8_BAR; PG8_SCHED;
            PG8_LDA(At, 0, 1); PG8_STAGE(PG8_SB(0, 0), b2, voffB); PG8_STAGE(PG8_SB(0, 1), b2 + hstepB, voffB); PG8_STAGE(PG8_SA(0, 0), a2, voffA);
            PG8_WAIT_V(8); PG8_WAIT_L(0); PG8_BAR; PG8_MMA(1, 0, At, B0); PG8_MMA(1, 1, At, B1); PG8_BAR; PG8_SCHED;
            PG8_LDB(B0, 1, 0); PG8_LDB(B1, 1, 1); PG8_SCHED; PG8_LDA(At, 1, 0); PG8_STAGE(PG8_SA(0, 1), a2 + hstepA, voffA);
            PG8_WAIT_V(8); PG8_WAIT_L(0); PG8_BAR; PG8_MMA(0, 0, At, B0); PG8_MMA(0, 1, At, B1); PG8_BAR; PG8_SCHED;
            PG8_LDA(At, 1, 1); PG8_STAGE(PG8_SB(1, 0), b3, voffB); PG8_STAGE(PG8_SB(1, 1), b3 + hstepB, voffB); PG8_STAGE(PG8_SA(1, 0), a3, voffA);
            PG8_WAIT_V(8); PG8_WAIT_L(0); PG8_BAR; PG8_MMA(1, 0, At, B0); PG8_MMA(1, 1, At, B1); PG8_BAR; PG8_SCHED;
            } else {
            PG8_LDB(B0, 0, 0); PG8_SCHED; PG8_LDA(At, 0, 0); PG8_STAGE(PG8_SA(1, 1), a1 + hstepA, voffA);
            PG8_WAIT_L(8); PG8_BAR; PG8_WAIT_L(0); PG8_MMA(0, 0, At, B0); PG8_BAR; PG8_SCHED;
            PG8_LDB(B1, 0, 1); PG8_STAGE(PG8_SB(0, 0), b2, voffB);
            PG8_BAR; PG8_WAIT_L(0); PG8_MMA(0, 1, At, B1); PG8_BAR;
            PG8_LDA(At, 0, 1); PG8_STAGE(PG8_SA(0, 0), a2, voffA);
            PG8_BAR; PG8_WAIT_L(0); PG8_MMA(1, 0, At, B0); PG8_BAR; PG8_SCHED;
            PG8_STAGE(PG8_SB(0, 1), b2 + hstepB, voffB);
            PG8_WAIT_V(6); PG8_BAR; PG8_MMA(1, 1, At, B1); PG8_BAR;
            PG8_LDB(B0, 1, 0); PG8_SCHED; PG8_LDA(At, 1, 0); PG8_STAGE(PG8_SA(0, 1), a2 + hstepA, voffA);
            PG8_WAIT_L(8); PG8_BAR; PG8_WAIT_L(0); PG8_MMA(0, 0, At, B0); PG8_BAR; PG8_SCHED;
            PG8_LDB(B1, 1, 1); PG8_STAGE(PG8_SB(1, 0), b3, voffB);
            PG8_BAR; PG8_WAIT_L(0); PG8_MMA(0, 1, At, B1); PG8_BAR;
            PG8_LDA(At, 1, 1); PG8_STAGE(PG8_SA(1, 0), a3, voffA);
            PG8_BAR; PG8_WAIT_L(0); PG8_MMA(1, 0, At, B0); PG8_BAR; PG8_SCHED;
            PG8_STAGE(PG8_SB(1, 1), b3 + hstepB, voffB);
            PG8_WAIT_V(6); PG8_BAR; PG8_MMA(1, 1, At, B1); PG8_BAR;
            }
        }
        if constexpr (ALIGN_EPI) { if (wr == 0) PG8_BAR; }
        E(acc, cur, wr, wc, fr, fq); S.done(cur);
        if (!has_next) break;
#pragma unroll
        for (int a = 0; a < 2; ++a)
#pragma unroll
            for (int b = 0; b < 2; ++b)
#pragma unroll
                for (int m = 0; m < 4; ++m)
#pragma unroll
                    for (int n = 0; n < 2; ++n) acc[a][b][m][n] = (f32x4){0.f, 0.f, 0.f, 0.f};
        cur = nxt; cA = nA; cB = nB; ++ui;
        if constexpr (ALIGN_EPI) { if (wr == 1) PG8_BAR; }
    }
    PG8_WAIT_V(0);
    if constexpr (!ALIGN_EPI) { if (wr == 0) PG8_BAR; }
    PG8_BAR;
#undef PG8_SA
#undef PG8_SB
#undef PG8_STAGE
#undef PG8_LDA
#undef PG8_LDB
#undef PG8_MMA
#undef PG8_WAIT_V
#undef PG8_WAIT_L
#undef PG8_BAR
#undef PG8_SCHED
}
}

#define XB_TMO      128
#define XB_XCNT(j)  (256  + 64 * (j))
#define XB_XSUB(j)  (1280 + 64 * (j))
#define XB_XGEN(j)  (2304 + 64 * (j))
#define XB_TOP      3328
#define XB_TOPGEN   3392
#define XCD_BAR_WORDS 3456
#define XB_SPIN_CAP (1u << 18)
__device__ __forceinline__ unsigned xb_ld(unsigned* p)              { return __hip_atomic_load(p, __ATOMIC_RELAXED, __HIP_MEMORY_SCOPE_AGENT); }
__device__ __forceinline__ unsigned xb_add(unsigned* p, unsigned v) { return __hip_atomic_fetch_add(p, v, __ATOMIC_RELAXED, __HIP_MEMORY_SCOPE_AGENT); }
__device__ __forceinline__ unsigned xb_xcc_id() { return (unsigned)__builtin_amdgcn_s_getreg((3 << 11) | 20) & 0xFu; }
#define XB_SPIN(cond, bar) do { unsigned _sp = 0; while (cond) { __builtin_amdgcn_s_sleep(1); \
    if ((++_sp & 255u) == 0u) { if (xb_ld(&(bar)[XB_TMO])) break; if (_sp > XB_SPIN_CAP) { atomicAdd(&(bar)[XB_TMO], 1u); break; } } } } while (0)
struct XcdBarrier { unsigned* bar; unsigned x; volatile LAS unsigned* st; int wv; };
__device__ __forceinline__ bool xb_thread0(int wv) { return wv == 0 && lane_fresh() == 0; }
__device__ __forceinline__ XcdBarrier xcd_barrier_post(unsigned* bar, volatile LAS unsigned* st, int wv) {
    XcdBarrier b; b.bar = bar; b.x = xb_xcc_id(); b.st = st; b.wv = wv;
    if (xb_thread0(wv)) (void)xb_add(&bar[XB_XCNT(b.x)], 1u);
    return b;
}
__device__ __forceinline__ void xcd_barrier_complete(unsigned* bar, unsigned x, unsigned& nloc, unsigned& nx) {
    const unsigned G = gridDim.x * gridDim.y * gridDim.z;
    unsigned sum, cnt, mine, sp = 0u;
    for (;;) {
        sum = 0u; cnt = 0u;
#pragma unroll
        for (unsigned j = 0; j < 16; ++j) { const unsigned c = xb_ld(&bar[XB_XCNT(j)]); sum += c; cnt += (c > 0u) ? 1u : 0u; }
        mine = xb_ld(&bar[XB_XCNT(x)]);
        if (sum == G) break;
        __builtin_amdgcn_s_sleep(1);
        if ((++sp & 255u) == 0u) { if (xb_ld(&bar[XB_TMO])) break; if (sp > XB_SPIN_CAP) { atomicAdd(&bar[XB_TMO], 1u); break; } }
    }
    nloc = mine > 0u ? mine : 1u; nx = cnt > 0u ? cnt : 1u;
}
__device__ __forceinline__ void xcd_barrier(const XcdBarrier& b) {
    asm volatile("s_waitcnt vmcnt(0)" ::: "memory");
    __syncthreads();
    if (xb_thread0(b.wv)) {
        unsigned* bar = b.bar; asm volatile("" : "+s"(bar));
        __builtin_amdgcn_s_waitcnt(0);
        unsigned nloc = b.st[0], nx = b.st[1];
        if (nloc == 0u) { xcd_barrier_complete(bar, b.x, nloc, nx); b.st[0] = nloc; b.st[1] = nx; }
        const unsigned old = xb_add(&bar[XB_XSUB(b.x)], 1u);
        const unsigned gen = old / nloc;
        if (old + 1u == (gen + 1u) * nloc) {
            __builtin_amdgcn_fence(__ATOMIC_RELEASE, "agent");
            asm volatile("s_waitcnt vmcnt(0)" ::: "memory");
            const unsigned og = xb_add(&bar[XB_TOP], 1u);
            const unsigned tg = og / nx;
            if (og + 1u == (tg + 1u) * nx) xb_add(&bar[XB_TOPGEN], 1u);
            else XB_SPIN(xb_ld(&bar[XB_TOPGEN]) == tg, bar);
            __builtin_amdgcn_fence(__ATOMIC_ACQUIRE, "agent");
            xb_add(&bar[XB_XGEN(b.x)], 1u);
            asm volatile("s_waitcnt vmcnt(0)" ::: "memory");
        } else {
            XB_SPIN(xb_ld(&bar[XB_XGEN(b.x)]) == gen, bar);
            __builtin_amdgcn_fence(__ATOMIC_ACQUIRE, "agent");
            asm volatile("s_waitcnt vmcnt(0)" ::: "memory");
        }
    }
    __syncthreads();
}

namespace att {
constexpr int KVBLK = 64, QBLK = 32, QB = 256;
constexpr int SHM_V = 16384, SHM_K = 16384, SHM_KR = 8192;
constexpr int V_OFF = 0, K_OFF = 2 * SHM_V, KR_OFF = K_OFF + 2 * SHM_K, WS_OFF = KR_OFF + 2 * SHM_KR, FLG_OFF = WS_OFF + 8 * 256, QR_OFF = FLG_OFF + 64 + 384, ATT_LDS = QR_OFF + 8 * 4096;
constexpr float SB_DONE = 0.f;
constexpr float THR2 = 11.5f;
#define KSWZ(row, colB) ((row) * 256 + ((colB) ^ ((((row) & 7) | ((((row) >> 4) & 1) << 3)) << 4)))
#define KRSWZ(row, colB) ((row) * 128 + ((colB) ^ ((((row) >> 1) & 7) << 4)))
__device__ __forceinline__ int v_st(int k, int c) { const int kk = (k & ~0xC) | ((k & 4) << 1) | ((k & 8) >> 1); return ((kk >> 3) * 4 + (c >> 5)) * 512 + ((kk & 7) * 32 + (c & 31)) * 2; }
__device__ __forceinline__ int v_rd_base(int lane) { return ((lane & 3) << 3) | (((lane >> 2) & 3) << 6) | (((lane >> 4) & 1) << 5) | (((lane >> 5) & 1) << 8); }
constexpr int v_rd_off(int d0, int ks, int half) { return d0 * 512 + ks * 4096 + half * 2048; }
__device__ __forceinline__ int crow(int r, int hi) { return (r & 3) + 8 * (r >> 2) + 4 * hi; }
__device__ __forceinline__ float xhalf(float v, int hi) {
    auto rr = __builtin_amdgcn_permlane32_swap(__float_as_uint(v), __float_as_uint(v), false, false);
    return __uint_as_float(hi ? rr[0] : rr[1]);
}
__device__ __forceinline__ void mask_tile(f32x16& p0, f32x16& p1, int dq, unsigned W) {
    const float NEG = -__builtin_inff();
#pragma unroll
    for (int r = 0; r < 16; ++r) {
        const int c = (r & 3) + 8 * (r >> 2);
        if ((unsigned)(dq - c) >= W) p0[r] = NEG;
        if ((unsigned)(dq - c - 32) >= W) p1[r] = NEG;
    }
}
#define PK4(P, B_, OUT) do { unsigned a0 = cvtpk(P[B_+0], P[B_+1]), a1 = cvtpk(P[B_+2], P[B_+3]);                          \
        unsigned b0 = cvtpk(P[B_+4], P[B_+5]), b1 = cvtpk(P[B_+6], P[B_+7]);                                             \
        auto r0 = __builtin_amdgcn_permlane32_swap(a0, b0, false, false); auto r1 = __builtin_amdgcn_permlane32_swap(a1, b1, false, false); \
        u32x4 w = {r0[0], r1[0], r0[1], r1[1]}; OUT = __builtin_bit_cast(bf16x8, w); } while (0)
__device__ __forceinline__ void softmax_tile(f32x16& p0, f32x16& p1, float& m_reg, float& l_reg, float& alpha) {
    float pmax = p0[0];
#pragma unroll
    for (int r = 1; r < 16; ++r) pmax = fmaxf(pmax, p0[r]);
#pragma unroll
    for (int r = 0; r < 16; ++r) pmax = fmaxf(pmax, p1[r]);
    { auto rr = __builtin_amdgcn_permlane32_swap(__float_as_uint(pmax), __float_as_uint(pmax), false, false);
      pmax = fmaxf(__uint_as_float(rr[0]), __uint_as_float(rr[1])); }
    float mn;
    if (__all((pmax - m_reg) <= THR2)) { mn = m_reg; alpha = 1.f; }
    else { mn = fmaxf(m_reg, pmax); alpha = __builtin_amdgcn_exp2f(m_reg - mn); m_reg = mn; }
#pragma unroll
    for (int r = 0; r < 16; ++r) p0[r] = __builtin_amdgcn_exp2f(p0[r] - mn);
#pragma unroll
    for (int r = 0; r < 16; ++r) p1[r] = __builtin_amdgcn_exp2f(p1[r] - mn);
    float ps = 0.f;
#pragma unroll
    for (int r = 0; r < 16; ++r) ps += p0[r];
#pragma unroll
    for (int r = 0; r < 16; ++r) ps += p1[r];
    { auto rr = __builtin_amdgcn_permlane32_swap(__float_as_uint(ps), __float_as_uint(ps), false, false);
      ps = __uint_as_float(rr[0]) + __uint_as_float(rr[1]); }
    l_reg = l_reg * alpha + ps;
}
__device__ __forceinline__ void sb_half(f32x16& p, float rin, float& rout, int hi) {
#pragma unroll
    for (int r = 0; r < 16; ++r) p[r] = __builtin_amdgcn_rcpf(1.f + __builtin_amdgcn_exp2f(p[r]));
    float s[4], q[4], R[4];
#pragma unroll
    for (int g = 0; g < 4; ++g) s[g] = (p[4 * g] * p[4 * g + 1]) * (p[4 * g + 2] * p[4 * g + 3]);
#pragma unroll
    for (int g = 0; g < 4; ++g) q[g] = xhalf(s[g], hi);
    R[3] = rin; R[2] = R[3] * (s[3] * q[3]); R[1] = R[2] * (s[2] * q[2]); R[0] = R[1] * (s[1] * q[1]);
    rout = R[0] * (s[0] * q[0]);
#pragma unroll
    for (int g = 0; g < 4; ++g) {
        float run = hi ? R[g] : R[g] * q[g];
#pragma unroll
        for (int i = 3; i >= 0; --i) { const float ui = p[4 * g + i]; p[4 * g + i] = (1.f - ui) * run; run *= ui; }
    }
}
__device__ __forceinline__ void sb_tile(f32x16& p0, f32x16& p1, float& carry, int hi) {
    float mid, nc;
    sb_half(p1, carry, mid, hi);
    sb_half(p0, mid, nc, hi);
    carry = nc;
}
template <bool MLA>
__device__ __forceinline__ void qkt(f32x16& p0, f32x16& p1, LAS unsigned char* lds, int KB, int r32, int hi, const bf16x8* qr, const bf16x8* qrr, bool a0, bool a1) {
    constexpr int NF = MLA ? 12 : 8, D = 8;
    const float NEG = -__builtin_inff();
    unsigned kb[4];
#pragma unroll
    for (int dd = 0; dd < 4; ++dd) kb[dd] = (unsigned)(K_OFF + KB * SHM_K + KSWZ(r32, (dd * 16 + hi * 8) * 2));
    const unsigned krb = (unsigned)(KR_OFF + KB * SHM_KR);
#define KADDR(i) ((i) < 8 ? (kb[(i) & 3] ^ ((unsigned)(((i) & 7) >> 2) << 7)) : krb + (unsigned)KRSWZ(r32, ((((i) < 8 ? 8 : (i)) - 8) * 16 + hi * 8) * 2))
#define KHOFF(i) ((i) < 8 ? 32u * 256u : 32u * 128u)
#define QFRAG(i) ((i) < 8 ? qr[(i) < 8 ? (i) : 0] : qrr[(i) < 8 ? 0 : (i) - 8])
    bf16x8 F[D];
    if (a0 && a1) {
#pragma unroll
        for (int s_ = 0; s_ < D; ++s_) F[s_] = *(const LAS bf16x8*)(lds + KADDR(s_ % NF) + (s_ / NF) * KHOFF(s_ % NF));
        SBAR();
#pragma unroll
        for (int r = 0; r < 16; ++r) { p0[r] = 0.f; p1[r] = 0.f; }
        __builtin_amdgcn_s_setprio(1);
#pragma unroll
        for (int s_ = 0; s_ < 2 * NF; ++s_) { const int i = s_ % NF;
            if (s_ < NF) p0 = __builtin_amdgcn_mfma_f32_32x32x16_bf16(F[s_ % D], QFRAG(i), p0, 0, 0, 0);
            else p1 = __builtin_amdgcn_mfma_f32_32x32x16_bf16(F[s_ % D], QFRAG(i), p1, 0, 0, 0);
            if (s_ + D < 2 * NF) F[s_ % D] = *(const LAS bf16x8*)(lds + KADDR((s_ + D) % NF) + ((s_ + D) / NF) * KHOFF((s_ + D) % NF));
            SBAR(); }
    } else if (a0) {
#pragma unroll
        for (int s_ = 0; s_ < D; ++s_) F[s_] = *(const LAS bf16x8*)(lds + KADDR(s_));
        SBAR();
#pragma unroll
        for (int r = 0; r < 16; ++r) { p0[r] = 0.f; p1[r] = NEG; }
        __builtin_amdgcn_s_setprio(1);
#pragma unroll
        for (int s_ = 0; s_ < NF; ++s_) { p0 = __builtin_amdgcn_mfma_f32_32x32x16_bf16(F[s_ % D], QFRAG(s_), p0, 0, 0, 0);
            if (s_ + D < NF) F[s_ % D] = *(const LAS bf16x8*)(lds + KADDR(s_ + D));
            SBAR(); }
    } else {
#pragma unroll
        for (int s_ = 0; s_ < D; ++s_) F[s_] = *(const LAS bf16x8*)(lds + KADDR(s_) + KHOFF(s_));
        SBAR();
#pragma unroll
        for (int r = 0; r < 16; ++r) { p1[r] = 0.f; p0[r] = NEG; }
        __builtin_amdgcn_s_setprio(1);
#pragma unroll
        for (int s_ = 0; s_ < NF; ++s_) { p1 = __builtin_amdgcn_mfma_f32_32x32x16_bf16(F[s_ % D], QFRAG(s_), p1, 0, 0, 0);
            if (s_ + D < NF) F[s_ % D] = *(const LAS bf16x8*)(lds + KADDR(s_ + D) + KHOFF(s_ + D));
            SBAR(); }
    }
    __builtin_amdgcn_s_setprio(0);
#undef KADDR
#undef KHOFF
#undef QFRAG
}
__device__ __forceinline__ void pv_tile(f32x16* o, unsigned vb0, const f32x16& p0, const f32x16& p1, bool a0, bool a1) {
#define TRRD(dst, off) asm volatile("ds_read_b64_tr_b16 %0, %1 offset:%2" : "=&v"(dst) : "v"(vb0), "i"(off) : "memory")
#define PV_RD(ks, S) do { constexpr int b_ = V_OFF + v_rd_off(0, ks, 0); \
        TRRD(S##l0, b_); TRRD(S##h0, b_ + 2048); TRRD(S##l1, b_ + 512); TRRD(S##h1, b_ + 512 + 2048); TRRD(S##l2, b_ + 1024); TRRD(S##h2, b_ + 1024 + 2048); TRRD(S##l3, b_ + 1536); TRRD(S##h3, b_ + 1536 + 2048); } while (0)
#define PV_MM(S, P, B_) do { bf16x8 pa; PK4(P, B_, pa); __builtin_amdgcn_s_setprio(1); \
        o[0] = __builtin_amdgcn_mfma_f32_32x32x16_bf16(pa, (bf16x8){S##l0[0], S##l0[1], S##l0[2], S##l0[3], S##h0[0], S##h0[1], S##h0[2], S##h0[3]}, o[0], 0, 0, 0);   \
        o[1] = __builtin_amdgcn_mfma_f32_32x32x16_bf16(pa, (bf16x8){S##l1[0], S##l1[1], S##l1[2], S##l1[3], S##h1[0], S##h1[1], S##h1[2], S##h1[3]}, o[1], 0, 0, 0);   \
        o[2] = __builtin_amdgcn_mfma_f32_32x32x16_bf16(pa, (bf16x8){S##l2[0], S##l2[1], S##l2[2], S##l2[3], S##h2[0], S##h2[1], S##h2[2], S##h2[3]}, o[2], 0, 0, 0);   \
        o[3] = __builtin_amdgcn_mfma_f32_32x32x16_bf16(pa, (bf16x8){S##l3[0], S##l3[1], S##l3[2], S##l3[3], S##h3[0], S##h3[1], S##h3[2], S##h3[3]}, o[3], 0, 0, 0); __builtin_amdgcn_s_setprio(0); } while (0)
    s16x4 Al0, Al1, Al2, Al3, Ah0, Ah1, Ah2, Ah3, Bl0, Bl1, Bl2, Bl3, Bh0, Bh1, Bh2, Bh3;
    if (a0) {
        PV_RD(0, A); PV_RD(1, B);
        asm volatile("s_waitcnt lgkmcnt(8)" ::: "memory"); SBAR(); PV_MM(A, p0, 0); SBAR();
        asm volatile("s_waitcnt lgkmcnt(0)" ::: "memory"); SBAR(); PV_MM(B, p0, 8); SBAR();
    }
    if (a1) {
        PV_RD(2, A); PV_RD(3, B);
        asm volatile("s_waitcnt lgkmcnt(8)" ::: "memory"); SBAR(); PV_MM(A, p1, 0); SBAR();
        asm volatile("s_waitcnt lgkmcnt(0)" ::: "memory"); SBAR(); PV_MM(B, p1, 8);
    }
#undef PV_MM
#undef PV_RD
#undef TRRD
}

struct Blk {
    const bf16_t* Q;
    const bf16_t* K;
    const bf16_t* V;
    bf16_t* O;
    const bf16_t* G;
    float* LSE;
    int P0;
    int dil;
    const float* ssq;
    const float* qw;
    const float* cs; const float* sn;
};
template <int MODE>
__device__ __forceinline__ void attn_block(const Blk& b, LAS unsigned char* lds, int wv) {
    constexpr bool MLA = MODE == 0, DIL = MODE == 1, SB = MODE == 2;
    constexpr int NQR = 8;
    const int qs = MLA ? UQ_N : (DIL ? b.dil * EVEN_LD : EVEN_LD), ks = MLA ? 192 : qs, vs = MLA ? 128 : qs;
    const int os = DIL ? b.dil * 2048 : DM, gs = MLA ? ODD_INP : EVEN_LD, ls = DIL ? b.dil * 16 : 0;
    const int tid = opaque_tid(wv), wid = __builtin_amdgcn_readfirstlane(tid >> 6), lane = tid & 63, r32 = lane & 31, hi = lane >> 5;
    int j_lo = 0; const int j_hi = b.P0 / KVBLK + 4;
    if (DIL) j_lo = b.P0 >= 256 ? b.P0 / KVBLK - 2 : 0;
    int NT = j_hi - j_lo;
    const int qlo = b.P0 + wid * QBLK, qm = qlo + r32 - 4 * hi;
    LAS float* wsf = (LAS float*)(lds + WS_OFF) + wid * 64; LAS float* li_l = wsf; LAS float* al_l = wsf + 32;
    const unsigned vb0 = (unsigned)(size_t)(lds + V_OFF) + (unsigned)v_rd_base(lane);
    unsigned kdo[2], vdo[2], krdo = 0u;
#pragma unroll
    for (int i = 0; i < 2; ++i) { const int row = 4 * (2 * wid + i) + (lane >> 4);
        kdo[i] = (unsigned)row * (unsigned)(ks * 2) + ((((unsigned)lane & 15u) << 4) ^ ((unsigned)((row & 7) | (((row >> 4) & 1) << 3)) << 4));
        const int key = (((lane >> 2) & 3) | (((lane >> 4) & 1) << 3)) + (((wid & 1) << 2) | ((wid >> 1) << 4));
        vdo[i] = (unsigned)key * (unsigned)(vs * 2) + (unsigned)(((2 * i + (lane >> 5)) * 32 + (lane & 3) * 8) * 2); }
    if constexpr (MLA) { const int row = 8 * wid + (lane >> 3); krdo = (unsigned)row * (unsigned)(ks * 2) + 256u + ((((unsigned)lane & 7u) << 4) ^ ((unsigned)((row >> 1) & 7) << 4)); }
#define TILE_J(t) (SB ? (j_hi - 1 - (t)) : (j_lo + (t)))
#define TDMA(j, bf) do { const char* kt_ = (const char*)b.K + (size_t)(j) * KVBLK * ks * 2; const char* vt_ = (const char*)b.V + (size_t)(j) * KVBLK * vs * 2; \
        _Pragma("unroll") for (int i_ = 0; i_ < 2; ++i_) __builtin_amdgcn_global_load_lds((const unsigned*)(kt_ + kdo[i_]), (LAS unsigned*)(lds + K_OFF + (bf) * SHM_K + (2 * wid + i_) * 1024), 16, 0, 0); \
        _Pragma("unroll") for (int i_ = 0; i_ < 2; ++i_) __builtin_amdgcn_global_load_lds((const unsigned*)(vt_ + vdo[i_]), (LAS unsigned*)(lds + V_OFF + (bf) * SHM_V + (2 * wid + i_) * 1024), 16, 0, 0); \
        if constexpr (MLA) __builtin_amdgcn_global_load_lds((const unsigned*)(kt_ + krdo), (LAS unsigned*)(lds + KR_OFF + (bf) * SHM_KR + wid * 1024), 16, 0, 0); } while (0)
    TDMA(TILE_J(0), 0);
    bf16x8 qr[NQR]; bf16x8 qrr[4];
    if constexpr (!MLA) { const bf16_t* qp = b.Q + (size_t)(wid * QBLK + r32) * qs + hi * 8;
#pragma unroll
      for (int d0 = 0; d0 < NQR; ++d0) qr[d0] = *GP(const bf16x8, qp + d0 * 16); }
    else {
      const int row = wid * QBLK + r32;
      const bf16_t* qp = b.Q + (size_t)row * qs + hi * 8;
      u32x4 raw[12];
#pragma unroll
      for (int d0 = 0; d0 < 12; ++d0) raw[d0] = *GP(const u32x4, qp + d0 * 16);
      f32x4 wq[16], w1r[2][2], w2r[2][2], csr[2][2], snr[2][2];
#pragma unroll
      for (int d0 = 0; d0 < 8; ++d0) { wq[2 * d0] = *GP(const f32x4, b.qw + d0 * 16 + hi * 8); wq[2 * d0 + 1] = *GP(const f32x4, b.qw + d0 * 16 + hi * 8 + 4); }
#pragma unroll
      for (int d1 = 0; d1 < 2; ++d1)
#pragma unroll
          for (int h4 = 0; h4 < 2; ++h4) { const int i0 = d1 * 16 + hi * 8 + 4 * h4;
              w1r[d1][h4] = *GP(const f32x4, b.qw + 128 + i0); w2r[d1][h4] = *GP(const f32x4, b.qw + 160 + i0);
              csr[d1][h4] = *GP(const f32x4, b.cs + row * 32 + i0); snr[d1][h4] = *GP(const f32x4, b.sn + row * 32 + i0); }
      const float rq = __builtin_amdgcn_rsqf(*GP(const float, b.ssq + row) * (1.0f / QLORA) + EPS);
      float ss = 0.f;
#pragma unroll
      for (int d0 = 0; d0 < 12; ++d0) { float x[8]; unpack8(raw[d0], x);
#pragma unroll
          for (int e = 0; e < 8; ++e) ss += x[e] * x[e]; }
      ss += xhalf(ss, hi);
      const float sc = rq * __builtin_amdgcn_rsqf(rq * rq * ss * (1.0f / 192.0f) + EPS) * QS192;
#pragma unroll
      for (int d0 = 0; d0 < 8; ++d0) { float x[8]; unpack8(raw[d0], x); const f32x4 wa = wq[2 * d0], wb = wq[2 * d0 + 1];
#pragma unroll
          for (int e = 0; e < 4; ++e) { x[e] *= sc * wa[e]; x[4 + e] *= sc * wb[e]; }
          qr[d0] = __builtin_bit_cast(bf16x8, pack8u(x)); }
#pragma unroll
      for (int d1 = 0; d1 < 2; ++d1) { float x1[8], x2[8], o1[8], o2[8]; unpack8(raw[8 + d1], x1); unpack8(raw[10 + d1], x2);
          const int i0 = d1 * 16 + hi * 8;
#pragma unroll
          for (int e = 0; e < 8; ++e) { const float y1 = x1[e] * sc * w1r[d1][e >> 2][e & 3], y2 = x2[e] * sc * w2r[d1][e >> 2][e & 3]; const float c = csr[d1][e >> 2][e & 3], s = snr[d1][e >> 2][e & 3];
              o1[e] = y1 * c - y2 * s; o2[e] = y2 * c + y1 * s; }
          qrr[d1] = __builtin_bit_cast(bf16x8, pack8u(o1)); qrr[d1 + 2] = __builtin_bit_cast(bf16x8, pack8u(o2)); }
    }
    f32x16 o[4];
#pragma unroll
    for (int d = 0; d < 4; ++d)
#pragma unroll
        for (int r = 0; r < 16; ++r) o[d][r] = 0.f;
    float m_reg = -1e30f, l_reg = 0.f, carry = SB ? 1.f : 0.f;
#define TILE_FLAGS(t, act_, needm_, kb_) const int kb_ = TILE_J(t) * KVBLK; bool act_, needm_, a0_, a1_; \
        if (MLA) { a0_ = kb_ <= qlo + QBLK - 1; a1_ = kb_ + 32 <= qlo + QBLK - 1; needm_ = kb_ + KVBLK - 1 > qlo; } \
        else if (DIL) { a0_ = (kb_ <= qlo + QBLK - 1) && (kb_ + 31 >= qlo - 128); a1_ = (kb_ + 32 <= qlo + QBLK - 1) && (kb_ + KVBLK - 1 >= qlo - 128); \
                        needm_ = (kb_ + KVBLK - 1 > qlo) || (kb_ <= qlo + QBLK - 1 - 129); } \
        else { a0_ = kb_ <= qlo + QBLK - 2; a1_ = kb_ + 32 <= qlo + QBLK - 2; needm_ = kb_ + KVBLK - 1 > qlo - 1; } \
        act_ = a0_ || a1_;
    LAS unsigned* flg = (LAS unsigned*)(lds + FLG_OFF);
    constexpr bool NOPP = true;
    const bool h0 = NOPP ? true : (wid < 4);
#define SBDONE(td) ({ bool r_ = false; if constexpr (SB) { const u32x4 f0_ = *(const LAS u32x4*)(flg + ((td) & 1) * 8), f1_ = *(const LAS u32x4*)(flg + ((td) & 1) * 8 + 4); \
            r_ = (f0_.x & f0_.y & f0_.z & f0_.w & f1_.x & f1_.y & f1_.z & f1_.w) != 0u; } r_; })
    VM_WAIT();
    __syncthreads();
    bool stopped = false;
    for (int t = 0; t < NT; ++t) {
        if (SB && (NOPP || !h0) && t >= 1) { if (SBDONE(t - 1)) break; }
        if (t + 1 < NT) TDMA(TILE_J(t + 1), (t + 1) & 1);
        TILE_FLAGS(t, act_, needm_, kb_)
        f32x16 p0, p1;
        if (act_) qkt<MLA>(p0, p1, lds, t & 1, r32, hi, qr, qrr, a0_, a1_);
        if constexpr (!NOPP) __syncthreads();
        if (SB && !NOPP && h0 && t >= 1) { if (SBDONE(t - 1)) { stopped = true; break; } }
        if (act_) {
            if (needm_) { if (SB) mask_tile(p0, p1, qm - kb_ - 1, 0x7fffffffu); else mask_tile(p0, p1, qm - kb_, DIL ? 129u : 0x7fffffffu); }
            if constexpr (SB) { sb_tile(p0, p1, carry, hi); }
            else { float alpha_; softmax_tile(p0, p1, m_reg, l_reg, alpha_);
                if (__any(alpha_ < 1.f)) { if (hi == 0) al_l[r32] = alpha_; LDS_WAIT();
#pragma unroll
                    for (int d_ = 0; d_ < 4; ++d_)
#pragma unroll
                        for (int r = 0; r < 16; ++r) o[d_][r] *= al_l[crow(r, hi)]; } }
            pv_tile(o, vb0 + (unsigned)((t & 1) * SHM_V), p0, p1, a0_, a1_); }
        if constexpr (SB) { const bool dn_ = __all(carry <= SB_DONE); if (lane == 0) flg[(t & 1) * 8 + wid] = dn_ ? 1u : 0u; }
        VM_WAIT();
        __syncthreads();
    }
    if (!NOPP && h0 && !stopped) __syncthreads();
#undef SBDONE
#undef TILE_FLAGS
#undef TDMA
#undef TILE_J
    u32x4 gpre[8];
    if (b.G) {
#pragma unroll
        for (int i = 0; i < 8; ++i) { const int id = lane + 64 * i, row = id >> 4, c = id & 15; gpre[i] = *GP(const u32x4, b.G + (size_t)(wid * QBLK + row) * gs + c * 8); } }
    if constexpr (!SB) {
        if (hi == 0) li_l[r32] = l_reg;
        LDS_WAIT();
        if constexpr (DIL) { if (hi == 0) b.LSE[(size_t)(wid * QBLK + r32) * ls] = m_reg + __builtin_amdgcn_logf(l_reg); }
#pragma unroll
        for (int r = 0; r < 16; ++r) { const float rl = __builtin_amdgcn_rcpf(li_l[crow(r, hi)]);
#pragma unroll
            for (int d = 0; d < 4; ++d) o[d][r] *= rl; }
    }
    LAS unsigned char* ost = lds + wid * 8192;
#pragma unroll
    for (int r = 0; r < 16; ++r) { const int orow = crow(r, hi);
#pragma unroll
        for (int d = 0; d < 4; d += 2) {
            const float x = o[d][r], y = o[d + 1][r]; const bool odd = (r32 & 1) != 0;
            const float got = dpp_xor1(odd ? x : y);
            const unsigned w = odd ? cvtpk(got, y) : cvtpk(x, got);
            *(LAS unsigned*)(ost + orow * 256 + ((odd ? d + 1 : d) * 32 + (r32 & ~1)) * 2) = w; } }
    LDS_WAIT();
#pragma unroll
    for (int i = 0; i < 8; ++i) { const int id = lane + 64 * i, row = id >> 4, c = id & 15;
        u32x4 w = *(const LAS u32x4*)(ost + row * 256 + c * 16);
        if (b.G) { const u32x4 g = gpre[i]; float x[8], y[8]; unpack8(w, x); unpack8(g, y);
#pragma unroll
            for (int e = 0; e < 8; ++e) x[e] *= y[e];
            w = pack8u(x); }
        *GP(u32x4, b.O + (size_t)(wid * QBLK + row) * os + c * 8) = w; }
    __syncthreads();
}
__device__ __forceinline__ void attn_dil_wave(const Blk& b, LAS unsigned char* lds, LAS unsigned char* scratch, int wv) {
    const int qs = b.dil * EVEN_LD, os = b.dil * 2048, ls = b.dil * 16;
    const int tid = opaque_tid(wv), wid = __builtin_amdgcn_readfirstlane(tid >> 6), lane = tid & 63, r32 = lane & 31, hi = lane >> 5;
    const int qlo = b.P0, qm = qlo + r32 - 4 * hi;
    const int hlast = qlo >> 5, hfirst = qlo >= 128 ? hlast - 4 : 0, n = hlast - hfirst + 1;
    LAS unsigned char* kbuf = lds + wid * 16384; LAS unsigned char* vbuf = kbuf + 8192;
    LAS float* li_l = (LAS float*)(scratch + wid * 256); LAS float* al_l = li_l + 32;
    bf16x8 qr[8];
    { const bf16_t* qp = b.Q + (size_t)r32 * qs + hi * 8;
#pragma unroll
      for (int d0 = 0; d0 < 8; ++d0) qr[d0] = *GP(const bf16x8, qp + d0 * 16); }
    const unsigned rs2 = (unsigned)qs * 2u;
    const unsigned kl = (unsigned)(lane >> 4) * rs2 + ((((unsigned)lane & 15u) ^ ((unsigned)lane >> 4)) << 4);
    const unsigned vl = (unsigned)(((lane >> 2) & 3) | (((lane >> 4) & 1) << 3)) * rs2 + (unsigned)(((lane >> 5) * 32 + (lane & 3) * 8) * 2);
#define KDMA(hh) do { const char* kb_ = (const char*)b.K + (size_t)(hh) * 32 * rs2; _Pragma("unroll") for (int c_ = 0; c_ < 8; ++c_) \
        __builtin_amdgcn_global_load_lds((const unsigned*)(kb_ + (size_t)(4 * c_) * rs2 + (kl ^ (unsigned)(((c_ & 1) << 6) | ((c_ >> 2) << 7)))), (LAS unsigned*)(kbuf + c_ * 1024), 16, 0, 0); } while (0)
#define VDMA(hh) do { const char* vb_ = (const char*)b.V + (size_t)(hh) * 32 * rs2; _Pragma("unroll") for (int c_ = 0; c_ < 8; ++c_) \
        __builtin_amdgcn_global_load_lds((const unsigned*)(vb_ + (size_t)((((c_ >> 1) & 1) << 2) | ((c_ >> 2) << 4)) * rs2 + (c_ & 1) * 128 + vl), (LAS unsigned*)(vbuf + c_ * 1024), 16, 0, 0); } while (0)
    KDMA(hfirst); VDMA(hfirst);
    f32x16 o[4];
#pragma unroll
    for (int d = 0; d < 4; ++d)
#pragma unroll
        for (int r = 0; r < 16; ++r) o[d][r] = 0.f;
    float m_reg = -1e30f, l_reg = 0.f;
    const unsigned vb0 = (unsigned)(size_t)vbuf + (unsigned)v_rd_base(lane);
    unsigned kb[4];
#pragma unroll
    for (int dd = 0; dd < 4; ++dd) kb[dd] = (unsigned)(wid * 16384 + KSWZ(r32, (dd * 16 + hi * 8) * 2));
    const float NEG = -__builtin_inff();
    for (int i = 0; i < n; ++i) { const int hh = hfirst + i; const bool more = i + 1 < n;
        asm volatile("s_waitcnt vmcnt(8)" ::: "memory");
        f32x16 p;
#pragma unroll
        for (int r = 0; r < 16; ++r) p[r] = 0.f;
        { bf16x8 F[8];
#pragma unroll
          for (int d0 = 0; d0 < 8; ++d0) F[d0] = *(const LAS bf16x8*)(lds + (kb[d0 & 3] ^ ((unsigned)(d0 >> 2) << 7)));
          SBAR();
          __builtin_amdgcn_s_setprio(1);
#pragma unroll
          for (int d0 = 0; d0 < 8; ++d0) p = __builtin_amdgcn_mfma_f32_32x32x16_bf16(F[d0], qr[d0], p, 0, 0, 0);
          __builtin_amdgcn_s_setprio(0); }
        LDS_WAIT(); asm volatile("" ::: "memory");
        if (more) KDMA(hh + 1);
        if (hh == hlast || hh * 32 < qlo + 31 - 128) { const int dq = qm - hh * 32;
#pragma unroll
            for (int r = 0; r < 16; ++r) { const int c = (r & 3) + 8 * (r >> 2); if ((unsigned)(dq - c) >= 129u) p[r] = NEG; } }
        { float pmax = p[0];
#pragma unroll
          for (int r = 1; r < 16; ++r) pmax = fmaxf(pmax, p[r]);
          { auto rr = __builtin_amdgcn_permlane32_swap(__float_as_uint(pmax), __float_as_uint(pmax), false, false); pmax = fmaxf(__uint_as_float(rr[0]), __uint_as_float(rr[1])); }
          float mn, alpha;
          if (__all((pmax - m_reg) <= THR2)) { mn = m_reg; alpha = 1.f; }
          else { mn = fmaxf(m_reg, pmax); alpha = __builtin_amdgcn_exp2f(m_reg - mn); m_reg = mn; }
#pragma unroll
          for (int r = 0; r < 16; ++r) p[r] = __builtin_amdgcn_exp2f(p[r] - mn);
          float ps = 0.f;
#pragma unroll
          for (int r = 0; r < 16; ++r) ps += p[r];
          { auto rr = __builtin_amdgcn_permlane32_swap(__float_as_uint(ps), __float_as_uint(ps), false, false); ps = __uint_as_float(rr[0]) + __uint_as_float(rr[1]); }
          l_reg = l_reg * alpha + ps;
          if (__any(alpha < 1.f)) { if (hi == 0) al_l[r32] = alpha; LDS_WAIT();
#pragma unroll
              for (int d_ = 0; d_ < 4; ++d_)
#pragma unroll
                  for (int r = 0; r < 16; ++r) o[d_][r] *= al_l[crow(r, hi)];
              LDS_WAIT(); } }
        if (more) asm volatile("s_waitcnt vmcnt(8)" ::: "memory"); else asm volatile("s_waitcnt vmcnt(0)" ::: "memory");
        pv_tile(o, vb0, p, p, true, false);
        LDS_WAIT(); asm volatile("" ::: "memory");
        if (more) VDMA(hh + 1);
    }
#undef KDMA
#undef VDMA
    if (hi == 0) li_l[r32] = l_reg;
    LDS_WAIT();
    if (hi == 0) *GP(float, b.LSE + (size_t)r32 * ls) = m_reg + __builtin_amdgcn_logf(l_reg);
#pragma unroll
    for (int r = 0; r < 16; ++r) { const float rl = __builtin_amdgcn_rcpf(li_l[crow(r, hi)]);
#pragma unroll
        for (int d = 0; d < 4; ++d) o[d][r] *= rl; }
    LAS unsigned char* ost = kbuf;
#pragma unroll
    for (int r = 0; r < 16; ++r) { const int orow = crow(r, hi);
#pragma unroll
        for (int d = 0; d < 4; d += 2) {
            const float x = o[d][r], y = o[d + 1][r]; const bool odd = (r32 & 1) != 0;
            const float got = dpp_xor1(odd ? x : y);
            const unsigned w = odd ? cvtpk(got, y) : cvtpk(x, got);
            *(LAS unsigned*)(ost + orow * 256 + ((odd ? d + 1 : d) * 32 + (r32 & ~1)) * 2) = w; } }
    LDS_WAIT();
#pragma unroll 2
    for (int i = 0; i < 8; ++i) { const int id = lane + 64 * i, row = id >> 4, c = id & 15;
        const u32x4 w = *(const LAS u32x4*)(ost + row * 256 + c * 16);
        *GP(u32x4, b.O + (size_t)row * os + c * 8) = w; }
    LDS_WAIT(); asm volatile("" ::: "memory");
}
}

struct Args { const void* in[18]; float* out; unsigned char* ws; int ph_lo, ph_hi; };
typedef const __attribute__((address_space(4))) Args CArgs;
__device__ __forceinline__ CArgs* kargs() { CArgs* p = (CArgs*)__builtin_amdgcn_kernarg_segment_ptr(); asm volatile("" : "+s"(p)); return p; }
enum { IN_X = 0, IN_C, IN_POS, IN_ADAW, IN_ADAB, IN_NORMW, IN_EVWIN, IN_EVQN, IN_EVKN, IN_EVWOUT, IN_ODWIN, IN_ODQLN, IN_ODKVLN, IN_ODWUQ, IN_ODWUKV, IN_ODQN, IN_ODKN, IN_ODWOUT };

struct Frame {
    LAS unsigned char* lds;
    int tid, lane, wave, vcu, G, wv;
    unsigned char* ws;
    __device__ __forceinline__ void refresh() { tid = opaque_tid(wv); lane = tid & 63; wave = __builtin_amdgcn_readfirstlane(tid >> 6); }
};

__device__ __forceinline__ void transpose_item(const float* W, int N, const float* kscale, bf16_t* Bt, int ldb, int k0, int n0, int brow0, LAS unsigned char* scr, int lane, int dl_perm = -1) {
    const int kq = lane >> 4, nq = lane & 15;
    f32x4 v[16];
#pragma unroll
    for (int i = 0; i < 16; ++i) { const int k = 8 * (i >> 1) + 2 * kq + (i & 1); v[i] = __builtin_nontemporal_load((const f32x4*)(W + (size_t)(k0 + k) * N + n0 + 4 * nq)); }
#pragma unroll
    for (int i = 0; i < 8; ++i) { const int k = 8 * i + 2 * kq; f32x4 a = v[2 * i], c = v[2 * i + 1];
        if (kscale) { const float s0 = kscale[k0 + k], s1 = kscale[k0 + k + 1]; a = a * s0; c = c * s1; }
#pragma unroll
        for (int j = 0; j < 4; ++j) *(LAS unsigned*)(scr + (4 * nq + j) * 144 + k * 2) = cvtpk(a[j], c[j]); }
    LDS_WAIT(); asm volatile("" ::: "memory");
#pragma unroll
    for (int jj = 0; jj < 8; ++jj) { const int n = (lane >> 3) + 8 * jj, c = lane & 7;
        const u32x4 w = *(const LAS u32x4*)(scr + n * 144 + c * 16);
        const int drow = dl_perm < 0 ? brow0 + n : (dl_perm == 2 ? brow0 + 8 * ((n & 31) >> 2) + (n & 3) + 4 * (n >> 5) : brow0 + 8 * (n >> 2) + (n & 3) + 4 * dl_perm);
        __builtin_nontemporal_store(w, (u32x4*)(Bt + (size_t)drow * ldb + k0 + 8 * c)); }
    LDS_WAIT(); asm volatile("" ::: "memory");
}

__device__ __forceinline__ void phase_prologue(Frame& F, CArgs& a) {
    F.refresh();
    const float* cvec = (const float*)a.in[IN_C];
    const float* adaw = (const float*)a.in[IN_ADAW]; const float* adab = (const float*)a.in[IN_ADAB];
    LAS float* sl = (LAS float*)F.lds;
    LAS float* red = (LAS float*)(F.lds + 32768);
    for (int i = F.tid; i < 2 * DM; i += NTHR) sl[i] = silu_f(cvec[i]);
    __syncthreads();
    float* MOD = (float*)(F.ws + WS_MOD);
    for (int item = F.vcu; item < DEPTH * 192; item += F.G) {
        const int l = item / 192, ct = item % 192, cq = F.tid & 15, ir = F.tid >> 4;
        const float* wp = adaw + ((size_t)l * DM + ir) * 12288 + ct * 64 + cq * 4;
        f32x4 a0 = {0.f, 0.f, 0.f, 0.f}, a1 = {0.f, 0.f, 0.f, 0.f};
#pragma unroll 8
        for (int k = 0; k < 128; ++k) { const f32x4 w = __builtin_nontemporal_load((const f32x4*)(wp + (size_t)(32 * k) * 12288)); const float s0 = sl[ir + 32 * k], s1 = sl[DM + ir + 32 * k]; a0 += w * s0; a1 += w * s1; }
#pragma unroll
        for (int j = 0; j < 4; ++j) { red[(ir * 64 + cq * 4 + j) * 2 + 0] = a0[j]; red[(ir * 64 + cq * 4 + j) * 2 + 1] = a1[j]; }
        __syncthreads();
        if (F.tid < 128) { const int col = F.tid & 63, bb = F.tid >> 6; float s = 0.f;
#pragma unroll 8
            for (int r = 0; r < 32; ++r) s += red[(r * 64 + col) * 2 + bb];
            MOD[(size_t)(l * 2 + bb) * 12288 + ct * 64 + col] = s + adab[l * 12288 + ct * 64 + col]; }
        __syncthreads();
    }
    LAS unsigned char* scr = F.lds + F.wave * 9216;
    const int gw = F.vcu * NWAVES + F.wave, NGW = F.G * NWAVES;
    constexpr int I_EVIN = (DM / 64) * (EVEN_IN / 64), I_EVOUT = (DM / 64) * (DM / 64), I_ODIN = (DM / 64) * (ODD_IN / 64), I_UQ = (QLORA / 64) * (UQ_N / 64), I_UKV = (KVLORA / 64) * (UKV_N / 64), I_ODOUT = I_EVOUT;
    constexpr int I_PER = I_EVIN + I_EVOUT + I_ODIN + I_UQ + I_UKV + I_ODOUT;
    for (int it = gw; it < 2 * I_PER; it += NGW) {
        const int i = it / I_PER; int r = it % I_PER;
        if (r < I_EVIN) { const int nb = EVEN_IN / 64, kb = r / nb, nn = r % nb;
            const int n0 = nn * 64; const bool dl = n0 >= EC_QDL && n0 < EC_VDL;
            transpose_item((const float*)a.in[IN_EVWIN] + (size_t)i * DM * EVEN_IN, EVEN_IN, nullptr, (bf16_t*)(F.ws + WS_WEVIN) + (size_t)i * EVEN_IN * DM, DM, kb * 64, n0, dl ? (n0 & ~127) : n0, scr, F.lane, dl ? ((n0 >> 6) & 1) : -1); continue; } r -= I_EVIN;
        if (r < I_EVOUT) { const int nb = DM / 64, kb = r / nb, nn = r % nb;
            transpose_item((const float*)a.in[IN_EVWOUT] + (size_t)i * DM * DM, DM, nullptr, (bf16_t*)(F.ws + WS_WEVOUT) + (size_t)i * DM * DM, DM, kb * 64, nn * 64, nn * 64, scr, F.lane); continue; } r -= I_EVOUT;
        if (r < I_ODIN) { const int nb = ODD_IN / 64, kb = r / nb, nn = r % nb; const int n0 = nn * 64;
            const int brow = n0 < 1536 ? n0 : (n0 < 1600 ? OC_KPE + (n0 - 1536) : n0 - 64);
            transpose_item((const float*)a.in[IN_ODWIN] + (size_t)i * DM * ODD_IN, ODD_IN, nullptr, (bf16_t*)(F.ws + WS_WODIN) + (size_t)i * ODD_INP * DM, DM, kb * 64, n0, brow, scr, F.lane, n0 == 1536 ? 2 : -1); continue; } r -= I_ODIN;
        if (r < I_UQ) { const int nb = UQ_N / 64, kb = r / nb, nn = r % nb;
            transpose_item((const float*)a.in[IN_ODWUQ] + (size_t)i * QLORA * UQ_N, UQ_N, (const float*)a.in[IN_ODQLN] + i * QLORA, (bf16_t*)(F.ws + WS_WUQ) + (size_t)i * UQ_N * QLORA, QLORA, kb * 64, nn * 64, nn * 64, scr, F.lane); continue; } r -= I_UQ;
        if (r < I_UKV) { const int nb = UKV_N / 64, kb = r / nb, nn = r % nb;
            transpose_item((const float*)a.in[IN_ODWUKV] + (size_t)i * KVLORA * UKV_N, UKV_N, (const float*)a.in[IN_ODKVLN] + i * KVLORA, (bf16_t*)(F.ws + WS_WUKV) + (size_t)i * UKV_N * KVLORA, KVLORA, kb * 64, nn * 64, nn * 64, scr, F.lane); continue; } r -= I_UKV;
        { const int nb = DM / 64, kb = r / nb, nn = r % nb;
            transpose_item((const float*)a.in[IN_ODWOUT] + (size_t)i * DM * DM, DM, nullptr, (bf16_t*)(F.ws + WS_WODOUT) + (size_t)i * DM * DM, DM, kb * 64, nn * 64, nn * 64, scr, F.lane); }
    }
    const size_t gt = (size_t)F.vcu * NTHR + F.tid, NGT = (size_t)F.G * NTHR;
    for (size_t i = gt; i < (size_t)2 * 192 * DM / 8; i += NGT) { const size_t li = i / (192 * DM / 8), rem = i % (192 * DM / 8);
        *(u32x4*)((bf16_t*)(F.ws + WS_WODIN) + li * (size_t)ODD_INP * DM + (size_t)ODD_IN * DM + rem * 8) = (u32x4){0u, 0u, 0u, 0u}; }
    const int* pos = (const int*)a.in[IN_POS];
    for (size_t i = gt; i < (size_t)MTOK * 96; i += NGT) { const int tok = (int)(i / 96), j = (int)(i % 96);
        const float p = (float)pos[tok];
        if (j < 64) { const float inv = (float)pow(10000.0, -(double)j / 64.0); const float ang = p * inv;
            ((float*)(F.ws + WS_COSF))[tok * 64 + j] = (float)cos((double)ang); ((float*)(F.ws + WS_SINF))[tok * 64 + j] = (float)sin((double)ang); }
        else { const int jj = j - 64; const float inv = (float)pow(10000.0, -(double)jj / 32.0); const float ang = p * inv;
            ((float*)(F.ws + WS_COSM))[tok * 32 + jj] = (float)cos((double)ang); ((float*)(F.ws + WS_SINM))[tok * 32 + jj] = (float)sin((double)ang); } }
}

__device__ __forceinline__ void phase_h(Frame& F, CArgs& a, int layer, const float* xsrc) {
    F.refresh();
    const float* MOD = (const float*)(F.ws + WS_MOD); const float* nw = (const float*)a.in[IN_NORMW] + layer * DM;
    bf16_t* H = (bf16_t*)(F.ws + WS_H);
    LAS float* Acol = (LAS float*)F.lds; LAS float* Scol = Acol + DM;
    int cur_b = -1;
    for (int rb = F.vcu; rb < MTOK / 32; rb += F.G) {
        const int bb = rb / (SEQ / 32);
        if (bb != cur_b) { __syncthreads();
            const float* mp = MOD + (size_t)(layer * 2 + bb) * 12288;
            for (int i = F.tid; i < DM; i += NTHR) { Acol[i] = nw[i] * (1.0f + mp[DM + i]); Scol[i] = mp[i]; }
            __syncthreads(); cur_b = bb; }
#pragma unroll 1
        for (int rr = 0; rr < 4; ++rr) { const int row = rb * 32 + F.wave * 4 + rr;
            if (xsrc) {
            const f32x4* xr = (const f32x4*)(xsrc + (size_t)row * DM) + F.lane;
            f32x4 v[16]; float s = 0.f;
#pragma unroll
            for (int j = 0; j < 16; ++j) { v[j] = __builtin_nontemporal_load(xr + 64 * j); s += (v[j][0] * v[j][0] + v[j][1] * v[j][1]) + (v[j][2] * v[j][2] + v[j][3] * v[j][3]); }
            const float rinv = __builtin_amdgcn_rsqf(wave_sum(s) * (1.0f / DM) + EPS);
            u32x2* o8 = (u32x2*)(H + (size_t)row * DM) + F.lane;
#pragma unroll
            for (int j = 0; j < 16; ++j) { const int c = 4 * F.lane + 256 * j; const f32x4 A = *(const LAS f32x4*)(Acol + c), Sh = *(const LAS f32x4*)(Scol + c);
                const f32x4 h = v[j] * rinv * A + Sh; u32x2 w; w.x = cvtpk(h[0], h[1]); w.y = cvtpk(h[2], h[3]); o8[64 * j] = w; }
            } else {
            const u32x4* xr = (const u32x4*)((const unsigned short*)(F.ws + WS_XH) + (size_t)row * DM) + F.lane;
            u32x4 r[8]; float s = 0.f;
#pragma unroll
            for (int j = 0; j < 8; ++j) r[j] = __builtin_nontemporal_load(xr + 64 * j);
#pragma unroll
            for (int j = 0; j < 8; ++j) { const float a0 = h_lo(r[j].x), a1 = h_hi(r[j].x), a2 = h_lo(r[j].y), a3 = h_hi(r[j].y), a4 = h_lo(r[j].z), a5 = h_hi(r[j].z), a6 = h_lo(r[j].w), a7 = h_hi(r[j].w);
                s += ((a0 * a0 + a1 * a1) + (a2 * a2 + a3 * a3)) + ((a4 * a4 + a5 * a5) + (a6 * a6 + a7 * a7)); }
            const float rinv = __builtin_amdgcn_rsqf(wave_sum(s) * (1.0f / DM) + EPS);
            u32x4* o16 = (u32x4*)(H + (size_t)row * DM) + F.lane;
#pragma unroll
            for (int j = 0; j < 8; ++j) { const int c = 8 * F.lane + 512 * j;
                const f32x4 A0 = *(const LAS f32x4*)(Acol + c), A1 = *(const LAS f32x4*)(Acol + c + 4), S0 = *(const LAS f32x4*)(Scol + c), S1 = *(const LAS f32x4*)(Scol + c + 4);
                const f32x4 x0 = {h_lo(r[j].x), h_hi(r[j].x), h_lo(r[j].y), h_hi(r[j].y)}, x1 = {h_lo(r[j].z), h_hi(r[j].z), h_lo(r[j].w), h_hi(r[j].w)};
                const f32x4 h0 = x0 * rinv * A0 + S0, h1 = x1 * rinv * A1 + S1; u32x4 w; w.x = cvtpk(h0[0], h0[1]); w.y = cvtpk(h0[2], h0[3]); w.z = cvtpk(h1[0], h1[1]); w.w = cvtpk(h1[2], h1[3]); o16[64 * j] = w; }
            }
        }
    }
    __syncthreads();
}

__device__ __forceinline__ void phase_attn_even(Frame& F) {
    asm volatile("" : "+s"(F.ws), "+s"(F.vcu));
    bf16_t* P = (bf16_t*)(F.ws + WS_PROJ); bf16_t* MX = (bf16_t*)(F.ws + WS_MIXED); bf16_t* ODL = (bf16_t*)(F.ws + WS_ODL); float* LSE = (float*)(F.ws + WS_LSE);
    for (int it = F.vcu; it < 256; it += F.G) { const int bh = it >> 3, x = it & 7, bb = bh >> 4, h = bh & 15;
        for (int pass = 0; pass < 2; ++pass) { const int qb = pass ? x : 15 - x;
            att::Blk k; const size_t t0 = (size_t)bb * SEQ + (size_t)qb * 256;
            k.Q = P + t0 * EVEN_LD + EC_QSB + h * 128;
            k.K = P + (size_t)bb * SEQ * EVEN_LD + EC_KSB + h * 128;
            k.V = P + (size_t)bb * SEQ * EVEN_LD + EC_VSB + h * 128;
            k.O = MX + t0 * DM + h * 128;
            k.G = P + t0 * EVEN_LD + EC_GSB + h * 128;
            k.LSE = nullptr; k.P0 = qb * 256; k.dil = 1; k.ssq = nullptr; k.qw = nullptr; k.cs = nullptr; k.sn = nullptr;
            att::attn_block<2>(k, F.lds, F.wv); } }
    for (int it = F.vcu; it < 256; it += F.G) { const int bh = it >> 3, kr = it & 7, bb = bh >> 4, h = bh & 15;
#pragma unroll 1
        for (int i = 0; i < 6; ++i) { const int sg = F.wv + 8 * i, pat = sg >> 4, j = sg & 15;
            const int dil = pat == 0 ? 1 : (pat == 1 ? 4 : 16); const int r = pat == 0 ? 0 : (pat == 1 ? (j >> 2) : j);
            const int P0 = pat == 0 ? 512 * kr + 32 * j : (pat == 1 ? 128 * kr + 32 * (j & 3) : 32 * kr);
            att::Blk k; const size_t tb = (size_t)bb * SEQ + r, t0 = tb + (size_t)P0 * dil;
            k.Q = P + t0 * EVEN_LD + EC_QDL + h * 128;
            k.K = P + tb * EVEN_LD + EC_KDL + h * 128;
            k.V = P + tb * EVEN_LD + EC_VDL + h * 128;
            k.O = ODL + (size_t)pat * MTOK * 2048 + t0 * 2048 + h * 128;
            k.G = nullptr;
            k.LSE = LSE + (size_t)pat * MTOK * 16 + t0 * 16 + h;  k.P0 = P0; k.dil = dil; k.ssq = nullptr; k.qw = nullptr; k.cs = nullptr; k.sn = nullptr;
            att::attn_dil_wave(k, F.lds, F.lds + XCH_OFF, F.wv); }
        asm volatile("s_waitcnt vmcnt(0)" ::: "memory");
        __syncthreads();
        F.refresh();
        const size_t tokb = (size_t)bb * SEQ + (size_t)kr * 512;
#pragma unroll 1
        for (int u0 = 0; u0 < 16; u0 += 2) {
            u32x4 r0[2], r1[2], r2[2], rg[2]; float l0[2], l1[2], l2[2]; size_t oo[2];
#pragma unroll
            for (int u = 0; u < 2; ++u) { const int idx = F.tid + NTHR * (u0 + u), c = idx & 15; const size_t tok = tokb + (idx >> 4);
                l0[u] = *GP(const float, LSE + tok * 16 + h); l1[u] = *GP(const float, LSE + (size_t)MTOK * 16 + tok * 16 + h); l2[u] = *GP(const float, LSE + (size_t)2 * MTOK * 16 + tok * 16 + h);
                r0[u] = *GP(const u32x4, ODL + tok * 2048 + h * 128 + c * 8);
                r1[u] = *GP(const u32x4, ODL + (size_t)MTOK * 2048 + tok * 2048 + h * 128 + c * 8);
                r2[u] = *GP(const u32x4, ODL + (size_t)2 * MTOK * 2048 + tok * 2048 + h * 128 + c * 8);
                rg[u] = __builtin_nontemporal_load(GP(const u32x4, P + tok * EVEN_LD + EC_GDL + h * 128 + c * 8));
                oo[u] = tok * DM + 2048 + h * 128 + c * 8; }
#pragma unroll
            for (int u = 0; u < 2; ++u) {
                const float mx = fmaxf(l0[u], fmaxf(l1[u], l2[u]));
                float w0 = __builtin_amdgcn_exp2f(l0[u] - mx), w1 = __builtin_amdgcn_exp2f(l1[u] - mx), w2 = __builtin_amdgcn_exp2f(l2[u] - mx);
                const float inv = 1.0f / (w0 + w1 + w2); w0 *= inv; w1 *= inv; w2 *= inv;
                float x0[8], x1[8], x2[8], g[8], o[8];
                unpack8(r0[u], x0); unpack8(r1[u], x1); unpack8(r2[u], x2); unpack8(rg[u], g);
#pragma unroll
                for (int e = 0; e < 8; ++e) o[e] = (w0 * x0[e] + w1 * x1[e] + w2 * x2[e]) * g[e];
                *GP(u32x4, MX + oo[u]) = pack8u(o);
            }
        }
        __syncthreads();
    }
}
__device__ __forceinline__ void phase_attn_mla(Frame& F, CArgs& a, int lp) {
    asm volatile("" : "+s"(F.ws), "+s"(F.vcu));
    const bf16_t* QR = (const bf16_t*)(F.ws + WS_QRAW); const bf16_t* KF = (const bf16_t*)(F.ws + WS_KF); const bf16_t* VF = (const bf16_t*)(F.ws + WS_VF);
    const bf16_t* P2 = (const bf16_t*)(F.ws + WS_PROJ); bf16_t* MX = (bf16_t*)(F.ws + WS_MIXED);
    const float* ssq = (const float*)(F.ws + WS_CTL + CTL_SSQCQ) + (size_t)lp * MTOK;
    for (int it = F.vcu; it < 512; it += F.G) { const int bh = it >> 3, x = it & 7, bb = bh >> 5, h = bh & 31;
        for (int pass = 0; pass < 2; ++pass) { const int qb = pass ? x : 15 - x;
            att::Blk k; const size_t t0 = (size_t)bb * SEQ + (size_t)qb * 256;
            k.Q = QR + t0 * UQ_N + h * 192;
            k.K = KF + (size_t)bh * SEQ * 192;
            k.V = VF + (size_t)bh * SEQ * 128;
            k.O = MX + t0 * DM + h * 128;
            k.G = P2 + t0 * ODD_INP + OC_G + h * 128;
            k.LSE = nullptr; k.P0 = qb * 256; k.dil = 1;
            k.ssq = ssq + t0; k.qw = (const float*)a.in[IN_ODQN] + lp * 192; k.cs = (const float*)(F.ws + WS_COSM) + t0 * 32; k.sn = (const float*)(F.ws + WS_SINM) + t0 * 32;
            att::attn_block<0>(k, F.lds, F.wv); } }
}

__device__ __forceinline__ void gemm_even_in(Frame& F, CArgs& a, int lp) {
    pg8::Gemm g{(const bf16_t*)(F.ws + WS_H), (const bf16_t*)(F.ws + WS_WEVIN) + (size_t)lp * EVEN_IN * DM, MTOK, EVEN_IN, DM, DM, DM};
    pg8::StaticOrder S; S.init(MTOK, EVEN_IN, F.G, (int)blockIdx.x);
    pg8::EpiEvenIn E{(bf16_t*)(F.ws + WS_PROJ), (const float*)a.in[IN_EVQN] + lp * 128, (const float*)a.in[IN_EVKN] + lp * 128,
                     (const float*)(F.ws + WS_COSF), (const float*)(F.ws + WS_SINF), F.lds + XCH_OFF};
    pg8::gemm_phase<pg8::EpiEvenIn, pg8::StaticOrder>(F.lds, g, S, E, F.wv);
}
__device__ __forceinline__ void gemm_odd_in(Frame& F, CArgs& a, int lp) {
    pg8::Gemm g{(const bf16_t*)(F.ws + WS_H), (const bf16_t*)(F.ws + WS_WODIN) + (size_t)lp * ODD_INP * DM, MTOK, ODD_INP, DM, DM, DM};
    pg8::StaticOrder S; S.init(MTOK, ODD_INP, F.G, (int)blockIdx.x);
    pg8::EpiBf16Op E{(bf16_t*)(F.ws + WS_PROJ), ODD_INP, 2, (const float*)a.in[IN_ODKN] + lp * 192, (const float*)(F.ws + WS_COSM), (const float*)(F.ws + WS_SINM), (float*)(F.ws + WS_CTL + CTL_SSQCQ) + (size_t)lp * MTOK, (float*)(F.ws + WS_CTL + CTL_SSQKV) + (size_t)lp * 2 * MTOK, (float*)(F.ws + WS_CTL + CTL_SSQKV) + (size_t)lp * 2 * MTOK + 1};
    pg8::gemm_phase<pg8::EpiBf16Op, pg8::StaticOrder>(F.lds, g, S, E, F.wv);
}
__device__ __forceinline__ void gemm_odd_up(Frame& F, CArgs& a, int lp) {
    { pg8::Gemm g{(const bf16_t*)(F.ws + WS_PROJ) + OC_CQ, (const bf16_t*)(F.ws + WS_WUQ) + (size_t)lp * UQ_N * QLORA, MTOK, UQ_N, QLORA, ODD_INP, QLORA};
      pg8::StaticOrder S; S.init(MTOK, UQ_N, F.G, (int)blockIdx.x);
      pg8::EpiBf16Op E{(bf16_t*)(F.ws + WS_QRAW), UQ_N, 0, nullptr, nullptr, nullptr, nullptr, nullptr, nullptr};
      pg8::gemm_phase<pg8::EpiBf16Op, pg8::StaticOrder>(F.lds, g, S, E, F.wv); }
    { pg8::Gemm g{(const bf16_t*)(F.ws + WS_PROJ) + OC_CKV, (const bf16_t*)(F.ws + WS_WUKV) + (size_t)lp * UKV_N * KVLORA, MTOK, UKV_N, KVLORA, ODD_INP, KVLORA};
      pg8::StaticOrder S; S.init(MTOK, UKV_N, F.G, (int)blockIdx.x);
      pg8::EpiKV E{(bf16_t*)(F.ws + WS_KF), (bf16_t*)(F.ws + WS_VF), (const bf16_t*)(F.ws + WS_PROJ), (const float*)(F.ws + WS_CTL + CTL_SSQKV) + (size_t)lp * 2 * MTOK, nullptr,
                   (const float*)a.in[IN_ODKN] + lp * 192, (const float*)(F.ws + WS_COSM), (const float*)(F.ws + WS_SINM), F.lds + XCH_OFF};
      pg8::gemm_phase<pg8::EpiKV, pg8::StaticOrder>(F.lds, g, S, E, F.wv); }
}
__device__ __forceinline__ void gemm_out(Frame& F, const bf16_t* Wt, const float* xs32, float* xo32, const float* gate) {
    unsigned short* XH = (unsigned short*)(F.ws + WS_XH);
    pg8::Gemm g{(const bf16_t*)(F.ws + WS_MIXED), Wt, MTOK, DM, DM, DM, DM};
    pg8::StaticOrder S; S.init(MTOK, DM, F.G, (int)blockIdx.x);
    pg8::EpiResid E{xs32, xs32 ? nullptr : XH, xo32, xo32 ? nullptr : XH, gate};
    pg8::gemm_phase<pg8::EpiResid, pg8::StaticOrder>(F.lds, g, S, E, F.wv);
}

constexpr int N_PHASES = 25;
#ifndef REPEAT_MASK
#define REPEAT_MASK 0
#endif
#define REP(idx) ((REPEAT_MASK >> (idx)) & 1)
__global__ void __launch_bounds__(NTHR, 2) mega_fwd(Args args) {
    extern __shared__ __attribute__((aligned(16))) unsigned char lds_raw[];
    Frame F;
    F.lds = (LAS unsigned char*)lds_raw;
    F.tid = threadIdx.x; F.lane = F.tid & 63; F.wave = __builtin_amdgcn_readfirstlane(F.tid >> 6); F.wv = F.wave;
    F.G = gridDim.x; { const int bx = blockIdx.x; F.vcu = (F.G % 8 == 0) ? (bx % 8) * (F.G / 8) + bx / 8 : bx; }
    F.ws = args.ws;
    for (int u = F.tid; u < (LDS_BYTES - LDSCTL_OFF) / 4; u += NTHR) ((LAS unsigned*)(F.lds + LDSCTL_OFF))[u] = 0u;
    __syncthreads();
    const int lo = args.ph_lo, hi = args.ph_hi;
    XcdBarrier bar; bar.bar = (unsigned*)(F.ws + WS_CTL) + CW_BAR; bar.x = 0; bar.st = nullptr; bar.wv = F.wv;
    if (hi - lo > 1) bar = xcd_barrier_post((unsigned*)(F.ws + WS_CTL) + CW_BAR, (volatile LAS unsigned*)(F.lds + MISC_OFF) + 8, F.wv);
#define IN(k) (lo <= (k) && (k) < hi)
#define SEAM(k) do { if (IN(k) && IN((k) + 1)) xcd_barrier(bar); } while (0)
    const float* xin = (const float*)args.in[IN_X];
    float* xout = args.out;
    const float* MOD = (const float*)(F.ws + WS_MOD);

#define KA (*kargs())
#define RUN(k, idx, BODY) do { if (IN(k)) { BODY; if (REP(idx)) { xcd_barrier(bar); BODY; } } SEAM(k); } while (0)
    RUN(0, 0, phase_prologue(F, KA));

    for (int lp = 0; lp < 2; ++lp) {
        const int base = 1 + 12 * lp;
        { const int layer = 2 * lp; const float* xs = (layer == 0) ? xin : nullptr;
        RUN(base + 0, 1, phase_h(F, KA, layer, xs));
        RUN(base + 1, 2, gemm_even_in(F, KA, lp));
        RUN(base + 3, 4, phase_attn_even(F));
        RUN(base + 5, 6, gemm_out(F, (const bf16_t*)(F.ws + WS_WEVOUT) + (size_t)lp * DM * DM, xs, nullptr, MOD + (size_t)(layer * 2) * 12288 + 2 * DM));
        }
        { const int layer = 2 * lp + 1;
        RUN(base + 6, 7, phase_h(F, KA, layer, nullptr));
        RUN(base + 7, 8, gemm_odd_in(F, KA, lp));
        RUN(base + 8, 9, gemm_odd_up(F, KA, lp));
        RUN(base + 10, 11, phase_attn_mla(F, KA, lp));
        RUN(base + 11, 12, gemm_out(F, (const bf16_t*)(F.ws + WS_WODOUT) + (size_t)lp * DM * DM, nullptr, (lp == 1) ? xout : nullptr, MOD + (size_t)(layer * 2) * 12288 + 2 * DM));
        }
    }
#undef RUN
#undef KA
#undef IN
#undef SEAM
}

extern "C" void kernel_launch(void* const* d_in, const int* in_sizes, int n_in, void* d_out, int out_size, void* d_ws, size_t ws_size, hipStream_t stream) {
    static int grid = 0;
    if (grid == 0) {
        if (n_in != 18 || out_size != MTOK * DM || ws_size < WS_END) { fprintf(stderr, "kernel_launch: unexpected shapes (n_in %d, out %d, ws %zu); nothing launched\n", n_in, out_size, ws_size); grid = -1; return; }
        int dev = 0, cus = 0, per_cu = 0;
        if (hipGetDevice(&dev) != hipSuccess || hipDeviceGetAttribute(&cus, hipDeviceAttributeMultiprocessorCount, dev) != hipSuccess) { grid = -1; return; }
        if (hipFuncSetAttribute((const void*)mega_fwd, hipFuncAttributeMaxDynamicSharedMemorySize, LDS_BYTES) != hipSuccess) { fprintf(stderr, "kernel_launch: hipFuncSetAttribute failed\n"); grid = -1; return; }
        if (hipOccupancyMaxActiveBlocksPerMultiprocessor(&per_cu, (const void*)mega_fwd, NTHR, LDS_BYTES) != hipSuccess || per_cu < 1)
            fprintf(stderr, "kernel_launch: note: occupancy query reports %d workgroups per CU\n", per_cu);
        (void)hipGetLastError();
        grid = cus;
    }
    if (grid < 0) return;
    if (hipMemsetAsync((char*)d_ws + WS_CTL, 0, CTL_ZERO_BYTES, stream) != hipSuccess) { fprintf(stderr, "kernel_launch: memset failed\n"); return; }
    Args a{};
    for (int i = 0; i < 18; ++i) a.in[i] = d_in[i];
    a.out = (float*)d_out; a.ws = (unsigned char*)d_ws;
#if MK_N_LAUNCHES == 1
    a.ph_lo = 0; a.ph_hi = N_PHASES;
    hipLaunchKernelGGL(mega_fwd, dim3(grid), dim3(NTHR), LDS_BYTES, stream, a);
#else
    for (int k = 0; k < N_PHASES; ++k) { a.ph_lo = k; a.ph_hi = k + 1; hipLaunchKernelGGL(mega_fwd, dim3(grid), dim3(NTHR), LDS_BYTES, stream, a); }
#endif
}
```
